# Optimizing an MI355X kernel written in HIP

```python
import math
import jax, jax.numpy as jnp
from jax import lax
import numpy as np

D_MODEL = 2048
BATCH = 2
SEQ = 4096
DEPTH = 1
DEC_BATCH = 32
DEC_SEQ = 16
PAST_LEN = 1024

CHUNK = 64
N_META = 16
D_SSM = D_MODEL // 2
SSM_GROUP = 16
N_SSM_GROUPS = D_SSM // SSM_GROUP
SSM_STATE = 64
D_POOL = D_MODEL - D_SSM
POOL_WINDOWS = (2, 4, 8, 16)
N_POOL_GROUPS = len(POOL_WINDOWS)
POOL_GROUP = D_POOL // N_POOL_GROUPS
POOL_HIST = max(POOL_WINDOWS) - 1
D_MIX = D_SSM + D_POOL
D_FF = 5632
FFN_CONV_W = 3
RMS_EPS = 1e-6
DT_MIN = 1e-3
DT_MAX = 1e-1

kernel_name = "hymba_s5_pool_convffn_stream_step"

F32 = jnp.float32


def rmsnorm(x, g):
    xf = x.astype(F32)
    y = xf * lax.rsqrt(jnp.mean(xf * xf, axis=-1, keepdims=True) + RMS_EPS)
    return (y * g.astype(F32)).astype(x.dtype)


def s5_mixer(u, h0_re, h0_im, lam_re, lam_im, log_dt, b_re, b_im, c_re, c_im, d_skip, w_glu):
    bsz, seqlen, _ = u.shape
    uf = u.astype(F32).reshape(bsz, seqlen, N_SSM_GROUPS, SSM_GROUP)
    dt = jnp.exp(log_dt.astype(F32))[:, None]
    lam = lax.complex(lam_re.astype(F32), lam_im.astype(F32))
    lam_bar = jnp.exp(lam * dt)
    b = lax.complex(b_re.astype(F32), b_im.astype(F32))
    b_bar = ((lam_bar - 1.0) / lam)[..., None] * b
    bu = jnp.einsum("gpn,blgn->blgp", b_bar, uf.astype(jnp.complex64))
    h0 = lax.complex(h0_re.astype(F32), h0_im.astype(F32))
    bu = bu.at[:, 0].add(lam_bar[None] * h0)
    a = jnp.broadcast_to(lam_bar, bu.shape)

    def combine(e1, e2):
        a1, b1 = e1
        a2, b2 = e2
        return a1 * a2, a2 * b1 + b2

    _, h = lax.associative_scan(combine, (a, bu), axis=1)
    c = lax.complex(c_re.astype(F32), c_im.astype(F32))
    y = jnp.einsum("gnp,blgp->blgn", c, h).real
    y = y + d_skip.astype(F32).reshape(N_SSM_GROUPS, SSM_GROUP) * uf
    y = jax.nn.gelu(y.reshape(bsz, seqlen, D_SSM))
    y = y * jax.nn.sigmoid(y @ w_glu.astype(F32))
    h_last = h[:, -1]
    return y.astype(u.dtype), h_last.real.astype(h0_re.dtype), h_last.imag.astype(h0_im.dtype)


def pool_mixer(u, hist, pos0, w_pool, pool_scale):
    bsz, seqlen, _ = u.shape
    z = jnp.concatenate([hist.astype(u.dtype), u], axis=1).astype(F32)
    cs = jnp.cumsum(z, axis=1)
    cs = jnp.concatenate([jnp.zeros_like(cs[:, :1]), cs], axis=1)
    end = cs[:, POOL_HIST + 1:]
    pos = pos0 + jnp.arange(seqlen)
    outs = []
    for k, w in enumerate(POOL_WINDOWS):
        lo, hi = k * POOL_GROUP, (k + 1) * POOL_GROUP
        start = cs[:, POOL_HIST + 1 - w: POOL_HIST + 1 - w + seqlen, lo:hi]
        cnt = jnp.minimum(pos + 1, w).astype(F32)[None, :, None]
        mean = (end[..., lo:hi] - start) / cnt
        outs.append(mean - z[:, POOL_HIST:, lo:hi])
    m = jnp.stack(outs, axis=2)
    m = jnp.einsum("blgc,gcd->blgd", m, w_pool.astype(F32)).reshape(bsz, seqlen, D_POOL)
    y = m * pool_scale.astype(F32)
    new_hist = z[:, -POOL_HIST:]
    return y.astype(u.dtype), new_hist.astype(hist.dtype)


def conv_ffn(x, hist, w_up, conv_w, conv_b, w_down):
    seqlen = x.shape[1]
    up = x @ w_up
    g, v = up[..., :D_FF], up[..., D_FF:]
    gext = jnp.concatenate([hist.astype(g.dtype), g], axis=1)
    gc = conv_b
    for k in range(FFN_CONV_W):
        gc = gc + gext[:, k:k + seqlen] * conv_w[k]
    h = jax.nn.gelu(gc) * v
    return h @ w_down, gext[:, -(FFN_CONV_W - 1):].astype(hist.dtype)


def layer(x, h_re, h_im, pool_hist, conv_hist, pos0,
          g_mix, w_in, lam_re, lam_im, log_dt, b_re, b_im, c_re, c_im, d_skip, w_glu,
          w_pool, pool_scale, w_out, g_ffn, w_up, conv_w, conv_b, w_down):
    hn = rmsnorm(x, g_mix)
    proj = hn @ w_in
    u_ssm, u_pool = proj[..., :D_SSM], proj[..., D_SSM:]
    y_ssm, new_re, new_im = s5_mixer(u_ssm, h_re, h_im, lam_re, lam_im, log_dt,
                                     b_re, b_im, c_re, c_im, d_skip, w_glu)
    y_pool, new_pool = pool_mixer(u_pool, pool_hist, pos0, w_pool, pool_scale)
    x = x + jnp.concatenate([y_ssm, y_pool], axis=-1) @ w_out
    f, new_conv = conv_ffn(rmsnorm(x, g_ffn), conv_hist, w_up, conv_w, conv_b, w_down)
    x = x + f
    return x, new_re, new_im, new_pool, new_conv


def trunk(x, h_re, h_im, pool_hist, conv_hist, pos0, layer_params):
    res_re, res_im, res_pool, res_conv = [], [], [], []
    for l in range(DEPTH):
        p = tuple(a[l] for a in layer_params)
        x, nr, ni, npool, nconv = layer(x, h_re[l], h_im[l], pool_hist[l], conv_hist[l], pos0, *p)
        res_re.append(nr)
        res_im.append(ni)
        res_pool.append(npool)
        res_conv.append(nconv)
    return x, jnp.stack(res_re), jnp.stack(res_im), jnp.stack(res_pool), jnp.stack(res_conv)


def setup_inputs(seed: int = 0) -> dict:
    key = jax.random.key(seed)
    ks = jax.random.split(key, 32)
    nrm = jax.random.normal
    lam_im0 = jnp.pi * jnp.arange(SSM_STATE, dtype=F32)
    return {
        "x_prompt": nrm(ks[0], (BATCH, SEQ, D_MODEL), F32),
        "x_sample": nrm(ks[1], (DEC_BATCH, DEC_SEQ, D_MODEL), F32),
        "state_ssm_re": nrm(ks[2], (DEPTH, DEC_BATCH, N_SSM_GROUPS, SSM_STATE), F32),
        "state_ssm_im": nrm(ks[3], (DEPTH, DEC_BATCH, N_SSM_GROUPS, SSM_STATE), F32),
        "state_pool": nrm(ks[4], (DEPTH, DEC_BATCH, POOL_HIST, D_POOL), F32),
        "state_ffn_conv": nrm(ks[5], (DEPTH, DEC_BATCH, FFN_CONV_W - 1, D_FF), F32),
        "meta_tokens": nrm(ks[6], (N_META, D_MODEL), F32),
        "g_mix": 1.0 + 0.02 * nrm(ks[7], (DEPTH, D_MODEL), F32),
        "w_in": nrm(ks[8], (DEPTH, D_MODEL, D_MIX), F32) * D_MODEL ** -0.5,
        "lam_re": -0.5 + 0.01 * nrm(ks[9], (DEPTH, N_SSM_GROUPS, SSM_STATE), F32),
        "lam_im": lam_im0 + 0.01 * nrm(ks[10], (DEPTH, N_SSM_GROUPS, SSM_STATE), F32),
        "log_dt": jax.random.uniform(ks[11], (DEPTH, N_SSM_GROUPS), F32,
                                     math.log(DT_MIN), math.log(DT_MAX)),
        "b_re": nrm(ks[12], (DEPTH, N_SSM_GROUPS, SSM_STATE, SSM_GROUP), F32) * (2 * SSM_GROUP) ** -0.5,
        "b_im": nrm(ks[13], (DEPTH, N_SSM_GROUPS, SSM_STATE, SSM_GROUP), F32) * (2 * SSM_GROUP) ** -0.5,
        "c_re": nrm(ks[14], (DEPTH, N_SSM_GROUPS, SSM_GROUP, SSM_STATE), F32) * (2 * SSM_STATE) ** -0.5,
        "c_im": nrm(ks[15], (DEPTH, N_SSM_GROUPS, SSM_GROUP, SSM_STATE), F32) * (2 * SSM_STATE) ** -0.5,
        "d_skip": 1.0 + 0.1 * nrm(ks[16], (DEPTH, D_SSM), F32),
        "w_glu": nrm(ks[17], (DEPTH, D_SSM, D_SSM), F32) * D_SSM ** -0.5,
        "w_pool": nrm(ks[18], (DEPTH, N_POOL_GROUPS, POOL_GROUP, POOL_GROUP), F32) * POOL_GROUP ** -0.5,
        "pool_scale": 1.0 + 0.1 * nrm(ks[19], (DEPTH, D_POOL), F32),
        "w_out": nrm(ks[20], (DEPTH, D_MIX, D_MODEL), F32) * D_MIX ** -0.5,
        "g_ffn": 1.0 + 0.02 * nrm(ks[21], (DEPTH, D_MODEL), F32),
        "w_up": nrm(ks[22], (DEPTH, D_MODEL, 2 * D_FF), F32) * D_MODEL ** -0.5,
        "conv_w": nrm(ks[23], (DEPTH, FFN_CONV_W, D_FF), F32) * FFN_CONV_W ** -0.5,
        "conv_b": 0.02 * nrm(ks[24], (DEPTH, D_FF), F32),
        "w_down": nrm(ks[25], (DEPTH, D_FF, D_MODEL), F32) * D_FF ** -0.5,
        "g_final": 1.0 + 0.02 * nrm(ks[26], (D_MODEL,), F32),
    }


def reference(x_prompt, x_sample, state_ssm_re, state_ssm_im, state_pool, state_ffn_conv,
              meta_tokens, g_mix, w_in, lam_re, lam_im, log_dt, b_re, b_im, c_re, c_im,
              d_skip, w_glu, w_pool, pool_scale, w_out, g_ffn, w_up, conv_w, conv_b,
              w_down, g_final):
    layer_params = (g_mix, w_in, lam_re, lam_im, log_dt, b_re, b_im, c_re, c_im, d_skip,
                    w_glu, w_pool, pool_scale, w_out, g_ffn, w_up, conv_w, conv_b, w_down)

    meta = jnp.broadcast_to(meta_tokens.astype(x_prompt.dtype)[None], (BATCH, N_META, D_MODEL))
    xp = jnp.concatenate([meta, x_prompt], axis=1)
    z_re = jnp.zeros((DEPTH, BATCH, N_SSM_GROUPS, SSM_STATE), state_ssm_re.dtype)
    z_im = jnp.zeros((DEPTH, BATCH, N_SSM_GROUPS, SSM_STATE), state_ssm_im.dtype)
    z_pool = jnp.zeros((DEPTH, BATCH, POOL_HIST, D_POOL), state_pool.dtype)
    z_conv = jnp.zeros((DEPTH, BATCH, FFN_CONV_W - 1, D_FF), state_ffn_conv.dtype)
    hp, ssm_re_p, ssm_im_p, pool_p, conv_p = trunk(xp, z_re, z_im, z_pool, z_conv, 0, layer_params)
    y_prompt = rmsnorm(hp, g_final)[:, N_META:]

    hs, ssm_re_s, ssm_im_s, pool_s, conv_s = trunk(x_sample, state_ssm_re, state_ssm_im,
                                                   state_pool, state_ffn_conv, PAST_LEN,
                                                   layer_params)
    y_sample = rmsnorm(hs, g_final)

    return (y_prompt, y_sample, ssm_re_p, ssm_im_p, pool_p, conv_p,
            ssm_re_s, ssm_im_s, pool_s, conv_s)
```

```cpp
#include <hip/hip_runtime.h>
#include <hip/hip_cooperative_groups.h>
#include <cstdio>
#include <cstdint>
namespace cg = cooperative_groups;

namespace pg8 {
#define PG8_LAS __attribute__((address_space(3)))
typedef unsigned short bf16_t;
typedef short bf16x8 __attribute__((ext_vector_type(8)));
typedef float f32x4 __attribute__((ext_vector_type(4)));
typedef float f32x2 __attribute__((ext_vector_type(2)));
typedef unsigned u32x4 __attribute__((ext_vector_type(4)));
typedef unsigned u32x2 __attribute__((ext_vector_type(2)));
constexpr int BM = 256, BK = 64, HALF = 128, HTB = HALF * BK * 2  , STAGE_BYTES = 8 * HTB, NXCD = 8, WGM = 8;

__host__ __device__ __forceinline__ int lds_byte(int r, int c) { const int st = (r >> 4) * 2 + (c >> 5), rr = r & 15, cc = c & 31, ob = rr * 64 + cc * 2; return st * 1024 + (ob ^ (((ob >> 9) & 1) << 5)); }
__host__ __device__ __forceinline__ void stage_rc(int b, int& R, int& C) { const int st = b / 1024, sb = b % 1024, swz = sb ^ (((sb >> 9) & 1) << 5); R = (st >> 1) * 16 + swz / 64; C = (st & 1) * 32 + (swz % 64) / 2; }
__host__ __device__ __forceinline__ int perm32(int rho) { const int n = rho >> 4, i = rho & 15; return 8 * (i >> 2) + 4 * n + (i & 3); }

struct Unit { int pm, pn; };
struct Gemm {
    const bf16_t* A; const bf16_t* Bt; int lda, ldb, K, a_pn_off;
    __device__ __forceinline__ const char* abase(const Unit& u) const { return (const char*)(A + ((size_t)u.pm * BM * lda + (size_t)u.pn * a_pn_off)); }
    __device__ __forceinline__ const char* bbase(const Unit& u) const { return (const char*)(Bt + (size_t)u.pn * BM * ldb); }
};

struct StaticOrder {
    int nM, nN, nwg, G, c;
    __host__ __device__ void init(int nM_, int nN_, int G_, int c_) { nM = nM_; nN = nN_; nwg = nM * nN; G = G_; c = c_; }
    __host__ __device__ bool next(int i, Unit& u) const {
        const long L = (long)i * G + c; if (L >= nwg) return false;
        int wgid = (int)L; { const int q = nwg / NXCD, r = nwg % NXCD, xcd = wgid % NXCD, off = wgid / NXCD; wgid = (xcd < r ? xcd * (q + 1) : r * (q + 1) + (xcd - r) * q) + off; }
        const int nig = WGM * nN, gid = wgid / nig, fm = gid * WGM, gsz = (nM - fm) < WGM ? (nM - fm) : WGM;
        u.pm = fm + ((wgid % nig) % gsz); u.pn = (wgid % nig) / gsz; return true;
    }
    __device__ __forceinline__ void a_ready(const Unit&) const {}
    __device__ __forceinline__ void done(const Unit&) const {}
};

__device__ __forceinline__ unsigned cvt_pk_bf16(float lo, float hi) { unsigned r; asm volatile("v_cvt_pk_bf16_f32 %0, %1, %2" : "=v"(r) : "v"(lo), "v"(hi)); return r; }
__device__ __forceinline__ float bflo(unsigned w) { return __uint_as_float(w << 16); }
__device__ __forceinline__ float bfhi(unsigned w) { return __uint_as_float(w & 0xffff0000u); }
__device__ __forceinline__ float gelu_tanh(float x) {
    const float u = x * (1.0f + 0.044715f * x * x);
    const float e = __builtin_amdgcn_exp2f(u * (-2.0f * 0.7978845608028654f * 1.4426950408889634f));
    return x * __builtin_amdgcn_rcpf(1.0f + e);
}
__device__ __forceinline__ float sigmoidf_(float x) { return __builtin_amdgcn_rcpf(1.0f + __builtin_amdgcn_exp2f(x * -1.4426950408889634f)); }

struct EpiBf16 {
    static constexpr bool PERM = true, AFTER_DRAIN = false;
    bf16_t* O; int ldc;
    __device__ __forceinline__ void operator()(const f32x4 (&acc)[2][2][4][2], const Unit& u, int wr, int wc, int fr, int fq) const {
        const int row0 = u.pm * BM + wr * 64 + fr; const int col0 = u.pn * BM + wc * 32 + 8 * fq;
#pragma unroll
        for (int ai = 0; ai < 2; ++ai)
#pragma unroll
            for (int m = 0; m < 4; ++m) { bf16_t* rowp = O + (size_t)(row0 + ai * HALF + m * 16) * ldc + col0;
#pragma unroll
                for (int bj = 0; bj < 2; ++bj) { const f32x4 v0 = acc[ai][bj][m][0], v1 = acc[ai][bj][m][1];
                    u32x4 w; w.x = cvt_pk_bf16(v0[0], v0[1]); w.y = cvt_pk_bf16(v0[2], v0[3]); w.z = cvt_pk_bf16(v1[0], v1[1]); w.w = cvt_pk_bf16(v1[2], v1[3]);
                    *(u32x4*)(rowp + bj * HALF) = w; } }
    }
};
struct EpiPool {
    static constexpr bool PERM = true, AFTER_DRAIN = false;
    bf16_t* O; const float* scale;
    __device__ __forceinline__ void operator()(const f32x4 (&acc)[2][2][4][2], const Unit& u, int wr, int wc, int fr, int fq) const {
        const int row0 = u.pm * BM + wr * 64 + fr; const int c0 = u.pn * BM + wc * 32 + 8 * fq;
        f32x4 sv[2][2];
#pragma unroll
        for (int bj = 0; bj < 2; ++bj)
#pragma unroll
            for (int n = 0; n < 2; ++n) sv[bj][n] = *(const f32x4*)(scale + c0 + bj * HALF + 4 * n);
#pragma unroll
        for (int ai = 0; ai < 2; ++ai)
#pragma unroll
            for (int m = 0; m < 4; ++m) { bf16_t* rowp = O + (size_t)(row0 + ai * HALF + m * 16) * 2048 + 1024 + c0;
#pragma unroll
                for (int bj = 0; bj < 2; ++bj) { const f32x4 v0 = acc[ai][bj][m][0] * sv[bj][0], v1 = acc[ai][bj][m][1] * sv[bj][1];
                    u32x4 w; w.x = cvt_pk_bf16(v0[0], v0[1]); w.y = cvt_pk_bf16(v0[2], v0[3]); w.z = cvt_pk_bf16(v1[0], v1[1]); w.w = cvt_pk_bf16(v1[2], v1[3]);
                    *(u32x4*)(rowp + bj * HALF) = w; } }
    }
};
struct EpiGlu {
    static constexpr bool PERM = true, AFTER_DRAIN = false;
    const bf16_t* YP; bf16_t* O;
    __device__ __forceinline__ void operator()(const f32x4 (&acc)[2][2][4][2], const Unit& u, int wr, int wc, int fr, int fq) const {
        const int row0 = u.pm * BM + wr * 64 + fr; const int c0 = u.pn * BM + wc * 32 + 8 * fq;
#pragma unroll
        for (int ai = 0; ai < 2; ++ai)
#pragma unroll
            for (int m = 0; m < 4; ++m) { const size_t R = (size_t)(row0 + ai * HALF + m * 16);
#pragma unroll
                for (int bj = 0; bj < 2; ++bj) { const u32x4 yp = *(const u32x4*)(YP + R * 1024 + c0 + bj * HALF);
                    const f32x4 a = acc[ai][bj][m][0], b = acc[ai][bj][m][1];
                    u32x4 w;
                    w.x = cvt_pk_bf16(bflo(yp.x) * sigmoidf_(a[0]), bfhi(yp.x) * sigmoidf_(a[1]));
                    w.y = cvt_pk_bf16(bflo(yp.y) * sigmoidf_(a[2]), bfhi(yp.y) * sigmoidf_(a[3]));
                    w.z = cvt_pk_bf16(bflo(yp.z) * sigmoidf_(b[0]), bfhi(yp.z) * sigmoidf_(b[1]));
                    w.w = cvt_pk_bf16(bflo(yp.w) * sigmoidf_(b[2]), bfhi(yp.w) * sigmoidf_(b[3]));
                    *(u32x4*)(O + R * 2048 + c0 + bj * HALF) = w; } }
    }
};
constexpr int R_SAMPLE0 = 8192, R_REAL = 8704, R_ALL = 8736, R_PAD = 8960;
struct EpiOut {
    static constexpr bool PERM = false, AFTER_DRAIN = false;
    const float *xp, *xs, *meta, *gffn; float* out; float* xmeta; bf16_t* XN; float* ss;
    __device__ __forceinline__ void operator()(const f32x4 (&acc)[2][2][4][2], const Unit& u, int wr, int wc, int fr, int fq) const {
        const int col0 = u.pn * BM + wc * 32 + 4 * fq;
        f32x4 gv[2][2];
#pragma unroll
        for (int bj = 0; bj < 2; ++bj)
#pragma unroll
            for (int n = 0; n < 2; ++n) gv[bj][n] = *(const f32x4*)(gffn + col0 + bj * HALF + n * 16);
#pragma unroll
        for (int ai = 0; ai < 2; ++ai)
#pragma unroll
            for (int m = 0; m < 4; ++m) { const int R = u.pm * BM + ai * HALF + wr * 64 + m * 16 + fr; float s = 0.f;
                if (R < R_ALL) {
                    const float* xr = R < R_SAMPLE0 ? xp + (size_t)R * 2048 : (R < R_REAL ? xs + (size_t)(R - R_SAMPLE0) * 2048 : meta + (size_t)((R - R_REAL) & 15) * 2048);
                    float* dst = R < R_REAL ? out + (size_t)R * 2048 : xmeta + (size_t)(R - R_REAL) * 2048;
                    bf16_t* xn = XN + (size_t)R * 2048;
#pragma unroll
                    for (int bj = 0; bj < 2; ++bj)
#pragma unroll
                        for (int n = 0; n < 2; ++n) { const int c = col0 + bj * HALF + n * 16; const f32x4 x1 = *(const f32x4*)(xr + c) + acc[ai][bj][m][n];
                            *(f32x4*)(dst + c) = x1; s += (x1[0] * x1[0] + x1[1] * x1[1]) + (x1[2] * x1[2] + x1[3] * x1[3]);
                            const f32x4 xg = x1 * gv[bj][n]; u32x2 w; w.x = cvt_pk_bf16(xg[0], xg[1]); w.y = cvt_pk_bf16(xg[2], xg[3]); *(u32x2*)(xn + c) = w; }
                }
                s += __shfl_xor(s, 16); s += __shfl_xor(s, 32);
                if (fq == 0 && R < R_ALL) atomicAdd(ss + R, s); }
    }
};
struct EpiDown {
    static constexpr bool PERM = false, AFTER_DRAIN = false;
    float* out; float* ss;
    __device__ __forceinline__ void operator()(const f32x4 (&acc)[2][2][4][2], const Unit& u, int wr, int wc, int fr, int fq) const {
        const int col0 = u.pn * BM + wc * 32 + 4 * fq;
#pragma unroll
        for (int ai = 0; ai < 2; ++ai)
#pragma unroll
            for (int m = 0; m < 4; ++m) { const int R = u.pm * BM + ai * HALF + wr * 64 + m * 16 + fr; float s = 0.f; float* dst = out + (size_t)R * 2048;
#pragma unroll
                for (int bj = 0; bj < 2; ++bj)
#pragma unroll
                    for (int n = 0; n < 2; ++n) { const int c = col0 + bj * HALF + n * 16; const f32x4 x2 = *(const f32x4*)(dst + c) + acc[ai][bj][m][n];
                        *(f32x4*)(dst + c) = x2; s += (x2[0] * x2[0] + x2[1] * x2[1]) + (x2[2] * x2[2] + x2[3] * x2[3]); }
                s += __shfl_xor(s, 16); s += __shfl_xor(s, 32);
                if (fq == 0) atomicAdd(ss + R, s); }
    }
};
constexpr int DFF = 5632;
struct EpiUp {
    static constexpr bool PERM = true, AFTER_DRAIN = false;
    const float* ss; const float *cw, *cb; bf16_t* H; float *gfix, *vfix, *gsrc; float *conv_p, *conv_s;
    __device__ __forceinline__ void operator()(const f32x4 (&acc)[2][2][4][2], const Unit& u, int wr, int wc, int fr, int fq) const {
        const int j0 = u.pn * HALF + wc * 32 + 8 * fq;
        const int lane = fq * 16 + fr;
        const int s1 = (lane & 48) | ((fr + 15) & 15), s2 = (lane & 48) | ((fr + 14) & 15);
        const bool samp = u.pm >= 32;
        float w0[8], w1[8], w2[8], b0[8];
#pragma unroll
        for (int h = 0; h < 2; ++h) { const f32x4 a = *(const f32x4*)(cw + j0 + 4 * h), b = *(const f32x4*)(cw + DFF + j0 + 4 * h), c = *(const f32x4*)(cw + 2 * DFF + j0 + 4 * h), d = *(const f32x4*)(cb + j0 + 4 * h);
#pragma unroll
            for (int e = 0; e < 4; ++e) { w0[4 * h + e] = a[e]; w1[4 * h + e] = b[e]; w2[4 * h + e] = c[e]; b0[4 * h + e] = d[e]; } }
#pragma unroll
        for (int ai = 0; ai < 2; ++ai) {
            float pp[8];
#pragma unroll
            for (int e = 0; e < 8; ++e) pp[e] = 0.f;
#pragma unroll
            for (int m = 0; m < 4; ++m) {
                const int rt = ai * HALF + wr * 64 + m * 16 + fr; const int R = u.pm * BM + rt;
                const float rstd = rsqrtf(ss[R] * (1.0f / 2048.0f) + 1e-6f);
                float gg[8], vv[8], hh[8];
#pragma unroll
                for (int e = 0; e < 4; ++e) { gg[e] = acc[ai][0][m][0][e] * rstd; gg[4 + e] = acc[ai][0][m][1][e] * rstd; vv[e] = acc[ai][1][m][0][e] * rstd; vv[4 + e] = acc[ai][1][m][1][e] * rstd; }
#pragma unroll
                for (int e = 0; e < 8; ++e) {
                    const float a1 = __shfl(gg[e], s1), a2 = __shfl(gg[e], s2), q1 = __shfl(pp[e], s1), q2 = __shfl(pp[e], s2);
                    const float p1 = fr >= 1 ? a1 : q1, p2 = fr >= 2 ? a2 : q2;
                    const float gc = b0[e] + p2 * w0[e] + p1 * w1[e] + gg[e] * w2[e];
                    hh[e] = gelu_tanh(gc) * vv[e];
                }
                u32x4 w; w.x = cvt_pk_bf16(hh[0], hh[1]); w.y = cvt_pk_bf16(hh[2], hh[3]); w.z = cvt_pk_bf16(hh[4], hh[5]); w.w = cvt_pk_bf16(hh[6], hh[7]);
                *(u32x4*)(H + (size_t)R * DFF + j0) = w;
                const f32x4 gA = {gg[0], gg[1], gg[2], gg[3]}, gB = {gg[4], gg[5], gg[6], gg[7]};
                if (fr < 2 && (m == 0 || samp)) {
                    const int id = samp ? 256 + (u.pm - 32) * 32 + (rt >> 4) * 2 + fr : u.pm * 8 + (rt >> 6) * 2 + fr;
                    float* gp = gfix + (size_t)id * DFF + j0; float* vp = vfix + (size_t)id * DFF + j0;
                    *(f32x4*)gp = gA; *(f32x4*)(gp + 4) = gB;
                    *(f32x4*)vp = (f32x4){vv[0], vv[1], vv[2], vv[3]}; *(f32x4*)(vp + 4) = (f32x4){vv[4], vv[5], vv[6], vv[7]};
                }
                if (fr >= 14) {
                    if (samp) { float* cp = conv_s + (size_t)(((R - R_SAMPLE0) >> 4) * 2 + (fr - 14)) * DFF + j0; *(f32x4*)cp = gA; *(f32x4*)(cp + 4) = gB; }
                    else if (m == 3) {
                        float* sp = gsrc + (size_t)(u.pm * 8 + (rt >> 6) * 2 + (fr - 14)) * DFF + j0; *(f32x4*)sp = gA; *(f32x4*)(sp + 4) = gB;
                        if ((R & 4095) >= 4094) { float* cp = conv_p + (size_t)((R >> 12) * 2 + ((R & 4095) - 4094)) * DFF + j0; *(f32x4*)cp = gA; *(f32x4*)(cp + 4) = gB; }
                    }
                }
#pragma unroll
                for (int e = 0; e < 8; ++e) pp[e] = gg[e];
            }
        }
    }
};

template <class Epi, class Sched, bool ALIGN_EPI = false, bool SP2 = false>
__device__ __forceinline__ void gemm_phase(PG8_LAS unsigned char* lds, const Gemm g, const Sched& S, const Epi& E) {
    int tid_ = threadIdx.x; asm volatile("" : "+v"(tid_));
    const int tid = tid_, wid = __builtin_amdgcn_readfirstlane(tid >> 6), lane = tid & 63, wr = wid >> 2, wc = wid & 3, fr = lane & 15, fq = lane >> 4;
    const int K = g.K, nt = K / BK;
    unsigned voffA[2], voffB[2];
#pragma unroll
    for (int i = 0; i < 2; ++i) { int R, C; stage_rc(tid * 16 + i * 8192, R, C); const int Rb = Epi::PERM ? ((R & ~31) + perm32(R & 31)) : R;
        voffA[i] = (unsigned)(R * g.lda + C) * 2u; voffB[i] = (unsigned)(Rb * g.ldb + C) * 2u; }
    const size_t kstep = (size_t)(BK * 2);
    const size_t hstepA = (size_t)HALF * g.lda * 2, hstepB = (size_t)HALF * g.ldb * 2;
    const unsigned ldsw = (unsigned)wid * 1024u;
    const int aoff = lds_byte(wr * 64 + fr, fq * 8), boff = lds_byte(wc * 32 + fr, fq * 8);
#define PG8_SA(b, h) (((b) * 2 + (h)) * HTB)
#define PG8_SB(b, h) ((4 + (b) * 2 + (h)) * HTB)
#define PG8_STAGE(bufoff, gbase, voff) do { _Pragma("unroll") for (int _i = 0; _i < 2; ++_i) \
        __builtin_amdgcn_global_load_lds((const unsigned*)((const char*)(gbase) + (voff)[_i]), (PG8_LAS unsigned*)(lds + (bufoff) + ldsw + _i * 8192), 16, 0, 0); } while (0)
#define PG8_LDA(dst, b, h) do { _Pragma("unroll") for (int m = 0; m < 4; ++m) _Pragma("unroll") for (int k = 0; k < 2; ++k) dst[m][k] = *(const PG8_LAS bf16x8*)(lds + PG8_SA(b, h) + aoff + m * 2048 + k * 1024); } while (0)
#define PG8_LDB(dst, b, h) do { _Pragma("unroll") for (int n = 0; n < 2; ++n) _Pragma("unroll") for (int k = 0; k < 2; ++k) dst[n][k] = *(const PG8_LAS bf16x8*)(lds + PG8_SB(b, h) + boff + n * 2048 + k * 1024); } while (0)
#define PG8_MMA(ai, bj, At, Bt) do { __builtin_amdgcn_s_setprio(1); _Pragma("unroll") for (int m = 0; m < 4; ++m) _Pragma("unroll") for (int n = 0; n < 2; ++n) _Pragma("unroll") for (int k = 0; k < 2; ++k) \
        acc[ai][bj][m][n] = __builtin_amdgcn_mfma_f32_16x16x32_bf16(Bt[n][k], At[m][k], acc[ai][bj][m][n], 0, 0, 0); __builtin_amdgcn_s_setprio(0); } while (0)
#define PG8_WAIT_V(n) asm volatile("s_waitcnt vmcnt(" #n ")" ::: "memory")
#define PG8_WAIT_L(n) asm volatile("s_waitcnt lgkmcnt(" #n ")" ::: "memory")
#define PG8_BAR __builtin_amdgcn_s_barrier()
#define PG8_SCHED __builtin_amdgcn_sched_barrier(0)
    Unit cur, nxt; int ui = 0;
    if (!S.next(0, cur)) return;
    f32x4 acc[2][2][4][2];
#pragma unroll
    for (int a = 0; a < 2; ++a)
#pragma unroll
        for (int b = 0; b < 2; ++b)
#pragma unroll
            for (int m = 0; m < 4; ++m)
#pragma unroll
                for (int n = 0; n < 2; ++n) acc[a][b][m][n] = (f32x4){0.f, 0.f, 0.f, 0.f};
    bf16x8 At[4][2], B0[2][2], B1[2][2];
    const char* cA = g.abase(cur); const char* cB = g.bbase(cur);
    S.a_ready(cur);
    if constexpr (SP2) {
        PG8_STAGE(PG8_SB(0, 0), cB, voffB); PG8_STAGE(PG8_SB(0, 1), cB + hstepB, voffB); PG8_STAGE(PG8_SA(0, 0), cA, voffA); PG8_STAGE(PG8_SA(0, 1), cA + hstepA, voffA);
        if (wr == 1) PG8_BAR;
        PG8_WAIT_V(2); PG8_BAR;
        PG8_STAGE(PG8_SB(1, 0), cB + kstep, voffB); PG8_STAGE(PG8_SA(1, 0), cA + kstep, voffA); PG8_STAGE(PG8_SB(1, 1), cB + hstepB + kstep, voffB);
        PG8_WAIT_V(6); PG8_BAR;
    } else {
        PG8_STAGE(PG8_SB(0, 0), cB, voffB); PG8_STAGE(PG8_SA(0, 0), cA, voffA); PG8_STAGE(PG8_SB(0, 1), cB + hstepB, voffB); PG8_STAGE(PG8_SA(0, 1), cA + hstepA, voffA);
        if (wr == 1) PG8_BAR;
        PG8_WAIT_V(4); PG8_BAR;
        PG8_STAGE(PG8_SB(1, 0), cB + kstep, voffB); PG8_STAGE(PG8_SA(1, 0), cA + kstep, voffA); PG8_STAGE(PG8_SB(1, 1), cB + hstepB + kstep, voffB);
        PG8_WAIT_V(6); PG8_BAR;
    }
    for (;;) {
        const bool has_next = S.next(ui + 1, nxt);
        const char* nA = has_next ? g.abase(nxt) : cA; const char* nB = has_next ? g.bbase(nxt) : cB;
        for (int t = 0; t < nt; t += 2) {
            const bool last = (t == nt - 2);
            const char* a1 = cA + (size_t)(t + 1) * kstep;
            const char* a2 = last ? nA : cA + (size_t)(t + 2) * kstep; const char* b2 = last ? nB : cB + (size_t)(t + 2) * kstep;
            const char* a3 = a2 + kstep; const char* b3 = b2 + kstep;
            if (last && has_next) S.a_ready(nxt);
            if constexpr (SP2) {
            PG8_LDB(B0, 0, 0); PG8_LDB(B1, 0, 1); PG8_SCHED; PG8_LDA(At, 0, 0); PG8_STAGE(PG8_SA(1, 1), a1 + hstepA, voffA);
            PG8_WAIT_V(8); PG8_WAIT_L(0); PG8_BAR; PG8_MMA(0, 0, At, B0); PG8_MMA(0, 1, At, B1); PG8_BAR; PG8_SCHED;
            PG8_LDA(At, 0, 1); PG8_STAGE(PG8_SB(0, 0), b2, voffB); PG8_STAGE(PG8_SB(0, 1), b2 + hstepB, voffB); PG8_STAGE(PG8_SA(0, 0), a2, voffA);
            PG8_WAIT_V(8); PG8_WAIT_L(0); PG8_BAR; PG8_MMA(1, 0, At, B0); PG8_MMA(1, 1, At, B1); PG8_BAR; PG8_SCHED;
            PG8_LDB(B0, 1, 0); PG8_LDB(B1, 1, 1); PG8_SCHED; PG8_LDA(At, 1, 0); PG8_STAGE(PG8_SA(0, 1), a2 + hstepA, voffA);
            PG8_WAIT_V(8); PG8_WAIT_L(0); PG8_BAR; PG8_MMA(0, 0, At, B0); PG8_MMA(0, 1, At, B1); PG8_BAR; PG8_SCHED;
            PG8_LDA(At, 1, 1); PG8_STAGE(PG8_SB(1, 0), b3, voffB); PG8_STAGE(PG8_SB(1, 1), b3 + hstepB, voffB); PG8_STAGE(PG8_SA(1, 0), a3, voffA);
            PG8_WAIT_V(8); PG8_WAIT_L(0); PG8_BAR; PG8_MMA(1, 0, At, B0); PG8_MMA(1, 1, At, B1); PG8_BAR; PG8_SCHED;
            } else {
            PG8_LDB(B0, 0, 0); PG8_SCHED; PG8_LDA(At, 0, 0); PG8_STAGE(PG8_SA(1, 1), a1 + hstepA, voffA);
            PG8_WAIT_L(8); PG8_BAR; PG8_WAIT_L(0); PG8_MMA(0, 0, At, B0); PG8_BAR; PG8_SCHED;
            PG8_LDB(B1, 0, 1); PG8_STAGE(PG8_SB(0, 0), b2, voffB);
            PG8_BAR; PG8_WAIT_L(0); PG8_MMA(0, 1, At, B1); PG8_BAR;
            PG8_LDA(At, 0, 1); PG8_STAGE(PG8_SA(0, 0), a2, voffA);
            PG8_BAR; PG8_WAIT_L(0); PG8_MMA(1, 0, At, B0); PG8_BAR; PG8_SCHED;
            PG8_STAGE(PG8_SB(0, 1), b2 + hstepB, voffB);
            PG8_WAIT_V(6); PG8_BAR; PG8_MMA(1, 1, At, B1); PG8_BAR;
            PG8_LDB(B0, 1, 0); PG8_SCHED; PG8_LDA(At, 1, 0); PG8_STAGE(PG8_SA(0, 1), a2 + hstepA, voffA);
            PG8_WAIT_L(8); PG8_BAR; PG8_WAIT_L(0); PG8_MMA(0, 0, At, B0); PG8_BAR; PG8_SCHED;
            PG8_LDB(B1, 1, 1); PG8_STAGE(PG8_SB(1, 0), b3, voffB);
            PG8_BAR; PG8_WAIT_L(0); PG8_MMA(0, 1, At, B1); PG8_BAR;
            PG8_LDA(At, 1, 1); PG8_STAGE(PG8_SA(1, 0), a3, voffA);
            PG8_BAR; PG8_WAIT_L(0); PG8_MMA(1, 0, At, B0); PG8_BAR; PG8_SCHED;
            PG8_STAGE(PG8_SB(1, 1), b3 + hstepB, voffB);
            PG8_WAIT_V(6); PG8_BAR; PG8_MMA(1, 1, At, B1); PG8_BAR;
            }
        }
        if constexpr (ALIGN_EPI) { if (wr == 0) PG8_BAR; }
        if constexpr (!Epi::AFTER_DRAIN) { E(acc, cur, wr, wc, fr, fq); S.done(cur); }
        if (!has_next) break;
#pragma unroll
        for (int a = 0; a < 2; ++a)
#pragma unroll
            for (int b = 0; b < 2; ++b)
#pragma unroll
                for (int m = 0; m < 4; ++m)
#pragma unroll
                    for (int n = 0; n < 2; ++n) acc[a][b][m][n] = (f32x4){0.f, 0.f, 0.f, 0.f};
        cur = nxt; cA = nA; cB = nB; ++ui;
        if constexpr (ALIGN_EPI) { if (wr == 1) PG8_BAR; }
    }
    PG8_WAIT_V(0);
    if constexpr (!ALIGN_EPI) { if (wr == 0) PG8_BAR; }
    PG8_BAR;
    if constexpr (Epi::AFTER_DRAIN) { E.fused(acc, cur, wr, wc, fr, fq, lds, wid, lane); S.done(cur); }
#undef PG8_SA
#undef PG8_SB
#undef PG8_STAGE
#undef PG8_LDA
#undef PG8_LDB
#undef PG8_MMA
#undef PG8_WAIT_V
#undef PG8_WAIT_L
#undef PG8_BAR
#undef PG8_SCHED
}
}

#define GAS __attribute__((address_space(1)))
#define LAS __attribute__((address_space(3)))
typedef unsigned short bf16;
typedef unsigned v4u __attribute__((ext_vector_type(4)));
typedef unsigned v2u __attribute__((ext_vector_type(2)));
typedef float f32x4 __attribute__((ext_vector_type(4)));
typedef float f32x16 __attribute__((ext_vector_type(16)));
typedef short bf16x8 __attribute__((ext_vector_type(8)));
constexpr int NWAVES = 8, NTHREADS = 512;
constexpr int DM = 2048, SEQ = 4096, NMETA = 16, DECB = 32, DECL = 16;
constexpr int NG = 64, NS = 64, DFF = 5632;
constexpr int R_SAMPLE0 = 8192, R_REAL = 8704, R_ALL = 8736, R_PAD = 8960;
constexpr float RMS_EPS = 1e-6f;
constexpr int NSEG = 16;
constexpr size_t O_Y = 0, O_SRE_P = 17825792, O_SIM_P = 17833984, O_POOL_P = 17842176, O_CONV_P = 17872896,
                 O_SRE_S = 17895424, O_SIM_S = 18026496, O_POOL_S = 18157568, O_CONV_S = 18649088;
constexpr size_t MiB = 1u << 20;
constexpr size_t WS_WIN = 0, WS_WGLU = 8 * MiB, WS_WPOOL = 10 * MiB, WS_WOUT = 11 * MiB, WS_WUP = 19 * MiB, WS_WDOWN = 63 * MiB;
constexpr size_t WS_XN = 85 * MiB, WS_U = 120 * MiB, WS_YPRE = 155 * MiB, WS_MB = 173 * MiB, WS_YCAT = 191 * MiB;
constexpr size_t WS_H = 120 * MiB;
constexpr size_t WS_SMALL = 226 * MiB;
constexpr size_t WS_XMETA = WS_SMALL, WS_SS1 = WS_XMETA + 32 * 2048 * 4, WS_SS2 = WS_SS1 + 36864, WS_LBAR = WS_SS2 + 36864, WS_PW = WS_LBAR + 32768,
                 WS_BB = WS_PW + 32768, WS_CC = WS_BB + 262144, WS_EST = WS_CC + 262144, WS_GMETA = WS_EST + 2 * 64 * 16 * 64 * 8;
constexpr size_t WS_GFIX = 230 * MiB, WS_VFIX = 237 * MiB, WS_GSRC = 244 * MiB, WS_END = 250 * MiB;
static_assert(WS_GMETA + 4 * DFF * 4 <= WS_GFIX && WS_H + (size_t)R_REAL * DFF * 2 <= WS_SMALL && 320 * (size_t)DFF * 4 <= 7 * MiB, "ws map");
constexpr int LDS_BYTES = 147456;
constexpr int S5_WLDS = 32 * 528;

__device__ __forceinline__ unsigned f2bf(float f) { unsigned u = __builtin_bit_cast(unsigned, f); return (u + 0x7fffu + ((u >> 16) & 1u)) >> 16; }
__device__ __forceinline__ unsigned pk2(float lo, float hi) { return f2bf(lo) | (f2bf(hi) << 16); }
__device__ __forceinline__ float blo(unsigned w) { return __uint_as_float(w << 16); }
__device__ __forceinline__ float bhi(unsigned w) { return __uint_as_float(w & 0xffff0000u); }
#define LDS_WAIT() asm volatile("s_waitcnt lgkmcnt(0)" ::: "memory")

struct Frame {
    LAS unsigned char* lds; int wave, vcu, G;
    const float* in[27]; float* out; unsigned char* ws;
};
__device__ __forceinline__ int ltid() { int t = threadIdx.x; asm volatile("" : "+v"(t)); return t; }
__device__ __forceinline__ float wave_sum(float v) {
#pragma unroll
    for (int o = 1; o < 64; o <<= 1) v += __shfl_xor(v, o);
    return v;
}
__device__ __forceinline__ void p0_transpose_item(const float* W, int K, int N, bf16* WT, int k0, int n0, int drow0, LAS float* scr, int lane) {
#pragma unroll 8
    for (int i = 0; i < 32; ++i) { const int kk = 2 * i + (lane >> 5); scr[kk * 33 + (lane & 31)] = W[(size_t)(k0 + kk) * N + n0 + (lane & 31)]; }
    LDS_WAIT(); asm volatile("" ::: "memory");
    const int c = lane & 7;
#pragma unroll
    for (int j = 0; j < 4; ++j) { const int n = (lane >> 3) + 8 * j; const LAS float* s = scr + (8 * c) * 33 + n;
        v4u o; o.x = pk2(s[0 * 33], s[1 * 33]); o.y = pk2(s[2 * 33], s[3 * 33]); o.z = pk2(s[4 * 33], s[5 * 33]); o.w = pk2(s[6 * 33], s[7 * 33]);
        *(v4u*)(WT + (size_t)(drow0 + n) * K + k0 + 8 * c) = o; }
    LDS_WAIT(); asm volatile("" ::: "memory");
}
__device__ __forceinline__ const float* xrow(const Frame& F, int R) {
    return R < R_SAMPLE0 ? F.in[0] + (size_t)R * DM : (R < R_REAL ? F.in[1] + (size_t)(R - R_SAMPLE0) * DM : F.in[6] + (size_t)((R - R_REAL) & 15) * DM);
}

__device__ __forceinline__ void p0_prologue(Frame& F) {
    unsigned char* ws = F.ws; const int tid = ltid(), lane = tid & 63;
    LAS float* scr = (LAS float*)(F.lds + F.wave * 16384);
    const int gw = F.vcu * NWAVES + F.wave, NGW = F.G * NWAVES;
    constexpr int I_IN = 32 * 64, I_GLU = 16 * 32, I_POOL = 4 * 4 * 8, I_OUT = 32 * 64, I_UP = 32 * 352, I_DOWN = 88 * 64;
    constexpr int NITEMS = I_IN + I_GLU + I_POOL + I_OUT + I_UP + I_DOWN;
    for (int it = gw; it < NITEMS; it += NGW) {
        int r = it;
        if (r < I_IN) { const int kb = r / 64, nb = r % 64; p0_transpose_item(F.in[8], 2048, 2048, (bf16*)(ws + WS_WIN), 64 * kb, 32 * nb, 32 * nb, scr, lane); continue; } r -= I_IN;
        if (r < I_GLU) { const int kb = r / 32, nb = r % 32; p0_transpose_item(F.in[17], 1024, 1024, (bf16*)(ws + WS_WGLU), 64 * kb, 32 * nb, 32 * nb, scr, lane); continue; } r -= I_GLU;
        if (r < I_POOL) { const int g = r / 32, q = r % 32, kb = q / 8, nb = q % 8; p0_transpose_item(F.in[18] + (size_t)g * 65536, 256, 256, (bf16*)(ws + WS_WPOOL) + (size_t)g * 65536, 64 * kb, 32 * nb, 32 * nb, scr, lane); continue; } r -= I_POOL;
        if (r < I_OUT) { const int kb = r / 64, nb = r % 64; p0_transpose_item(F.in[20], 2048, 2048, (bf16*)(ws + WS_WOUT), 64 * kb, 32 * nb, 32 * nb, scr, lane); continue; } r -= I_OUT;
        if (r < I_UP) { const int kb = r / 352, nb = r % 352, n0 = 32 * nb; const int drow = n0 < DFF ? (n0 / 128) * 256 + (n0 % 128) : ((n0 - DFF) / 128) * 256 + 128 + ((n0 - DFF) % 128);
            p0_transpose_item(F.in[22], 2048, 2 * DFF, (bf16*)(ws + WS_WUP), 64 * kb, n0, drow, scr, lane); continue; } r -= I_UP;
        { const int kb = r / 64, nb = r % 64; p0_transpose_item(F.in[25], DFF, 2048, (bf16*)(ws + WS_WDOWN), 64 * kb, 32 * nb, 32 * nb, scr, lane); }
    }
    const float* gm = F.in[7];
    for (int R = gw; R < R_ALL; R += NGW) {
        const f32x4* xr = (const f32x4*)xrow(F, R) + lane; f32x4 v[8]; float s = 0.f;
#pragma unroll
        for (int j = 0; j < 8; ++j) { v[j] = xr[64 * j]; s += (v[j].x * v[j].x + v[j].y * v[j].y) + (v[j].z * v[j].z + v[j].w * v[j].w); }
        const float rstd = rsqrtf(wave_sum(s) * (1.0f / DM) + RMS_EPS);
        unsigned long long* o8 = (unsigned long long*)((bf16*)(ws + WS_XN) + (size_t)R * DM) + lane;
#pragma unroll
        for (int j = 0; j < 8; ++j) { const f32x4 g = ((const f32x4*)gm)[64 * j + lane];
            o8[64 * j] = (unsigned long long)pk2(v[j].x * rstd * g.x, v[j].y * rstd * g.y) | ((unsigned long long)pk2(v[j].z * rstd * g.z, v[j].w * rstd * g.w) << 32); }
    }
    const int gt = F.vcu * NTHREADS + tid, NGT = F.G * NTHREADS;
    for (int i = gt; i < 2 * 9216; i += NGT) ((float*)(ws + WS_SS1))[i] = 0.f;
    for (int i = gt; i < NG * NS; i += NGT) {
        const int g = i >> 6;
        const float lr = F.in[9][i], li = F.in[10][i], dt = expf(F.in[11][g]);
        const float er = expf(lr * dt); float sn, cs; sn = sinf(li * dt); cs = cosf(li * dt);
        const float br = er * cs, bi = er * sn;
        ((float2*)(ws + WS_LBAR))[i] = make_float2(br, bi);
        float pr = br, pi = bi;
#pragma unroll
        for (int k = 0; k < 8; ++k) { const float nr = pr * pr - pi * pi, ni = 2.f * pr * pi; pr = nr; pi = ni; }
        ((float2*)(ws + WS_PW))[i] = make_float2(pr, pi);
        const float nr = br - 1.f, ni = bi, den = 1.f / (lr * lr + li * li);
        const float cr = (nr * lr + ni * li) * den, ci = (ni * lr - nr * li) * den;
        bf16* bb = (bf16*)(ws + WS_BB) + (size_t)g * 128 * 16; const int p = i & 63;
#pragma unroll
        for (int n = 0; n < 16; ++n) { const float b_r = F.in[12][(size_t)i * 16 + n], b_i = F.in[13][(size_t)i * 16 + n];
            bb[p * 16 + n] = (bf16)f2bf(cr * b_r - ci * b_i); bb[(64 + p) * 16 + n] = (bf16)f2bf(cr * b_i + ci * b_r); }
    }
    for (int i = gt; i < NG * 16 * 128; i += NGT) {
        const int k = i & 127, gn = i >> 7;
        ((bf16*)(ws + WS_CC))[i] = (bf16)f2bf(k < 64 ? F.in[14][(size_t)gn * 64 + k] : -F.in[15][(size_t)gn * 64 + (k - 64)]);
    }
}

struct S5Ctx { bf16x8 bb[4]; bf16x8 cc[8]; float lbr, lbi; int g; };
__device__ __forceinline__ void s5_load_ctx(S5Ctx& c, const Frame& F, int g, int lane) {
    const unsigned char* ws = F.ws; c.g = g;
    const bf16* bb = (const bf16*)(ws + WS_BB) + (size_t)g * 2048; const bf16* cc = (const bf16*)(ws + WS_CC) + (size_t)g * 2048;
#pragma unroll
    for (int cb = 0; cb < 4; ++cb) c.bb[cb] = *(const bf16x8*)(bb + (32 * cb + (lane & 31)) * 16 + 8 * (lane >> 5));
#pragma unroll
    for (int kb = 0; kb < 8; ++kb) { bf16x8 z = {0, 0, 0, 0, 0, 0, 0, 0}; if ((lane & 31) < 16) z = *(const bf16x8*)(cc + (lane & 31) * 128 + 16 * kb + 8 * (lane >> 5)); c.cc[kb] = z; }
    const float2 lb = ((const float2*)(ws + WS_LBAR))[g * 64 + lane]; c.lbr = lb.x; c.lbi = lb.y;
}
template <int NV, bool FULL>
__device__ __forceinline__ void s5_block(const S5Ctx& c, const Frame& F, LAS unsigned char* wl, int row0, float& hr, float& hi, int lane) {
    const bf16* U = (const bf16*)(F.ws + WS_U);
    const int ti = lane & 31, kh = lane >> 5;
    bf16x8 a = {0, 0, 0, 0, 0, 0, 0, 0};
    if (ti < NV) a = *(const bf16x8*)(U + (size_t)(row0 + ti) * 2048 + c.g * 16 + 8 * kh);
    LAS float* L = (LAS float*)wl;
#pragma unroll
    for (int cb = 0; cb < 4; ++cb) {
        f32x16 d = {0.f, 0.f, 0.f, 0.f, 0.f, 0.f, 0.f, 0.f, 0.f, 0.f, 0.f, 0.f, 0.f, 0.f, 0.f, 0.f};
        d = __builtin_amdgcn_mfma_f32_32x32x16_bf16(a, c.bb[cb], d, 0, 0, 0);
#pragma unroll
        for (int r = 0; r < 16; ++r) { const int i = (r & 3) + 8 * (r >> 2) + 4 * kh; if (i < NV) L[i * 132 + 32 * cb + ti] = d[r]; }
    }
    LDS_WAIT(); asm volatile("" ::: "memory");
    float bre[NV], bim[NV];
#pragma unroll
    for (int t = 0; t < NV; ++t) { bre[t] = L[t * 132 + lane]; bim[t] = L[t * 132 + 64 + lane]; }
    LDS_WAIT(); asm volatile("" ::: "memory");
    LAS bf16* Hh = (LAS bf16*)wl;
#pragma unroll
    for (int t = 0; t < NV; ++t) {
        const float nr = c.lbr * hr - c.lbi * hi + bre[t], ni = c.lbr * hi + c.lbi * hr + bim[t]; hr = nr; hi = ni;
        if (FULL) { Hh[t * 264 + lane] = (bf16)f2bf(hr); Hh[t * 264 + 64 + lane] = (bf16)f2bf(hi); }
    }
    if (FULL) {
        LDS_WAIT(); asm volatile("" ::: "memory");
        f32x16 y = {0.f, 0.f, 0.f, 0.f, 0.f, 0.f, 0.f, 0.f, 0.f, 0.f, 0.f, 0.f, 0.f, 0.f, 0.f, 0.f};
#pragma unroll
        for (int kb = 0; kb < 8; ++kb) { const bf16x8 hb = *(const LAS bf16x8*)(wl + ti * 528 + (16 * kb + 8 * kh) * 2); y = __builtin_amdgcn_mfma_f32_32x32x16_bf16(c.cc[kb], hb, y, 0, 0, 0); }
        LDS_WAIT(); asm volatile("" ::: "memory");
        if (ti < NV) {
            const float* dsk = F.in[16] + c.g * 16; bf16* YP = (bf16*)(F.ws + WS_YPRE) + (size_t)(row0 + ti) * 1024 + c.g * 16;
            const bf16* ur = U + (size_t)(row0 + ti) * 2048 + c.g * 16;
#pragma unroll
            for (int rr = 0; rr < 2; ++rr) { const int n0 = 8 * rr + 4 * kh; const v2u uu = *(const v2u*)(ur + n0); const f32x4 dd = *(const f32x4*)(dsk + n0);
                const float y0 = pg8::gelu_tanh(y[4 * rr + 0] + dd.x * blo(uu.x)), y1 = pg8::gelu_tanh(y[4 * rr + 1] + dd.y * bhi(uu.x)),
                            y2 = pg8::gelu_tanh(y[4 * rr + 2] + dd.z * blo(uu.y)), y3 = pg8::gelu_tanh(y[4 * rr + 3] + dd.w * bhi(uu.y));
                v2u o; o.x = pk2(y0, y1); o.y = pk2(y2, y3); *(v2u*)(YP + n0) = o; }
        }
    }
}
template <bool FULL>
__device__ __forceinline__ void s5_prompt_item(const Frame& F, LAS unsigned char* wl, int item, int lane) {
    const int seg = item & (NSEG - 1), g = (item >> 4) & 63, b = item >> 10;
    float2* est = (float2*)(F.ws + WS_EST) + ((size_t)(b * 64 + g) * NSEG) * 64;
    if (!FULL && seg == NSEG - 1) return;
    S5Ctx c; s5_load_ctx(c, F, g, lane);
    float hr = 0.f, hi = 0.f;
    if (FULL) { const float2 pw = ((const float2*)(F.ws + WS_PW))[g * 64 + lane];
        for (int s = 0; s < seg; ++s) { const float2 e = est[s * 64 + lane]; const float nr = pw.x * hr - pw.y * hi + e.x, ni = pw.x * hi + pw.y * hr + e.y; hr = nr; hi = ni; } }
    if (seg == 0) s5_block<16, FULL>(c, F, wl, R_REAL + 16 * b, hr, hi, lane);
    for (int j = 0; j < 8; ++j) s5_block<32, FULL>(c, F, wl, SEQ * b + 32 * (8 * seg + j), hr, hi, lane);
    if (!FULL) est[seg * 64 + lane] = make_float2(hr, hi);
    else if (seg == NSEG - 1) { F.out[O_SRE_P + (size_t)(b * 64 + g) * 64 + lane] = hr; F.out[O_SIM_P + (size_t)(b * 64 + g) * 64 + lane] = hi; }
}
__device__ __forceinline__ void s5_sample_item(const Frame& F, LAS unsigned char* wl, int item, int lane) {
    const int g = item & 63, s = item >> 6;
    S5Ctx c; s5_load_ctx(c, F, g, lane);
    float hr = F.in[2][(size_t)(s * 64 + g) * 64 + lane], hi = F.in[3][(size_t)(s * 64 + g) * 64 + lane];
    s5_block<16, true>(c, F, wl, R_SAMPLE0 + 16 * s, hr, hi, lane);
    F.out[O_SRE_S + (size_t)(s * 64 + g) * 64 + lane] = hr; F.out[O_SIM_S + (size_t)(s * 64 + g) * 64 + lane] = hi;
}

__device__ __forceinline__ void pool_m_phase(const Frame& F) {
    const bf16* U = (const bf16*)(F.ws + WS_U); bf16* MB = (bf16*)(F.ws + WS_MB); const int tid = ltid();
    const int sub = tid >> 7, t128 = tid & 127, c0 = 8 * t128, w = 2 << (c0 >> 8);
    for (int run = F.vcu * 4 + sub; run < 546; run += F.G * 4) {
        float s[8];
#pragma unroll
        for (int e = 0; e < 8; ++e) s[e] = 0.f;
        const bool samp = run >= 514; int rowbase, pos0; const float* hist = nullptr;
        if (samp) { const int sq = run - 514; rowbase = R_SAMPLE0 + 16 * sq; pos0 = 0; hist = F.in[4] + (size_t)sq * 15 * 1024 + c0; }
        else { const int b = run / 257, j = run % 257; pos0 = 16 * j; rowbase = j == 0 ? R_REAL + 16 * b : SEQ * b + 16 * (j - 1); }
        auto loadz = [&](int rel, float (&z)[8]) {
            if (samp) {
                if (rel >= 0) { const v4u q = *(const v4u*)(U + (size_t)(rowbase + rel) * 2048 + 1024 + c0); z[0] = blo(q.x); z[1] = bhi(q.x); z[2] = blo(q.y); z[3] = bhi(q.y); z[4] = blo(q.z); z[5] = bhi(q.z); z[6] = blo(q.w); z[7] = bhi(q.w); }
                else { const f32x4 a = *(const f32x4*)(hist + (size_t)(15 + rel) * 1024), b2 = *(const f32x4*)(hist + (size_t)(15 + rel) * 1024 + 4); z[0] = a.x; z[1] = a.y; z[2] = a.z; z[3] = a.w; z[4] = b2.x; z[5] = b2.y; z[6] = b2.z; z[7] = b2.w; }
            } else {
                const int pos = pos0 + rel;
                if (pos < 0) {
#pragma unroll
                    for (int e = 0; e < 8; ++e) z[e] = 0.f;
                } else {
                    const int b = run / 257; const int row = pos < 16 ? R_REAL + 16 * b + pos : SEQ * b + (pos - 16);
                    const v4u q = *(const v4u*)(U + (size_t)row * 2048 + 1024 + c0); z[0] = blo(q.x); z[1] = bhi(q.x); z[2] = blo(q.y); z[3] = bhi(q.y); z[4] = blo(q.z); z[5] = bhi(q.z); z[6] = blo(q.w); z[7] = bhi(q.w);
                }
            }
        };
        float z[8];
        for (int jj = 1; jj < w; ++jj) { loadz(-jj, z);
#pragma unroll
            for (int e = 0; e < 8; ++e) s[e] += z[e]; }
        for (int t = 0; t < 16; ++t) {
            loadz(t, z);
            const int pos = pos0 + t; const float inv = 1.0f / (float)((samp || pos + 1 >= w) ? w : pos + 1);
            float mo[8];
#pragma unroll
            for (int e = 0; e < 8; ++e) { s[e] += z[e]; mo[e] = s[e] * inv - z[e]; }
            v4u o; o.x = pk2(mo[0], mo[1]); o.y = pk2(mo[2], mo[3]); o.z = pk2(mo[4], mo[5]); o.w = pk2(mo[6], mo[7]);
            *(v4u*)(MB + (size_t)(rowbase + t) * 1024 + c0) = o;
            float zo[8]; loadz(t - w + 1, zo);
#pragma unroll
            for (int e = 0; e < 8; ++e) s[e] -= zo[e];
        }
    }
    const int gt = F.vcu * NTHREADS + tid, NGT = F.G * NTHREADS;
    for (int i = gt; i < (2 + 32) * 15 * 256; i += NGT) {
        const int c4 = (i & 255) * 4, q = i >> 8, r = q % 15, sq = q / 15;
        const int row = sq < 2 ? SEQ * sq + 4081 + r : R_SAMPLE0 + 16 * (sq - 2) + 1 + r;
        const v2u uu = *(const v2u*)(U + (size_t)row * 2048 + 1024 + c4);
        float* dst = sq < 2 ? F.out + O_POOL_P + (size_t)(sq * 15 + r) * 1024 + c4 : F.out + O_POOL_S + (size_t)((sq - 2) * 15 + r) * 1024 + c4;
        *(f32x4*)dst = (f32x4){blo(uu.x), bhi(uu.x), blo(uu.y), bhi(uu.y)};
    }
}

__device__ __forceinline__ void gmeta_phase(const Frame& F) {
    const bf16* XN = (const bf16*)(F.ws + WS_XN); const bf16* WU = (const bf16*)(F.ws + WS_WUP); const float* ss = (const float*)(F.ws + WS_SS1); float* GM = (float*)(F.ws + WS_GMETA);
    const int gw = F.vcu * NWAVES + F.wave, NGW = F.G * NWAVES; const int lane = ltid() & 63;
    for (int j = gw; j < DFF; j += NGW) {
        const bf16* wr_ = WU + (size_t)((j >> 7) * 256 + (j & 127)) * 2048;
        float a[4] = {0.f, 0.f, 0.f, 0.f};
#pragma unroll
        for (int i = 0; i < 4; ++i) { const int c = 8 * lane + 512 * i; const v4u wv = *(const v4u*)(wr_ + c);
            const float wf[8] = {blo(wv.x), bhi(wv.x), blo(wv.y), bhi(wv.y), blo(wv.z), bhi(wv.z), blo(wv.w), bhi(wv.w)};
#pragma unroll
            for (int q = 0; q < 4; ++q) { const int Rm = R_REAL + 16 * (q >> 1) + 14 + (q & 1); const v4u xv = *(const v4u*)(XN + (size_t)Rm * 2048 + c);
                a[q] += wf[0] * blo(xv.x) + wf[1] * bhi(xv.x) + wf[2] * blo(xv.y) + wf[3] * bhi(xv.y) + wf[4] * blo(xv.z) + wf[5] * bhi(xv.z) + wf[6] * blo(xv.w) + wf[7] * bhi(xv.w); } }
#pragma unroll
        for (int q = 0; q < 4; ++q) { a[q] = wave_sum(a[q]); }
        if (lane < 4) { const int q = lane; const int Rm = R_REAL + 16 * (q >> 1) + 14 + (q & 1); const float v = q == 0 ? a[0] : (q == 1 ? a[1] : (q == 2 ? a[2] : a[3]));
            GM[(size_t)q * DFF + j] = v * rsqrtf(ss[Rm] * (1.0f / DM) + RMS_EPS); }
    }
}

__device__ __forceinline__ void fixup_phase(const Frame& F) {
    const float* GF = (const float*)(F.ws + WS_GFIX); const float* VF = (const float*)(F.ws + WS_VFIX); const float* GS = (const float*)(F.ws + WS_GSRC); const float* GM = (const float*)(F.ws + WS_GMETA);
    const float* cw = F.in[23]; const float* cb = F.in[24]; const float* hist = F.in[5]; bf16* H = (bf16*)(F.ws + WS_H);
    const int tid = ltid(); const int gt = F.vcu * NTHREADS + tid, NGT = F.G * NTHREADS;
    for (int idx = gt; idx < 320 * 1408; idx += NGT) {
        const int id = idx / 1408, j = (idx % 1408) * 4;
        const f32x4 g0 = *(const f32x4*)(GF + (size_t)id * DFF + j), v0 = *(const f32x4*)(VF + (size_t)id * DFF + j);
        f32x4 p1, p2; int R;
        if (id < 256) {
            const int pm = id >> 3, blk = (id & 7) >> 1, rr = id & 1; R = 256 * pm + 64 * blk + rr;
            const bool start = blk == 0 && (pm == 0 || pm == 16);
            const float* S0; const float* S1;
            if (start) { const int b = pm >> 4; S0 = GM + (size_t)(b * 2 + 0) * DFF; S1 = GM + (size_t)(b * 2 + 1) * DFF; }
            else { const int sb = blk > 0 ? pm * 8 + (blk - 1) * 2 : (pm - 1) * 8 + 6; S0 = GS + (size_t)sb * DFF; S1 = GS + (size_t)(sb + 1) * DFF; }
            if (rr == 0) { p1 = *(const f32x4*)(S1 + j); p2 = *(const f32x4*)(S0 + j); }
            else { p1 = *(const f32x4*)(GF + (size_t)(id - 1) * DFF + j); p2 = *(const f32x4*)(S1 + j); }
        } else {
            const int q = id - 256, sq = q >> 1, rr = q & 1; R = R_SAMPLE0 + 16 * sq + rr;
            const float* h0 = hist + (size_t)(sq * 2 + 0) * DFF; const float* h1 = hist + (size_t)(sq * 2 + 1) * DFF;
            if (rr == 0) { p1 = *(const f32x4*)(h1 + j); p2 = *(const f32x4*)(h0 + j); }
            else { p1 = *(const f32x4*)(GF + (size_t)(id - 1) * DFF + j); p2 = *(const f32x4*)(h1 + j); }
        }
        const f32x4 w0 = *(const f32x4*)(cw + j), w1 = *(const f32x4*)(cw + DFF + j), w2 = *(const f32x4*)(cw + 2 * DFF + j), bb = *(const f32x4*)(cb + j);
        const f32x4 gc = bb + p2 * w0 + p1 * w1 + g0 * w2;
        v2u o; o.x = pk2(pg8::gelu_tanh(gc.x) * v0.x, pg8::gelu_tanh(gc.y) * v0.y); o.y = pk2(pg8::gelu_tanh(gc.z) * v0.z, pg8::gelu_tanh(gc.w) * v0.w);
        *(v2u*)(H + (size_t)R * DFF + j) = o;
    }
}
__device__ __forceinline__ void final_phase(const Frame& F) {
    const float* ss = (const float*)(F.ws + WS_SS2); const float* gf = F.in[26];
    const int gw = F.vcu * NWAVES + F.wave, NGW = F.G * NWAVES; const int lane = ltid() & 63;
    for (int R = gw; R < R_REAL; R += NGW) {
        const float rstd = rsqrtf(ss[R] * (1.0f / DM) + RMS_EPS);
        f32x4* xr = (f32x4*)(F.out + (size_t)R * DM) + lane;
#pragma unroll
        for (int j = 0; j < 8; ++j) { const f32x4 g = ((const f32x4*)gf)[64 * j + lane]; xr[64 * j] = xr[64 * j] * rstd * g; }
    }
}

struct Args { const float* in[27]; float* out; unsigned char* ws; };
#ifndef MK_LAST_PHASE
#define MK_LAST_PHASE 99
#endif
__global__ void __launch_bounds__(NTHREADS, 2) hymba_fwd(Args args) {
    extern __shared__ __attribute__((aligned(16))) unsigned char lds[];
    cg::grid_group grid = cg::this_grid();
    Frame F;
    F.lds = (LAS unsigned char*)lds;
    F.wave = __builtin_amdgcn_readfirstlane((int)threadIdx.x >> 6);
    F.G = gridDim.x; { const int bx = blockIdx.x; F.vcu = (F.G % 8 == 0) ? (bx % 8) * (F.G / 8) + bx / 8 : bx; }
#pragma unroll
    for (int i = 0; i < 27; ++i) F.in[i] = args.in[i];
    F.out = args.out; F.ws = args.ws;
    unsigned char* ws = F.ws;
    bf16* XN = (bf16*)(ws + WS_XN); bf16* U = (bf16*)(ws + WS_U); bf16* YPRE = (bf16*)(ws + WS_YPRE); bf16* MB = (bf16*)(ws + WS_MB); bf16* YCAT = (bf16*)(ws + WS_YCAT); bf16* H = (bf16*)(ws + WS_H);
    float* SS1 = (float*)(ws + WS_SS1); float* SS2 = (float*)(ws + WS_SS2);
    const int gw = F.vcu * NWAVES + F.wave, NGW = F.G * NWAVES;
    LAS unsigned char* wl = F.lds + F.wave * S5_WLDS;

    p0_prologue(F);
    grid.sync();
    { pg8::Gemm g{XN, (const bf16*)(ws + WS_WIN), 2048, 2048, 2048, 0}; pg8::StaticOrder S; S.init(35, 8, F.G, (int)blockIdx.x);
      pg8::EpiBf16 E{U, 2048}; pg8::gemm_phase<pg8::EpiBf16, pg8::StaticOrder, true, true>(F.lds, g, S, E); }
    grid.sync();
    for (int it = gw; it < 2 * 64 * NSEG; it += NGW) s5_prompt_item<false>(F, wl, it, ltid() & 63);
    for (int it = gw; it < DECB * 64; it += NGW) s5_sample_item(F, wl, it, ltid() & 63);
    pool_m_phase(F);
    grid.sync();
    for (int it = gw; it < 2 * 64 * NSEG; it += NGW) s5_prompt_item<true>(F, wl, it, ltid() & 63);
    __syncthreads();
    { pg8::Gemm g{MB, (const bf16*)(ws + WS_WPOOL), 1024, 256, 256, 256}; pg8::StaticOrder S; S.init(35, 4, F.G, (int)blockIdx.x);
      pg8::EpiPool E{YCAT, F.in[19]}; pg8::gemm_phase<pg8::EpiPool, pg8::StaticOrder, true, true>(F.lds, g, S, E); }
    grid.sync();
    { pg8::Gemm g{YPRE, (const bf16*)(ws + WS_WGLU), 1024, 1024, 1024, 0}; pg8::StaticOrder S; S.init(35, 4, F.G, (int)blockIdx.x);
      pg8::EpiGlu E{YPRE, YCAT}; pg8::gemm_phase<pg8::EpiGlu, pg8::StaticOrder, true, true>(F.lds, g, S, E); }
    grid.sync();
    { pg8::Gemm g{YCAT, (const bf16*)(ws + WS_WOUT), 2048, 2048, 2048, 0}; pg8::StaticOrder S; S.init(35, 8, F.G, (int)blockIdx.x);
      pg8::EpiOut E{F.in[0], F.in[1], F.in[6], F.in[21], F.out, (float*)(ws + WS_XMETA), XN, SS1};
      pg8::gemm_phase<pg8::EpiOut, pg8::StaticOrder, true, true>(F.lds, g, S, E); }
    grid.sync();
    gmeta_phase(F);
    { pg8::Gemm g{XN, (const bf16*)(ws + WS_WUP), 2048, 2048, 2048, 0}; pg8::StaticOrder S; S.init(34, 44, F.G, (int)blockIdx.x);
      pg8::EpiUp E{SS1, F.in[23], F.in[24], H, (float*)(ws + WS_GFIX), (float*)(ws + WS_VFIX), (float*)(ws + WS_GSRC), F.out + O_CONV_P, F.out + O_CONV_S};
      pg8::gemm_phase<pg8::EpiUp, pg8::StaticOrder, true, true>(F.lds, g, S, E); }
    grid.sync();
    fixup_phase(F);
    grid.sync();
    { pg8::Gemm g{H, (const bf16*)(ws + WS_WDOWN), DFF, DFF, DFF, 0}; pg8::StaticOrder S; S.init(34, 8, F.G, (int)blockIdx.x);
      pg8::EpiDown E{F.out, SS2}; pg8::gemm_phase<pg8::EpiDown, pg8::StaticOrder, true, true>(F.lds, g, S, E); }
    grid.sync();
    final_phase(F);
}

extern "C" void kernel_launch(void* const* d_in, const int* in_sizes, int n_in, void* d_out, int out_size, void* d_ws, size_t ws_size, hipStream_t stream) {
    static int grid = 0;
    if (grid == 0) {
        if (n_in != 27 || out_size != 19009536 || ws_size < WS_END) { fprintf(stderr, "kernel_launch: unexpected shapes (n_in %d, out %d, ws %zu)\n", n_in, out_size, ws_size); grid = -1; return; }
        int dev = 0, cus = 0, per_cu = 0;
        if (hipGetDevice(&dev) != hipSuccess || hipDeviceGetAttribute(&cus, hipDeviceAttributeMultiprocessorCount, dev) != hipSuccess) { grid = -1; return; }
        if (hipFuncSetAttribute((const void*)hymba_fwd, hipFuncAttributeMaxDynamicSharedMemorySize, LDS_BYTES) != hipSuccess) { fprintf(stderr, "kernel_launch: hipFuncSetAttribute failed\n"); grid = -1; return; }
        if (hipOccupancyMaxActiveBlocksPerMultiprocessor(&per_cu, (const void*)hymba_fwd, NTHREADS, LDS_BYTES) != hipSuccess || per_cu < 1) { fprintf(stderr, "kernel_launch: occupancy query says %d\n", per_cu); per_cu = 1; }
        (void)hipGetLastError();
        grid = cus;
    }
    if (grid < 0) return;
    Args a{};
    for (int i = 0; i < 27; ++i) a.in[i] = (const float*)d_in[i];
    a.out = (float*)d_out; a.ws = (unsigned char*)d_ws;
    void* kargs[] = {&a};
    hipError_t e = hipLaunchCooperativeKernel((const void*)hymba_fwd, dim3(grid), dim3(NTHREADS), kargs, LDS_BYTES, stream);
    if (e != hipSuccess) fprintf(stderr, "kernel_launch: cooperative launch failed: %s (grid %d)\n", hipGetErrorString(e), grid);
}
```

```cpp
#include <hip/hip_runtime.h>
#include <hip/hip_cooperative_groups.h>
#include <cstdio>
#include <cstdint>
namespace cg = cooperative_groups;

namespace pg8 {
#define PG8_LAS __attribute__((address_space(3)))
typedef unsigned short bf16_t;
typedef short bf16x8 __attribute__((ext_vector_type(8)));
typedef float f32x4 __attribute__((ext_vector_type(4)));
typedef float f32x2 __attribute__((ext_vector_type(2)));
typedef unsigned u32x4 __attribute__((ext_vector_type(4)));
typedef unsigned u32x2 __attribute__((ext_vector_type(2)));
constexpr int BM = 256, BK = 64, HALF = 128, HTB = HALF * BK * 2  , STAGE_BYTES = 8 * HTB, NXCD = 8, WGM = 8;

__host__ __device__ __forceinline__ int lds_byte(int r, int c) { const int st = (r >> 4) * 2 + (c >> 5), rr = r & 15, cc = c & 31, ob = rr * 64 + cc * 2; return st * 1024 + (ob ^ (((ob >> 9) & 1) << 5)); }
__host__ __device__ __forceinline__ void stage_rc(int b, int& R, int& C) { const int st = b / 1024, sb = b % 1024, swz = sb ^ (((sb >> 9) & 1) << 5); R = (st >> 1) * 16 + swz / 64; C = (st & 1) * 32 + (swz % 64) / 2; }
__host__ __device__ __forceinline__ int perm32(int rho) { const int n = rho >> 4, i = rho & 15; return 8 * (i >> 2) + 4 * n + (i & 3); }

struct Unit { int pm, pn, k0, nt, kind, nwait; };
struct Gemm {
    const bf16_t* A; const bf16_t* Bt; int lda, ldb, K, a_pn_off;
    __device__ __forceinline__ const char* abase(const Unit& u) const { return (const char*)(A + ((size_t)u.pm * BM * lda + (size_t)u.pn * a_pn_off + (size_t)u.k0 * BK)); }
    __device__ __forceinline__ const char* bbase(const Unit& u) const { return (const char*)(Bt + ((size_t)u.pn * BM * ldb + (size_t)u.k0 * BK)); }
};

struct StaticOrder {
    int nM, nN, nwg, G, c, ntile;
    __host__ __device__ void init(int nM_, int nN_, int ntile_, int G_, int c_) { nM = nM_; nN = nN_; nwg = nM * nN; ntile = ntile_; G = G_; c = c_; }
    __host__ __device__ bool next(int i, Unit& u) const { const long L = (long)i * G + c; if (L >= nwg) return false; map((int)L, u); return true; }
    __host__ __device__ bool map(int L, Unit& u) const {
        int wgid = L; { const int q = nwg / NXCD, r = nwg % NXCD, xcd = wgid % NXCD, off = wgid / NXCD; wgid = (xcd < r ? xcd * (q + 1) : r * (q + 1) + (xcd - r) * q) + off; }
        const int nig = WGM * nN, gid = wgid / nig, fm = gid * WGM, gsz = (nM - fm) < WGM ? (nM - fm) : WGM;
        u.pm = fm + ((wgid % nig) % gsz); u.pn = (wgid % nig) / gsz; u.k0 = 0; u.nt = ntile; u.kind = 0; u.nwait = 0; return true;
    }
    __device__ __forceinline__ void a_ready(const Unit&) const {}
    __device__ __forceinline__ void done(const Unit&) const {}
};

struct RemSplit {
    StaticOrder so; int q, R, S, P, c;
    __device__ void init(int nM_, int nN_, int P_, int S_, int G_, int c_) { so.init(nM_, nN_, 2 * P_, G_, c_); q = so.nwg / G_; R = so.nwg % G_; S = S_; P = P_; c = c_; }
    __device__ bool next(int i, Unit& u) const {
        if (c < R * S) { if (i == 0) { so.map(q * so.G + c / S, u); const int sl = c % S, lo = sl * P / S, hi = (sl + 1) * P / S; u.k0 = 2 * lo; u.nt = 2 * (hi - lo); u.kind = 1; return true; } i -= 1; }
        if (i >= q) return false; so.map(i * so.G + c, u); return true;
    }
    __device__ bool reducer(Unit& u, unsigned& mask, int& base) const {
        if (c >= R * S) return false; so.map(q * so.G + c / S, u); base = (c / S) * S; const int j = c % S;
        mask = S == 16 ? 1u << ((j >> 3) * 8 + ((j >> 1) & 3) * 2 + (j & 1)) : 3u << ((j >> 2) * 8 + (j & 3) * 2); return true;
    }
    __device__ __forceinline__ void a_ready(const Unit&) const {}
    __device__ __forceinline__ void done(const Unit&) const {}
};
struct SKBuf { float* slots; unsigned* flags; int v; };

__device__ __forceinline__ unsigned cvt_pk_bf16(float lo, float hi) { unsigned r; asm volatile("v_cvt_pk_bf16_f32 %0, %1, %2" : "=v"(r) : "v"(lo), "v"(hi)); return r; }
__device__ __forceinline__ float bflo(unsigned w) { return __uint_as_float(w << 16); }
__device__ __forceinline__ float bfhi(unsigned w) { return __uint_as_float(w & 0xffff0000u); }
__device__ __forceinline__ float gelu_tanh(float x) {
    const float u = x * (1.0f + 0.044715f * x * x);
    const float e = __builtin_amdgcn_exp2f(u * (-2.0f * 0.7978845608028654f * 1.4426950408889634f));
    return x * __builtin_amdgcn_rcpf(1.0f + e);
}
__device__ __forceinline__ float sigmoidf_(float x) { return __builtin_amdgcn_rcpf(1.0f + __builtin_amdgcn_exp2f(x * -1.4426950408889634f)); }

struct EpiBf16 {
    static constexpr bool PERM = true, AFTER_DRAIN = false;
    bf16_t* O; int ldc;
    __device__ __forceinline__ void operator()(const f32x4 (&acc)[2][2][4][2], const Unit& u, int wr, int wc, int fr, int fq, unsigned mask = 0xFFFFu) const {
        const int row0 = u.pm * BM + wr * 64 + fr; const int col0 = u.pn * BM + wc * 32 + 8 * fq;
#pragma unroll
        for (int ai = 0; ai < 2; ++ai)
#pragma unroll
            for (int m = 0; m < 4; ++m) { bf16_t* rowp = O + (size_t)(row0 + ai * HALF + m * 16) * ldc + col0;
#pragma unroll
                for (int bj = 0; bj < 2; ++bj) { if (!((mask >> (ai * 8 + m * 2 + bj)) & 1u)) continue; const f32x4 v0 = acc[ai][bj][m][0], v1 = acc[ai][bj][m][1];
                    u32x4 w; w.x = cvt_pk_bf16(v0[0], v0[1]); w.y = cvt_pk_bf16(v0[2], v0[3]); w.z = cvt_pk_bf16(v1[0], v1[1]); w.w = cvt_pk_bf16(v1[2], v1[3]);
                    *(u32x4*)(rowp + bj * HALF) = w; } }
    }
};
struct EpiF {
    static constexpr bool PERM = true, AFTER_DRAIN = false;
    bf16_t* Oa; bf16_t* Ob; int split;
    __device__ __forceinline__ void operator()(const f32x4 (&acc)[2][2][4][2], const Unit& u, int wr, int wc, int fr, int fq, unsigned mask = 0xFFFFu) const {
        const int rowt = u.pm * BM; bf16_t* base = rowt < split ? Oa + (size_t)rowt * 2048 : Ob + (size_t)(rowt - split) * 2048;
        const int row0 = wr * 64 + fr; const int col0 = u.pn * BM + wc * 32 + 8 * fq;
#pragma unroll
        for (int ai = 0; ai < 2; ++ai)
#pragma unroll
            for (int m = 0; m < 4; ++m) { bf16_t* rowp = base + (size_t)(row0 + ai * HALF + m * 16) * 2048 + col0;
#pragma unroll
                for (int bj = 0; bj < 2; ++bj) { if (!((mask >> (ai * 8 + m * 2 + bj)) & 1u)) continue; const f32x4 v0 = acc[ai][bj][m][0], v1 = acc[ai][bj][m][1];
                    u32x4 w; w.x = cvt_pk_bf16(v0[0], v0[1]); w.y = cvt_pk_bf16(v0[2], v0[3]); w.z = cvt_pk_bf16(v1[0], v1[1]); w.w = cvt_pk_bf16(v1[2], v1[3]);
                    *(u32x4*)(rowp + bj * HALF) = w; } }
    }
};
struct EpiPool {
    static constexpr bool PERM = true, AFTER_DRAIN = false;
    bf16_t* O; const float* scale;
    __device__ __forceinline__ void operator()(const f32x4 (&acc)[2][2][4][2], const Unit& u, int wr, int wc, int fr, int fq) const {
        const int row0 = u.pm * BM + wr * 64 + fr; const int c0 = u.pn * BM + wc * 32 + 8 * fq;
        f32x4 sv[2][2];
#pragma unroll
        for (int bj = 0; bj < 2; ++bj)
#pragma unroll
            for (int n = 0; n < 2; ++n) sv[bj][n] = *(const f32x4*)(scale + c0 + bj * HALF + 4 * n);
#pragma unroll
        for (int ai = 0; ai < 2; ++ai)
#pragma unroll
            for (int m = 0; m < 4; ++m) { bf16_t* rowp = O + (size_t)(row0 + ai * HALF + m * 16) * 2112 + 1024 + c0;
#pragma unroll
                for (int bj = 0; bj < 2; ++bj) { const f32x4 v0 = acc[ai][bj][m][0] * sv[bj][0], v1 = acc[ai][bj][m][1] * sv[bj][1];
                    u32x4 w; w.x = cvt_pk_bf16(v0[0], v0[1]); w.y = cvt_pk_bf16(v0[2], v0[3]); w.z = cvt_pk_bf16(v1[0], v1[1]); w.w = cvt_pk_bf16(v1[2], v1[3]);
                    *(u32x4*)(rowp + bj * HALF) = w; } }
    }
};
struct EpiGlu {
    static constexpr bool PERM = true, AFTER_DRAIN = false;
    const bf16_t* YP; bf16_t* O;
    __device__ __forceinline__ void operator()(const f32x4 (&acc)[2][2][4][2], const Unit& u, int wr, int wc, int fr, int fq) const {
        const int row0 = u.pm * BM + wr * 64 + fr; const int c0 = u.pn * BM + wc * 32 + 8 * fq;
        u32x4 yp[2][4][2];
#pragma unroll
        for (int ai = 0; ai < 2; ++ai)
#pragma unroll
            for (int m = 0; m < 4; ++m)
#pragma unroll
                for (int bj = 0; bj < 2; ++bj) yp[ai][m][bj] = *(const u32x4*)(YP + (size_t)(row0 + ai * HALF + m * 16) * 1024 + c0 + bj * HALF);
#pragma unroll
        for (int ai = 0; ai < 2; ++ai)
#pragma unroll
            for (int m = 0; m < 4; ++m) { const size_t R = (size_t)(row0 + ai * HALF + m * 16);
#pragma unroll
                for (int bj = 0; bj < 2; ++bj) { const u32x4 y = yp[ai][m][bj];
                    const f32x4 a = acc[ai][bj][m][0], b = acc[ai][bj][m][1];
                    u32x4 w;
                    w.x = cvt_pk_bf16(bflo(y.x) * sigmoidf_(a[0]), bfhi(y.x) * sigmoidf_(a[1]));
                    w.y = cvt_pk_bf16(bflo(y.y) * sigmoidf_(a[2]), bfhi(y.y) * sigmoidf_(a[3]));
                    w.z = cvt_pk_bf16(bflo(y.z) * sigmoidf_(b[0]), bfhi(y.z) * sigmoidf_(b[1]));
                    w.w = cvt_pk_bf16(bflo(y.w) * sigmoidf_(b[2]), bfhi(y.w) * sigmoidf_(b[3]));
                    *(u32x4*)(O + R * 2112 + c0 + bj * HALF) = w; } }
    }
};
constexpr int R_SAMPLE0 = 8192, R_REAL = 8704, R_ALL = 8736, R_PAD = 8960;
constexpr int LDP = 2112;
struct EpiOut {
    static constexpr bool PERM = false, AFTER_DRAIN = false;
    const float *irs0, *gmix, *gffn; bf16_t* XN; float* ss;
    __device__ __forceinline__ void operator()(const f32x4 (&acc)[2][2][4][2], const Unit& u, int wr, int wc, int fr, int fq, unsigned mask = 0xFFFFu) const {
        const int col0 = u.pn * BM + wc * 32 + 4 * fq;
        f32x4 gv[2][2], rm[2][2];
#pragma unroll
        for (int bj = 0; bj < 2; ++bj)
#pragma unroll
            for (int n = 0; n < 2; ++n) { gv[bj][n] = *(const f32x4*)(gffn + col0 + bj * HALF + n * 16); const f32x4 g = *(const f32x4*)(gmix + col0 + bj * HALF + n * 16); rm[bj][n] = (f32x4){1.0f / g[0], 1.0f / g[1], 1.0f / g[2], 1.0f / g[3]}; }
#pragma unroll
        for (int ai = 0; ai < 2; ++ai)
#pragma unroll
            for (int m = 0; m < 4; ++m) { if (!((mask >> (ai * 8 + m * 2)) & 3u)) continue; const int R = u.pm * BM + ai * HALF + wr * 64 + m * 16 + fr; float s = 0.f;
                if (R < R_ALL) {
                    const float ir = irs0[R];
                    bf16_t* xn = XN + (size_t)R * LDP;
#pragma unroll
                    for (int bj = 0; bj < 2; ++bj)
#pragma unroll
                        for (int n = 0; n < 2; ++n) { if (!((mask >> (ai * 8 + m * 2 + bj)) & 1u)) continue; const int c = col0 + bj * HALF + n * 16; const u32x2 xq = *(const u32x2*)(xn + c);
                            const f32x4 x1 = (f32x4){bflo(xq.x), bfhi(xq.x), bflo(xq.y), bfhi(xq.y)} * rm[bj][n] * ir + acc[ai][bj][m][n];
                            s += (x1[0] * x1[0] + x1[1] * x1[1]) + (x1[2] * x1[2] + x1[3] * x1[3]);
                            const f32x4 xg = x1 * gv[bj][n]; u32x2 w; w.x = cvt_pk_bf16(xg[0], xg[1]); w.y = cvt_pk_bf16(xg[2], xg[3]); *(u32x2*)(xn + c) = w; }
                }
                s += __shfl_xor(s, 16); s += __shfl_xor(s, 32);
                if (fq == 0 && R < R_ALL) atomicAdd(ss + R, s); }
    }
};
struct EpiDown {
    static constexpr bool PERM = false, AFTER_DRAIN = false;
    float* out; float* ss;
    __device__ __forceinline__ void operator()(const f32x4 (&acc)[2][2][4][2], const Unit& u, int wr, int wc, int fr, int fq, unsigned mask = 0xFFFFu) const {
        const int col0 = u.pn * BM + wc * 32 + 4 * fq;
#pragma unroll
        for (int ai = 0; ai < 2; ++ai)
#pragma unroll
            for (int m = 0; m < 4; ++m) { if (!((mask >> (ai * 8 + m * 2)) & 3u)) continue; const int R = u.pm * BM + ai * HALF + wr * 64 + m * 16 + fr; float s = 0.f; float* dst = out + (size_t)R * 2048;
#pragma unroll
                for (int bj = 0; bj < 2; ++bj)
#pragma unroll
                    for (int n = 0; n < 2; ++n) { if (!((mask >> (ai * 8 + m * 2 + bj)) & 1u)) continue; const int c = col0 + bj * HALF + n * 16; const f32x4 x2 = *(const f32x4*)(dst + c) + acc[ai][bj][m][n];
                        *(f32x4*)(dst + c) = x2; s += (x2[0] * x2[0] + x2[1] * x2[1]) + (x2[2] * x2[2] + x2[3] * x2[3]); }
                s += __shfl_xor(s, 16); s += __shfl_xor(s, 32);
                if (fq == 0) atomicAdd(ss + R, s); }
    }
};
constexpr int DFF = 5632;
struct EpiUp {
    static constexpr bool PERM = true, AFTER_DRAIN = false;
    const float* ss; const float *cw, *cb; bf16_t* H; float *gfix, *vfix, *gsrc; float *conv_p, *conv_s;
    __device__ __forceinline__ void operator()(const f32x4 (&acc)[2][2][4][2], const Unit& u, int wr, int wc, int fr, int fq) const {
        const int j0 = u.pn * HALF + wc * 32 + 8 * fq;
        const bool samp = u.pm >= 32;
        const bool is15 = fr == 15, ge14 = fr >= 14;
        float rs[2][4];
#pragma unroll
        for (int ai = 0; ai < 2; ++ai)
#pragma unroll
            for (int m = 0; m < 4; ++m) rs[ai][m] = ss[u.pm * BM + ai * HALF + wr * 64 + m * 16 + fr];
        f32x4 w0[2], w1[2], w2[2], b0[2];
#pragma unroll
        for (int h = 0; h < 2; ++h) { w0[h] = *(const f32x4*)(cw + j0 + 4 * h); w1[h] = *(const f32x4*)(cw + DFF + j0 + 4 * h); w2[h] = *(const f32x4*)(cw + 2 * DFF + j0 + 4 * h); b0[h] = *(const f32x4*)(cb + j0 + 4 * h); }
#pragma unroll
        for (int ai = 0; ai < 2; ++ai) {
            f32x4 pp[2] = {(f32x4){0.f, 0.f, 0.f, 0.f}, (f32x4){0.f, 0.f, 0.f, 0.f}};
#pragma unroll
            for (int m = 0; m < 4; ++m) {
                const int rt = ai * HALF + wr * 64 + m * 16 + fr; const int R = u.pm * BM + rt;
                const float rstd = rsqrtf(rs[ai][m] * (1.0f / 2048.0f) + 1e-6f);
                f32x4 g4[2], v4[2], h4[2];
#pragma unroll
                for (int h = 0; h < 2; ++h) {
                    g4[h] = acc[ai][0][m][h] * rstd; v4[h] = acc[ai][1][m][h] * rstd;
                    f32x4 t1, t2, p1, p2;
#pragma unroll
                    for (int e = 0; e < 4; ++e) { t1[e] = is15 ? pp[h][e] : g4[h][e]; t2[e] = ge14 ? pp[h][e] : g4[h][e];
                        p1[e] = __int_as_float(__builtin_amdgcn_update_dpp(0, __float_as_int(t1[e]), 0x121, 0xf, 0xf, false));
                        p2[e] = __int_as_float(__builtin_amdgcn_update_dpp(0, __float_as_int(t2[e]), 0x122, 0xf, 0xf, false)); }
                    const f32x4 gc = b0[h] + p2 * w0[h] + p1 * w1[h] + g4[h] * w2[h];
                    const f32x4 uu = gc * (gc * gc * 0.044715f + 1.0f);
                    const f32x4 ee = uu * (-2.0f * 0.7978845608028654f * 1.4426950408889634f);
                    f32x4 dn;
#pragma unroll
                    for (int e = 0; e < 4; ++e) dn[e] = __builtin_amdgcn_rcpf(1.0f + __builtin_amdgcn_exp2f(ee[e]));
                    h4[h] = gc * dn * v4[h];
                }
                u32x4 w; w.x = cvt_pk_bf16(h4[0][0], h4[0][1]); w.y = cvt_pk_bf16(h4[0][2], h4[0][3]); w.z = cvt_pk_bf16(h4[1][0], h4[1][1]); w.w = cvt_pk_bf16(h4[1][2], h4[1][3]);
                *(u32x4*)(H + (size_t)R * DFF + j0) = w;
                const float gg[8] = {g4[0][0], g4[0][1], g4[0][2], g4[0][3], g4[1][0], g4[1][1], g4[1][2], g4[1][3]};
                const float vv[8] = {v4[0][0], v4[0][1], v4[0][2], v4[0][3], v4[1][0], v4[1][1], v4[1][2], v4[1][3]};
                const f32x4 gA = {gg[0], gg[1], gg[2], gg[3]}, gB = {gg[4], gg[5], gg[6], gg[7]};
                if (fr < 2 && (m == 0 || samp)) {
                    const int id = samp ? 256 + (u.pm - 32) * 32 + (rt >> 4) * 2 + fr : u.pm * 8 + (rt >> 6) * 2 + fr;
                    float* gp = gfix + (size_t)id * DFF + j0; float* vp = vfix + (size_t)id * DFF + j0;
                    *(f32x4*)gp = gA; *(f32x4*)(gp + 4) = gB;
                    *(f32x4*)vp = (f32x4){vv[0], vv[1], vv[2], vv[3]}; *(f32x4*)(vp + 4) = (f32x4){vv[4], vv[5], vv[6], vv[7]};
                }
                if (fr >= 14) {
                    if (samp) { float* cp = conv_s + (size_t)(((R - R_SAMPLE0) >> 4) * 2 + (fr - 14)) * DFF + j0; *(f32x4*)cp = gA; *(f32x4*)(cp + 4) = gB; }
                    else if (m == 3) {
                        float* sp = gsrc + (size_t)(u.pm * 8 + (rt >> 6) * 2 + (fr - 14)) * DFF + j0; *(f32x4*)sp = gA; *(f32x4*)(sp + 4) = gB;
                        if ((R & 4095) >= 4094) { float* cp = conv_p + (size_t)((R >> 12) * 2 + ((R & 4095) - 4094)) * DFF + j0; *(f32x4*)cp = gA; *(f32x4*)(cp + 4) = gB; }
                    }
                }
                pp[0] = g4[0]; pp[1] = g4[1];
            }
        }
    }
};

template <class Epi, class Sched, bool ALIGN_EPI = false, bool SP2 = false, bool STREAMK = false>
__device__ __forceinline__ void gemm_phase(PG8_LAS unsigned char* lds, const Gemm g, const Sched& S, const Epi& E, const SKBuf sk = SKBuf{nullptr, nullptr, 0}) {
    int tid_ = threadIdx.x; asm volatile("" : "+v"(tid_));
    const int tid = tid_, wid = __builtin_amdgcn_readfirstlane(tid >> 6), lane = tid & 63, wr = wid >> 2, wc = wid & 3, fr = lane & 15, fq = lane >> 4;
    unsigned voffA[2], voffB[2];
#pragma unroll
    for (int i = 0; i < 2; ++i) { int R, C; stage_rc(tid * 16 + i * 8192, R, C); const int Rb = Epi::PERM ? ((R & ~31) + perm32(R & 31)) : R;
        voffA[i] = (unsigned)(R * g.lda + C) * 2u; voffB[i] = (unsigned)(Rb * g.ldb + C) * 2u; }
    const size_t kstep = (size_t)(BK * 2);
    const size_t hstepA = (size_t)HALF * g.lda * 2, hstepB = (size_t)HALF * g.ldb * 2;
    const unsigned ldsw = (unsigned)wid * 1024u;
    const int aoff = lds_byte(wr * 64 + fr, fq * 8), boff = lds_byte(wc * 32 + fr, fq * 8);
#define PG8_SA(b, h) (((b) * 2 + (h)) * HTB)
#define PG8_SB(b, h) ((4 + (b) * 2 + (h)) * HTB)
#define PG8_STAGE(bufoff, gbase, voff) do { _Pragma("unroll") for (int _i = 0; _i < 2; ++_i) \
        __builtin_amdgcn_global_load_lds((const unsigned*)((const char*)(gbase) + (voff)[_i]), (PG8_LAS unsigned*)(lds + (bufoff) + ldsw + _i * 8192), 16, 0, 0); } while (0)
#define PG8_LDA(dst, b, h) do { _Pragma("unroll") for (int m = 0; m < 4; ++m) _Pragma("unroll") for (int k = 0; k < 2; ++k) dst[m][k] = *(const PG8_LAS bf16x8*)(lds + PG8_SA(b, h) + aoff + m * 2048 + k * 1024); } while (0)
#define PG8_LDB(dst, b, h) do { _Pragma("unroll") for (int n = 0; n < 2; ++n) _Pragma("unroll") for (int k = 0; k < 2; ++k) dst[n][k] = *(const PG8_LAS bf16x8*)(lds + PG8_SB(b, h) + boff + n * 2048 + k * 1024); } while (0)
#define PG8_MMA(ai, bj, At, Bt) do { __builtin_amdgcn_s_setprio(1); _Pragma("unroll") for (int m = 0; m < 4; ++m) _Pragma("unroll") for (int n = 0; n < 2; ++n) _Pragma("unroll") for (int k = 0; k < 2; ++k) \
        acc[ai][bj][m][n] = __builtin_amdgcn_mfma_f32_16x16x32_bf16(Bt[n][k], At[m][k], acc[ai][bj][m][n], 0, 0, 0); __builtin_amdgcn_s_setprio(0); } while (0)
#define PG8_WAIT_V(n) asm volatile("s_waitcnt vmcnt(" #n ")" ::: "memory")
#define PG8_WAIT_L(n) asm volatile("s_waitcnt lgkmcnt(" #n ")" ::: "memory")
#define PG8_BAR __builtin_amdgcn_s_barrier()
#define PG8_SCHED __builtin_amdgcn_sched_barrier(0)
    Unit cur, nxt; int ui = 0;
    if (!S.next(0, cur)) return;
    f32x4 acc[2][2][4][2];
#pragma unroll
    for (int a = 0; a < 2; ++a)
#pragma unroll
        for (int b = 0; b < 2; ++b)
#pragma unroll
            for (int m = 0; m < 4; ++m)
#pragma unroll
                for (int n = 0; n < 2; ++n) acc[a][b][m][n] = (f32x4){0.f, 0.f, 0.f, 0.f};
    bf16x8 At[4][2], B0[2][2], B1[2][2];
    const char* cA = g.abase(cur); const char* cB = g.bbase(cur);
    S.a_ready(cur);
    if constexpr (SP2) {
        PG8_STAGE(PG8_SB(0, 0), cB, voffB); PG8_STAGE(PG8_SB(0, 1), cB + hstepB, voffB); PG8_STAGE(PG8_SA(0, 0), cA, voffA); PG8_STAGE(PG8_SA(0, 1), cA + hstepA, voffA);
        if (wr == 1) PG8_BAR;
        PG8_WAIT_V(2); PG8_BAR;
        PG8_STAGE(PG8_SB(1, 0), cB + kstep, voffB); PG8_STAGE(PG8_SA(1, 0), cA + kstep, voffA); PG8_STAGE(PG8_SB(1, 1), cB + hstepB + kstep, voffB);
        PG8_WAIT_V(6); PG8_BAR;
    } else {
        PG8_STAGE(PG8_SB(0, 0), cB, voffB); PG8_STAGE(PG8_SA(0, 0), cA, voffA); PG8_STAGE(PG8_SB(0, 1), cB + hstepB, voffB); PG8_STAGE(PG8_SA(0, 1), cA + hstepA, voffA);
        if (wr == 1) PG8_BAR;
        PG8_WAIT_V(4); PG8_BAR;
        PG8_STAGE(PG8_SB(1, 0), cB + kstep, voffB); PG8_STAGE(PG8_SA(1, 0), cA + kstep, voffA); PG8_STAGE(PG8_SB(1, 1), cB + hstepB + kstep, voffB);
        PG8_WAIT_V(6); PG8_BAR;
    }
    for (;;) {
        const bool has_next = S.next(ui + 1, nxt);
        const char* nA = has_next ? g.abase(nxt) : cA; const char* nB = has_next ? g.bbase(nxt) : cB;
        const int nt = cur.nt;
        for (int t = 0; t < nt; t += 2) {
            const bool last = (t == nt - 2);
            const char* a1 = cA + (size_t)(t + 1) * kstep;
            const char* a2 = last ? nA : cA + (size_t)(t + 2) * kstep; const char* b2 = last ? nB : cB + (size_t)(t + 2) * kstep;
            const char* a3 = a2 + kstep; const char* b3 = b2 + kstep;
            if (last && has_next) S.a_ready(nxt);
            if constexpr (SP2) {
            PG8_LDB(B0, 0, 0); PG8_LDB(B1, 0, 1); PG8_SCHED; PG8_LDA(At, 0, 0); PG8_STAGE(PG8_SA(1, 1), a1 + hstepA, voffA);
            PG8_WAIT_V(8); PG8_WAIT_L(0); PG8_BAR; PG8_MMA(0, 0, At, B0); PG8_MMA(0, 1, At, B1); PG8_BAR; PG8_SCHED;
            PG8_LDA(At, 0, 1); PG8_STAGE(PG8_SB(0, 0), b2, voffB); PG8_STAGE(PG8_SB(0, 1), b2 + hstepB, voffB); PG8_STAGE(PG8_SA(0, 0), a2, voffA);
            PG8_WAIT_V(8); PG8_WAIT_L(0); PG8_BAR; PG8_MMA(1, 0, At, B0); PG8_MMA(1, 1, At, B1); PG8_BAR; PG8_SCHED;
            PG8_LDB(B0, 1, 0); PG8_LDB(B1, 1, 1); PG8_SCHED; PG8_LDA(At, 1, 0); PG8_STAGE(PG8_SA(0, 1), a2 + hstepA, voffA);
            PG8_WAIT_V(8); PG8_WAIT_L(0); PG8_BAR; PG8_MMA(0, 0, At, B0); PG8_MMA(0, 1, At, B1); PG8_BAR; PG8_SCHED;
            PG8_LDA(At, 1, 1); PG8_STAGE(PG8_SB(1, 0), b3, voffB); PG8_STAGE(PG8_SB(1, 1), b3 + hstepB, voffB); PG8_STAGE(PG8_SA(1, 0), a3, voffA);
            PG8_WAIT_V(8); PG8_WAIT_L(0); PG8_BAR; PG8_MMA(1, 0, At, B0); PG8_MMA(1, 1, At, B1); PG8_BAR; PG8_SCHED;
            } else {
            PG8_LDB(B0, 0, 0); PG8_SCHED; PG8_LDA(At, 0, 0); PG8_STAGE(PG8_SA(1, 1), a1 + hstepA, voffA);
            PG8_WAIT_L(8); PG8_BAR; PG8_WAIT_L(0); PG8_MMA(0, 0, At, B0); PG8_BAR; PG8_SCHED;
            PG8_LDB(B1, 0, 1); PG8_STAGE(PG8_SB(0, 0), b2, voffB);
            PG8_BAR; PG8_WAIT_L(0); PG8_MMA(0, 1, At, B1); PG8_BAR;
            PG8_LDA(At, 0, 1); PG8_STAGE(PG8_SA(0, 0), a2, voffA);
            PG8_BAR; PG8_WAIT_L(0); PG8_MMA(1, 0, At, B0); PG8_BAR; PG8_SCHED;
            PG8_STAGE(PG8_SB(0, 1), b2 + hstepB, voffB);
            PG8_WAIT_V(6); PG8_BAR; PG8_MMA(1, 1, At, B1); PG8_BAR;
            PG8_LDB(B0, 1, 0); PG8_SCHED; PG8_LDA(At, 1, 0); PG8_STAGE(PG8_SA(0, 1), a2 + hstepA, voffA);
            PG8_WAIT_L(8); PG8_BAR; PG8_WAIT_L(0); PG8_MMA(0, 0, At, B0); PG8_BAR; PG8_SCHED;
            PG8_LDB(B1, 1, 1); PG8_STAGE(PG8_SB(1, 0), b3, voffB);
            PG8_BAR; PG8_WAIT_L(0); PG8_MMA(0, 1, At, B1); PG8_BAR;
            PG8_LDA(At, 1, 1); PG8_STAGE(PG8_SA(1, 0), a3, voffA);
            PG8_BAR; PG8_WAIT_L(0); PG8_MMA(1, 0, At, B0); PG8_BAR; PG8_SCHED;
            PG8_STAGE(PG8_SB(1, 1), b3 + hstepB, voffB);
            PG8_WAIT_V(6); PG8_BAR; PG8_MMA(1, 1, At, B1); PG8_BAR;
            }
        }
        if constexpr (ALIGN_EPI) { if (wr == 0) PG8_BAR; }
        if constexpr (STREAMK) {
            if (cur.kind == 1) {
                __attribute__((address_space(1))) unsigned* p = (__attribute__((address_space(1))) unsigned*)sk.slots + (size_t)sk.v * 32768 + (size_t)tid * 4;
#pragma unroll
                for (int a = 0; a < 2; ++a)
#pragma unroll
                    for (int b = 0; b < 2; ++b)
#pragma unroll
                        for (int m = 0; m < 4; ++m) { const f32x4 v0 = acc[a][b][m][0], v1 = acc[a][b][m][1];
                            u32x4 w; w.x = cvt_pk_bf16(v0[0], v0[1]); w.y = cvt_pk_bf16(v0[2], v0[3]); w.z = cvt_pk_bf16(v1[0], v1[1]); w.w = cvt_pk_bf16(v1[2], v1[3]);
                            *(__attribute__((address_space(1))) u32x4*)p = w; p += 2048; asm volatile("" : "+v"(p)); }
            } else {
                E(acc, cur, wr, wc, fr, fq);
            }
        } else
        if constexpr (!Epi::AFTER_DRAIN) { E(acc, cur, wr, wc, fr, fq); S.done(cur); }
        if (!has_next) break;
#pragma unroll
        for (int a = 0; a < 2; ++a)
#pragma unroll
            for (int b = 0; b < 2; ++b)
#pragma unroll
                for (int m = 0; m < 4; ++m)
#pragma unroll
                    for (int n = 0; n < 2; ++n) acc[a][b][m][n] = (f32x4){0.f, 0.f, 0.f, 0.f};
        cur = nxt; cA = nA; cB = nB; ++ui;
        if constexpr (ALIGN_EPI) { if (wr == 1) PG8_BAR; }
    }
    PG8_WAIT_V(0);
    if constexpr (!ALIGN_EPI) { if (wr == 0) PG8_BAR; }
    PG8_BAR;
    if constexpr (Epi::AFTER_DRAIN) { E.fused(acc, cur, wr, wc, fr, fq, lds, wid, lane); S.done(cur); }
#undef PG8_SA
#undef PG8_SB
#undef PG8_STAGE
#undef PG8_LDA
#undef PG8_LDB
#undef PG8_MMA
#undef PG8_WAIT_V
#undef PG8_WAIT_L
#undef PG8_BAR
#undef PG8_SCHED
}

template <class Epi, class Sched>
__device__ __forceinline__ void gemm_reduce(const Sched& S, const Epi& E, const SKBuf sk) {
    int tid_ = threadIdx.x; asm volatile("" : "+v"(tid_));
    const int tid = tid_, wid = __builtin_amdgcn_readfirstlane(tid >> 6), lane = tid & 63, wr = wid >> 2, wc = wid & 3, fr = lane & 15, fq = lane >> 4;
    Unit ru; unsigned mask; int base;
    if (!S.reducer(ru, mask, base)) return;
    const unsigned* sb = (const unsigned*)sk.slots + (size_t)base * 32768 + (size_t)tid * 4;
    f32x4 racc[2][2][4][2];
#pragma unroll
    for (int a = 0; a < 2; ++a)
#pragma unroll
        for (int b = 0; b < 2; ++b)
#pragma unroll
            for (int m = 0; m < 4; ++m)
#pragma unroll
                for (int n = 0; n < 2; ++n) racc[a][b][m][n] = (f32x4){0.f, 0.f, 0.f, 0.f};
#pragma unroll
    for (int a = 0; a < 2; ++a)
#pragma unroll
        for (int m = 0; m < 4; ++m)
#pragma unroll
            for (int b = 0; b < 2; ++b)
                if ((mask >> (a * 8 + m * 2 + b)) & 1u) {
                    f32x4 r0 = (f32x4){0.f, 0.f, 0.f, 0.f}, r1 = r0; const unsigned* p = sb + (size_t)(((a * 2 + b) * 4 + m) * 2048);
                    for (int s8 = 0; s8 < S.S; s8 += 8) {
                        u32x4 t[8];
#pragma unroll
                        for (int k = 0; k < 8; ++k) t[k] = *(const u32x4*)(p + (size_t)k * 32768);
#pragma unroll
                        for (int k = 0; k < 8; ++k) { r0 += (f32x4){bflo(t[k].x), bfhi(t[k].x), bflo(t[k].y), bfhi(t[k].y)}; r1 += (f32x4){bflo(t[k].z), bfhi(t[k].z), bflo(t[k].w), bfhi(t[k].w)}; }
                        p += 8 * 32768; }
                    racc[a][b][m][0] = r0; racc[a][b][m][1] = r1;
                }
    E(racc, ru, wr, wc, fr, fq, mask);
}
}

#define GAS __attribute__((address_space(1)))
#define LAS __attribute__((address_space(3)))
typedef unsigned short bf16;
typedef unsigned v4u __attribute__((ext_vector_type(4)));
typedef unsigned v2u __attribute__((ext_vector_type(2)));
typedef float f32x4 __attribute__((ext_vector_type(4)));
typedef float f32x16 __attribute__((ext_vector_type(16)));
typedef short bf16x8 __attribute__((ext_vector_type(8)));
constexpr int NWAVES = 8, NTHREADS = 512;
constexpr int DM = 2048, SEQ = 4096, NMETA = 16, DECB = 32, DECL = 16;
constexpr int NG = 64, NS = 64, DFF = 5632;
constexpr int R_SAMPLE0 = 8192, R_REAL = 8704, R_ALL = 8736, R_PAD = 8960;
constexpr float RMS_EPS = 1e-6f;
constexpr int NSEG = 16;
constexpr size_t O_Y = 0, O_SRE_P = 17825792, O_SIM_P = 17833984, O_POOL_P = 17842176, O_CONV_P = 17872896,
                 O_SRE_S = 17895424, O_SIM_S = 18026496, O_POOL_S = 18157568, O_CONV_S = 18649088;
constexpr size_t MiB = 1u << 20;
constexpr int LDP = 2112;
constexpr size_t WS_WIN = 0, WS_WGLU = 9 * MiB, WS_WPOOL = 11 * MiB, WS_WOUT = 12 * MiB, WS_WUP = 21 * MiB, WS_WDOWN = 67 * MiB;
constexpr size_t WS_XN = 89 * MiB, WS_U = 126 * MiB, WS_YPRE = 161 * MiB, WS_MB = 179 * MiB, WS_YCAT = 197 * MiB;
constexpr size_t WS_H = 126 * MiB;
constexpr size_t WS_SMALL = 234 * MiB;
constexpr size_t WS_XMETA = WS_SMALL, WS_SS1 = WS_XMETA + 32 * 2048 * 4, WS_SS2 = WS_SS1 + 36864, WS_LBAR = WS_SS2 + 36864, WS_PW = WS_LBAR + 32768,
                 WS_BB = WS_PW + 32768, WS_CC = WS_BB + 262144, WS_EST = WS_CC + 262144, WS_GMETA = WS_EST + 2 * 64 * 16 * 64 * 8;
constexpr size_t WS_GFIX = 238 * MiB, WS_VFIX = 245 * MiB, WS_GSRC = 252 * MiB, WS_SLOTS = 258 * MiB, WS_FLAGS = 322 * MiB, WS_BAR = 322 * MiB + 65536, WS_FA = 323 * MiB, WS_FB = 0, WS_END = 351 * MiB;
static_assert(WS_GMETA + 4 * DFF * 4 <= WS_GFIX && WS_H + (size_t)R_REAL * DFF * 2 <= WS_YCAT + (size_t)R_PAD * LDP * 2 && WS_YCAT + (size_t)R_PAD * LDP * 2 <= WS_SMALL && 320 * (size_t)DFF * 4 <= 7 * MiB
              && WS_XN + (size_t)R_PAD * LDP * 2 <= WS_U && WS_WUP + (size_t)11264 * LDP * 2 <= WS_WDOWN && WS_WIN + (size_t)2048 * LDP * 2 <= WS_WGLU && WS_WOUT + (size_t)2048 * LDP * 2 <= WS_WUP, "ws map");
constexpr int F_SPLIT = 7168;
constexpr int LDS_BYTES = 147456;
constexpr int S5_WLDS = 32 * 528;

__device__ __forceinline__ unsigned f2bf(float f) { unsigned u = __builtin_bit_cast(unsigned, f); return (u + 0x7fffu + ((u >> 16) & 1u)) >> 16; }
__device__ __forceinline__ unsigned pk2(float lo, float hi) { return f2bf(lo) | (f2bf(hi) << 16); }
__device__ __forceinline__ float blo(unsigned w) { return __uint_as_float(w << 16); }
__device__ __forceinline__ float bhi(unsigned w) { return __uint_as_float(w & 0xffff0000u); }
#define LDS_WAIT() asm volatile("s_waitcnt lgkmcnt(0)" ::: "memory")

#define XB_TMO      128
#define XB_XCNT(j)  (256  + 64 * (j))
#define XB_XSUB(j)  (1280 + 64 * (j))
#define XB_XGEN(j)  (2304 + 64 * (j))
#define XB_TOP      3328
#define XB_TOPGEN   3392
#define XCD_BAR_WORDS 3456
#define XB_SPIN_CAP (1u << 18)

__device__ __forceinline__ unsigned xb_ld(unsigned* p)              { return __hip_atomic_load(p, __ATOMIC_RELAXED, __HIP_MEMORY_SCOPE_AGENT); }
__device__ __forceinline__ unsigned xb_add(unsigned* p, unsigned v) { return __hip_atomic_fetch_add(p, v, __ATOMIC_RELAXED, __HIP_MEMORY_SCOPE_AGENT); }
__device__ __forceinline__ unsigned xb_xcc_id() { return (unsigned)__builtin_amdgcn_s_getreg((3 << 11) | 20) & 0xFu; }
#define XB_SPIN(cond, bar) do { unsigned _sp = 0; while (cond) { __builtin_amdgcn_s_sleep(1); \
    if ((++_sp & 255u) == 0u) { if (xb_ld(&(bar)[XB_TMO])) break; if (_sp > XB_SPIN_CAP) { atomicAdd(&(bar)[XB_TMO], 1u); break; } } } } while (0)

struct XcdBarrier {
    unsigned* bar; unsigned x;
    volatile LAS unsigned* st;
};

__device__ __forceinline__ XcdBarrier xcd_barrier_post(unsigned* bar, volatile LAS unsigned* st) {
    XcdBarrier b; b.bar = bar; b.x = xb_xcc_id(); b.st = st;
    if (threadIdx.x == 0) (void)xb_add(&bar[XB_XCNT(b.x)], 1u);
    return b;
}
__device__ __forceinline__ void xcd_barrier_complete(unsigned* bar, unsigned x, unsigned& nloc, unsigned& nx) {
    const unsigned G = gridDim.x * gridDim.y * gridDim.z;
    unsigned sum, cnt, mine, sp = 0u;
    for (;;) {
        sum = 0u; cnt = 0u; mine = 0u;
#pragma unroll
        for (unsigned j = 0; j < 16; ++j) { const unsigned c = xb_ld(&bar[XB_XCNT(j)]); sum += c; cnt += (c > 0u) ? 1u : 0u; mine = (j == x) ? c : mine; }
        if (sum == G) break;
        __builtin_amdgcn_s_sleep(1);
        if ((++sp & 255u) == 0u) { if (xb_ld(&bar[XB_TMO])) break; if (sp > XB_SPIN_CAP) { atomicAdd(&bar[XB_TMO], 1u); break; } }
    }
    nloc = mine > 0u ? mine : 1u; nx = cnt > 0u ? cnt : 1u;
}

__device__ __forceinline__ void xcd_barrier(const XcdBarrier& b) {
    asm volatile("s_waitcnt vmcnt(0)" ::: "memory");
    __syncthreads();
    if (threadIdx.x == 0) {
        unsigned* bar = b.bar;
        __builtin_amdgcn_s_waitcnt(0);
        unsigned nloc = b.st[0], nx = b.st[1];
        if (nloc == 0u) { xcd_barrier_complete(bar, b.x, nloc, nx); b.st[0] = nloc; b.st[1] = nx; }
        const unsigned old = xb_add(&bar[XB_XSUB(b.x)], 1u);
        const unsigned gen = old / nloc;
        if (old + 1u == (gen + 1u) * nloc) {
            __builtin_amdgcn_fence(__ATOMIC_RELEASE, "agent");
            asm volatile("s_waitcnt vmcnt(0)" ::: "memory");
            const unsigned og = xb_add(&bar[XB_TOP], 1u);
            const unsigned tg = og / nx;
            if (og + 1u == (tg + 1u) * nx) xb_add(&bar[XB_TOPGEN], 1u);
            else XB_SPIN(xb_ld(&bar[XB_TOPGEN]) == tg, bar);
            __builtin_amdgcn_fence(__ATOMIC_ACQUIRE, "agent");
            xb_add(&bar[XB_XGEN(b.x)], 1u);
            asm volatile("s_waitcnt vmcnt(0)" ::: "memory");
        } else {
            XB_SPIN(xb_ld(&bar[XB_XGEN(b.x)]) == gen, bar);
            __builtin_amdgcn_fence(__ATOMIC_ACQUIRE, "agent");
            asm volatile("s_waitcnt vmcnt(0)" ::: "memory");
        }
    }
    __syncthreads();
}

struct Frame {
    LAS unsigned char* lds; int wave, vcu, G;
    float* out; unsigned char* ws;
};
constexpr int BARST_OFF = 143360 + 256;
constexpr int TAB_OFF = 143360;
__device__ __forceinline__ const float* inp(const Frame& F, int i) {
    const LAS unsigned* t = (const LAS unsigned*)(F.lds + TAB_OFF) + 2 * i; const unsigned lo = __builtin_amdgcn_readfirstlane(t[0]), hi = __builtin_amdgcn_readfirstlane(t[1]);
    return (const float*)(const GAS float*)(((unsigned long long)hi << 32) | lo);
}
__device__ __forceinline__ int ltid() { int t = threadIdx.x; asm volatile("" : "+v"(t)); return t; }
__device__ __forceinline__ float wave_sum(float v) {
#pragma unroll
    for (int o = 1; o < 64; o <<= 1) v += __shfl_xor(v, o);
    return v;
}
struct TItem { const float* src; bf16* dst; int K, N; };
__device__ __forceinline__ void p0_item_load(const TItem& t, f32x4 (&buf)[16], int lane) {
    const float* p = t.src + (size_t)(lane >> 4) * t.N + 4 * (lane & 15);
#pragma unroll
    for (int i = 0; i < 16; ++i) buf[i] = __builtin_nontemporal_load((const f32x4*)(p + (size_t)(4 * i) * t.N));
}
__device__ __forceinline__ void p0_item_to_lds(const f32x4 (&buf)[16], LAS float* scr, int lane) {
    LAS float* q = scr + (lane >> 4) * 65 + 4 * (lane & 15);
#pragma unroll
    for (int i = 0; i < 16; ++i) { q[(4 * i) * 65 + 0] = buf[i][0]; q[(4 * i) * 65 + 1] = buf[i][1]; q[(4 * i) * 65 + 2] = buf[i][2]; q[(4 * i) * 65 + 3] = buf[i][3]; }
}
__device__ __forceinline__ void p0_item_store(const TItem& t, LAS float* scr, int lane) {
    const int c = lane & 7;
#pragma unroll
    for (int j = 0; j < 8; ++j) { const int n = (lane >> 3) + 8 * j; const LAS float* sp = scr + (8 * c) * 65 + n;
        v4u o; o.x = pk2(sp[0 * 65], sp[1 * 65]); o.y = pk2(sp[2 * 65], sp[3 * 65]); o.z = pk2(sp[4 * 65], sp[5 * 65]); o.w = pk2(sp[6 * 65], sp[7 * 65]);
        *(v4u*)(t.dst + (size_t)n * t.K + 8 * c) = o; }
}
__device__ __forceinline__ const float* xrow(const Frame& F, int R) {
    return R < R_SAMPLE0 ? inp(F, 0) + (size_t)R * DM : (R < R_REAL ? inp(F, 1) + (size_t)(R - R_SAMPLE0) * DM : inp(F, 6) + (size_t)((R - R_REAL) & 15) * DM);
}

constexpr int I_IN = 32 * 32, I_GLU = 16 * 16, I_POOL = 4 * 4 * 4, I_OUT = 32 * 32, I_UP = 32 * 176, I_DOWN = 88 * 32;
constexpr int I_EARLY = I_IN + I_GLU + I_POOL + I_OUT + I_UP;
__device__ __forceinline__ void p0_decode(const Frame& F, int it, TItem& t) {
    unsigned char* ws = F.ws; int r = it;
    if (r < I_IN) { const int kb = r / 32, nb = r % 32; t.K = LDP; t.N = 2048; t.src = inp(F, 8) + (size_t)(64 * kb) * 2048 + 64 * nb; t.dst = (bf16*)(ws + WS_WIN) + (size_t)(64 * nb) * LDP + 64 * kb; return; } r -= I_IN;
    if (r < I_GLU) { const int kb = r / 16, nb = r % 16; t.K = 1024; t.N = 1024; t.src = inp(F, 17) + (size_t)(64 * kb) * 1024 + 64 * nb; t.dst = (bf16*)(ws + WS_WGLU) + (size_t)(64 * nb) * 1024 + 64 * kb; return; } r -= I_GLU;
    if (r < I_POOL) { const int g = r / 16, q = r % 16, kb = q / 4, nb = q % 4; t.K = 256; t.N = 256; t.src = inp(F, 18) + (size_t)g * 65536 + (size_t)(64 * kb) * 256 + 64 * nb; t.dst = (bf16*)(ws + WS_WPOOL) + (size_t)g * 65536 + (size_t)(64 * nb) * 256 + 64 * kb; return; } r -= I_POOL;
    if (r < I_OUT) { const int kb = r / 32, nb = r % 32; t.K = LDP; t.N = 2048; t.src = inp(F, 20) + (size_t)(64 * kb) * 2048 + 64 * nb; t.dst = (bf16*)(ws + WS_WOUT) + (size_t)(64 * nb) * LDP + 64 * kb; return; } r -= I_OUT;
    if (r < I_UP) { const int kb = r / 176, nb = r % 176, n0 = 64 * nb; const int drow = n0 < DFF ? (n0 / 128) * 256 + (n0 % 128) : ((n0 - DFF) / 128) * 256 + 128 + ((n0 - DFF) % 128);
        t.K = LDP; t.N = 2 * DFF; t.src = inp(F, 22) + (size_t)(64 * kb) * (2 * DFF) + n0; t.dst = (bf16*)(ws + WS_WUP) + (size_t)drow * LDP + 64 * kb; return; } r -= I_UP;
    { const int kb = r / 32, nb = r % 32; t.K = DFF; t.N = 2048; t.src = inp(F, 25) + (size_t)(64 * kb) * 2048 + 64 * nb; t.dst = (bf16*)(ws + WS_WDOWN) + (size_t)(64 * nb) * DFF + 64 * kb; }
}
__device__ __forceinline__ void p0_convert(const Frame& F, int lo, int hi, int w, int nw, int lane) {
    LAS float* scr = (LAS float*)(F.lds + F.wave * 16640);
    f32x4 bufA[16], bufB[16]; TItem ta, tb; int it = lo + w;
    if (it < hi) { p0_decode(F, it, ta); p0_item_load(ta, bufA, lane); }
    while (it < hi) {
        p0_item_to_lds(bufA, scr, lane);
        if (it + nw < hi) { p0_decode(F, it + nw, tb); p0_item_load(tb, bufB, lane); }
        LDS_WAIT(); asm volatile("" ::: "memory");
        p0_item_store(ta, scr, lane);
        LDS_WAIT(); asm volatile("" ::: "memory");
        it += nw; if (it >= hi) break;
        p0_item_to_lds(bufB, scr, lane);
        if (it + nw < hi) { p0_decode(F, it + nw, ta); p0_item_load(ta, bufA, lane); }
        LDS_WAIT(); asm volatile("" ::: "memory");
        p0_item_store(tb, scr, lane);
        LDS_WAIT(); asm volatile("" ::: "memory");
        it += nw;
    }
}
__device__ __forceinline__ void p0_prologue(Frame& F) {
    unsigned char* ws = F.ws; const int tid = ltid(), lane = tid & 63;
    const int gw = F.vcu * NWAVES + F.wave, NGW = F.G * NWAVES;
    p0_convert(F, 0, F.G == 256 ? I_EARLY : I_EARLY + I_DOWN, gw, NGW, lane);
    const float* gm = inp(F, 7);
    {
        f32x4 v[8], vn[8]; int R = gw;
        if (R < R_ALL) { const f32x4* xr = (const f32x4*)xrow(F, R) + lane;
#pragma unroll
            for (int j = 0; j < 8; ++j) v[j] = __builtin_nontemporal_load(xr + 64 * j); }
        while (R < R_ALL) {
            const int Rn = R + NGW;
            if (Rn < R_ALL) { const f32x4* xr = (const f32x4*)xrow(F, Rn) + lane;
#pragma unroll
                for (int j = 0; j < 8; ++j) vn[j] = __builtin_nontemporal_load(xr + 64 * j); }
            float s = 0.f;
#pragma unroll
            for (int j = 0; j < 8; ++j) s += (v[j].x * v[j].x + v[j].y * v[j].y) + (v[j].z * v[j].z + v[j].w * v[j].w);
            const float ms = wave_sum(s) * (1.0f / DM) + RMS_EPS; const float rstd = rsqrtf(ms);
            if (lane == 0) ((float*)(ws + WS_SS2))[R] = sqrtf(ms);
            unsigned long long* o8 = (unsigned long long*)((bf16*)(ws + WS_XN) + (size_t)R * LDP) + lane;
#pragma unroll
            for (int j = 0; j < 8; ++j) { const f32x4 g = ((const f32x4*)gm)[64 * j + lane];
                o8[64 * j] = (unsigned long long)pk2(v[j].x * rstd * g.x, v[j].y * rstd * g.y) | ((unsigned long long)pk2(v[j].z * rstd * g.z, v[j].w * rstd * g.w) << 32); }
#pragma unroll
            for (int j = 0; j < 8; ++j) v[j] = vn[j];
            R = Rn;
        }
    }
    const int gt = F.vcu * NTHREADS + tid, NGT = F.G * NTHREADS;
    for (int i = gt; i < 9216; i += NGT) ((float*)(ws + WS_SS1))[i] = 0.f;
    for (int i = gt; i < 4 * 256; i += NGT) __hip_atomic_store((unsigned*)(ws + WS_FLAGS) + i, 0u, __ATOMIC_RELAXED, __HIP_MEMORY_SCOPE_SYSTEM);
    for (int i2 = gt; i2 < NG * NS * 16; i2 += NGT) {
        const int i = i2 >> 4, n = i2 & 15, g = i >> 6, p = i & 63;
        const float lr = inp(F, 9)[i], li = inp(F, 10)[i], dt = expf(inp(F, 11)[g]);
        const float er = expf(lr * dt); const float sn = sinf(li * dt), cs = cosf(li * dt);
        const float br = er * cs, bi = er * sn;
        if (n == 0) {
            ((float2*)(ws + WS_LBAR))[i] = make_float2(br, bi);
            float pr = br, pi = bi;
#pragma unroll
            for (int k = 0; k < 8; ++k) { const float nr = pr * pr - pi * pi, ni = 2.f * pr * pi; pr = nr; pi = ni; }
            ((float2*)(ws + WS_PW))[i] = make_float2(pr, pi);
        }
        const float nr = br - 1.f, ni = bi, den = 1.f / (lr * lr + li * li);
        const float cr = (nr * lr + ni * li) * den, ci = (ni * lr - nr * li) * den;
        bf16* bb = (bf16*)(ws + WS_BB) + (size_t)g * 128 * 16;
        const float b_r = inp(F, 12)[(size_t)i * 16 + n], b_i = inp(F, 13)[(size_t)i * 16 + n];
        bb[p * 16 + n] = (bf16)f2bf(cr * b_r - ci * b_i); bb[(64 + p) * 16 + n] = (bf16)f2bf(cr * b_i + ci * b_r);
    }
    for (int i = gt; i < NG * 16 * 128; i += NGT) {
        const int k = i & 127, gn = i >> 7;
        ((bf16*)(ws + WS_CC))[i] = (bf16)f2bf(k < 64 ? inp(F, 14)[(size_t)gn * 64 + k] : -inp(F, 15)[(size_t)gn * 64 + (k - 64)]);
    }
}

struct S5Ctx { bf16x8 bb[4]; bf16x8 cc[8]; float lbr, lbi; int g; f32x4 dsk[2]; };
struct S5In { bf16x8 a; v2u us[2]; };
__device__ __forceinline__ void s5_load_ctx(S5Ctx& c, const Frame& F, int g, int lane) {
    const unsigned char* ws = F.ws; c.g = g;
    const bf16* bb = (const bf16*)(ws + WS_BB) + (size_t)g * 2048; const bf16* cc = (const bf16*)(ws + WS_CC) + (size_t)g * 2048;
#pragma unroll
    for (int cb = 0; cb < 4; ++cb) c.bb[cb] = *(const bf16x8*)(bb + (32 * cb + (lane & 31)) * 16 + 8 * (lane >> 5));
#pragma unroll
    for (int kb = 0; kb < 8; ++kb) { bf16x8 z = {0, 0, 0, 0, 0, 0, 0, 0}; if ((lane & 31) < 16) z = *(const bf16x8*)(cc + (lane & 31) * 128 + 16 * kb + 8 * (lane >> 5)); c.cc[kb] = z; }
    const float2 lb = ((const float2*)(ws + WS_LBAR))[g * 64 + lane]; c.lbr = lb.x; c.lbi = lb.y;
    c.dsk[0] = *(const f32x4*)(inp(F, 16) + g * 16 + 4 * (lane >> 5)); c.dsk[1] = *(const f32x4*)(inp(F, 16) + g * 16 + 8 + 4 * (lane >> 5));
}
template <int NV, bool FULL>
__device__ __forceinline__ void s5_fetch(S5In& in, const Frame& F, int g, int row0, int lane) {
    const bf16* U = (const bf16*)(F.ws + WS_U); const int ti = lane & 31, kh = lane >> 5;
    in.a = (bf16x8){0, 0, 0, 0, 0, 0, 0, 0}; in.us[0] = (v2u){0u, 0u}; in.us[1] = (v2u){0u, 0u};
    if (ti < NV) { const bf16* ur = U + (size_t)(row0 + ti) * 2048 + g * 16; in.a = *(const bf16x8*)(ur + 8 * kh);
        if (FULL) { in.us[0] = *(const v2u*)(ur + 4 * kh); in.us[1] = *(const v2u*)(ur + 8 + 4 * kh); } }
}
template <int NV, bool FULL>
__device__ __forceinline__ void s5_block(const S5Ctx& c, const Frame& F, LAS unsigned char* wl, int row0, const S5In& in, float& hr, float& hi, int lane) {
    const int ti = lane & 31, kh = lane >> 5;
    const bf16x8 a = in.a;
    LAS float* L = (LAS float*)wl;
#pragma unroll
    for (int cb = 0; cb < 4; ++cb) {
        f32x16 d = {0.f, 0.f, 0.f, 0.f, 0.f, 0.f, 0.f, 0.f, 0.f, 0.f, 0.f, 0.f, 0.f, 0.f, 0.f, 0.f};
        d = __builtin_amdgcn_mfma_f32_32x32x16_bf16(a, c.bb[cb], d, 0, 0, 0);
#pragma unroll
        for (int r = 0; r < 16; ++r) { const int i = (r & 3) + 8 * (r >> 2) + 4 * kh; if (i < NV) L[i * 132 + 32 * cb + ti] = d[r]; }
    }
    LDS_WAIT(); asm volatile("" ::: "memory");
    float bre[NV], bim[NV];
#pragma unroll
    for (int t = 0; t < NV; ++t) { bre[t] = L[t * 132 + lane]; bim[t] = L[t * 132 + 64 + lane]; }
    LDS_WAIT(); asm volatile("" ::: "memory");
    LAS bf16* Hh = (LAS bf16*)wl;
#pragma unroll
    for (int t = 0; t < NV; ++t) {
        const float nr = c.lbr * hr - c.lbi * hi + bre[t], ni = c.lbr * hi + c.lbi * hr + bim[t]; hr = nr; hi = ni;
        if (FULL) { Hh[t * 264 + lane] = (bf16)f2bf(hr); Hh[t * 264 + 64 + lane] = (bf16)f2bf(hi); }
    }
    if (FULL) {
        LDS_WAIT(); asm volatile("" ::: "memory");
        f32x16 y = {0.f, 0.f, 0.f, 0.f, 0.f, 0.f, 0.f, 0.f, 0.f, 0.f, 0.f, 0.f, 0.f, 0.f, 0.f, 0.f};
#pragma unroll
        for (int kb = 0; kb < 8; ++kb) { const bf16x8 hb = *(const LAS bf16x8*)(wl + ti * 528 + (16 * kb + 8 * kh) * 2); y = __builtin_amdgcn_mfma_f32_32x32x16_bf16(c.cc[kb], hb, y, 0, 0, 0); }
        LDS_WAIT(); asm volatile("" ::: "memory");
        if (ti < NV) {
            bf16* YP = (bf16*)(F.ws + WS_YPRE) + (size_t)(row0 + ti) * 1024 + c.g * 16;
#pragma unroll
            for (int rr = 0; rr < 2; ++rr) { const int n0 = 8 * rr + 4 * kh; const v2u uu = in.us[rr]; const f32x4 dd = c.dsk[rr];
                const float y0 = pg8::gelu_tanh(y[4 * rr + 0] + dd.x * blo(uu.x)), y1 = pg8::gelu_tanh(y[4 * rr + 1] + dd.y * bhi(uu.x)),
                            y2 = pg8::gelu_tanh(y[4 * rr + 2] + dd.z * blo(uu.y)), y3 = pg8::gelu_tanh(y[4 * rr + 3] + dd.w * bhi(uu.y));
                v2u o; o.x = pk2(y0, y1); o.y = pk2(y2, y3); *(v2u*)(YP + n0) = o; }
        }
    }
}
template <bool FULL>
__device__ __forceinline__ void s5_prompt_item(const Frame& F, LAS unsigned char* wl, int item, int lane) {
    const int seg = item & (NSEG - 1), g = (item >> 4) & 63, b = item >> 10;
    float2* est = (float2*)(F.ws + WS_EST) + ((size_t)(b * 64 + g) * NSEG) * 64;
    if (!FULL && seg == NSEG - 1) return;
    S5Ctx c; s5_load_ctx(c, F, g, lane);
    float hr = 0.f, hi = 0.f;
    if (FULL) { const float2 pw = ((const float2*)(F.ws + WS_PW))[g * 64 + lane];
        float2 ev[NSEG - 1];
#pragma unroll
        for (int s = 0; s < NSEG - 1; ++s) { ev[s] = make_float2(0.f, 0.f); if (s < seg) ev[s] = est[s * 64 + lane]; }
#pragma unroll
        for (int s = 0; s < NSEG - 1; ++s) if (s < seg) { const float nr = pw.x * hr - pw.y * hi + ev[s].x, ni = pw.x * hi + pw.y * hr + ev[s].y; hr = nr; hi = ni; } }
    S5In cur, nxt, nx2;
    const int rbase = SEQ * b + 32 * (8 * seg);
    if (seg == 0) { s5_fetch<16, FULL>(cur, F, g, R_REAL + 16 * b, lane); s5_fetch<32, FULL>(nxt, F, g, rbase, lane); s5_fetch<32, FULL>(nx2, F, g, rbase + 32, lane);
        s5_block<16, FULL>(c, F, wl, R_REAL + 16 * b, cur, hr, hi, lane); cur = nxt; nxt = nx2; }
    else { s5_fetch<32, FULL>(cur, F, g, rbase, lane); s5_fetch<32, FULL>(nxt, F, g, rbase + 32, lane); }
    for (int j = 0; j < 8; ++j) {
        const int row0 = rbase + 32 * j;
        if (j < 6) s5_fetch<32, FULL>(nx2, F, g, row0 + 64, lane);
        s5_block<32, FULL>(c, F, wl, row0, cur, hr, hi, lane); cur = nxt; nxt = nx2; }
    if (!FULL) est[seg * 64 + lane] = make_float2(hr, hi);
    else if (seg == NSEG - 1) { F.out[O_SRE_P + (size_t)(b * 64 + g) * 64 + lane] = hr; F.out[O_SIM_P + (size_t)(b * 64 + g) * 64 + lane] = hi; }
}
__device__ __forceinline__ void s5_sample_item(const Frame& F, LAS unsigned char* wl, int item, int lane) {
    const int g = item & 63, s = item >> 6;
    S5Ctx c; s5_load_ctx(c, F, g, lane);
    float hr = inp(F, 2)[(size_t)(s * 64 + g) * 64 + lane], hi = inp(F, 3)[(size_t)(s * 64 + g) * 64 + lane];
    S5In cur; s5_fetch<16, true>(cur, F, g, R_SAMPLE0 + 16 * s, lane);
    s5_block<16, true>(c, F, wl, R_SAMPLE0 + 16 * s, cur, hr, hi, lane);
    F.out[O_SRE_S + (size_t)(s * 64 + g) * 64 + lane] = hr; F.out[O_SIM_S + (size_t)(s * 64 + g) * 64 + lane] = hi;
}

__device__ __forceinline__ void pool_m_phase(const Frame& F) {
    const bf16* U = (const bf16*)(F.ws + WS_U); bf16* MB = (bf16*)(F.ws + WS_MB); const int tid = ltid();
    const int sub = tid >> 7, t128 = tid & 127, c0 = 8 * t128, w = 2 << (c0 >> 8);
    for (int run = F.vcu * 4 + sub; run < 546; run += F.G * 4) {
        const bool samp = run >= 514; int rowbase, pos0; const float* hist = nullptr; int b = 0;
        if (samp) { const int sq = run - 514; rowbase = R_SAMPLE0 + 16 * sq; pos0 = 0; hist = inp(F, 4) + (size_t)sq * 15 * 1024 + c0; }
        else { b = run / 257; const int j = run % 257; pos0 = 16 * j; rowbase = j == 0 ? R_REAL + 16 * b : SEQ * b + 16 * (j - 1); }
        v4u zr[31];
#pragma unroll
        for (int i = 0; i < 31; ++i) {
            const int rel = i - 15; v4u q = {0u, 0u, 0u, 0u};
            if (rel >= 0) q = *(const v4u*)(U + (size_t)(rowbase + rel) * 2048 + 1024 + c0);
            else if (samp) { const f32x4 a = *(const f32x4*)(hist + (size_t)(15 + rel) * 1024), b2 = *(const f32x4*)(hist + (size_t)(15 + rel) * 1024 + 4); q.x = pk2(a.x, a.y); q.y = pk2(a.z, a.w); q.z = pk2(b2.x, b2.y); q.w = pk2(b2.z, b2.w); }
            else { const int pos = pos0 + rel; if (pos >= 0) { const int row = pos < 16 ? R_REAL + 16 * b + pos : SEQ * b + (pos - 16); q = *(const v4u*)(U + (size_t)row * 2048 + 1024 + c0); } }
            zr[i] = q;
        }
        float s[8];
#pragma unroll
        for (int e = 0; e < 8; ++e) s[e] = 0.f;
#pragma unroll
        for (int jj = 1; jj < 16; ++jj) { const v4u q = zr[15 - jj]; const float f = jj < w ? 1.f : 0.f;
            s[0] += f * blo(q.x); s[1] += f * bhi(q.x); s[2] += f * blo(q.y); s[3] += f * bhi(q.y); s[4] += f * blo(q.z); s[5] += f * bhi(q.z); s[6] += f * blo(q.w); s[7] += f * bhi(q.w); }
#pragma unroll
        for (int t = 0; t < 16; ++t) {
            const v4u q = zr[15 + t]; const float z[8] = {blo(q.x), bhi(q.x), blo(q.y), bhi(q.y), blo(q.z), bhi(q.z), blo(q.w), bhi(q.w)};
            const int pos = pos0 + t; const float inv = 1.0f / (float)((samp || pos + 1 >= w) ? w : pos + 1);
            float mo[8];
#pragma unroll
            for (int e = 0; e < 8; ++e) { s[e] += z[e]; mo[e] = s[e] * inv - z[e]; }
            v4u o; o.x = pk2(mo[0], mo[1]); o.y = pk2(mo[2], mo[3]); o.z = pk2(mo[4], mo[5]); o.w = pk2(mo[6], mo[7]);
            *(v4u*)(MB + (size_t)(rowbase + t) * 1024 + c0) = o;
            const v4u q2 = zr[15 + t - 1], q4 = zr[15 + t - 3], q8 = zr[15 + t - 7], q16 = zr[15 + t - 15];
            v4u ql; ql.x = w == 2 ? q2.x : (w == 4 ? q4.x : (w == 8 ? q8.x : q16.x)); ql.y = w == 2 ? q2.y : (w == 4 ? q4.y : (w == 8 ? q8.y : q16.y));
            ql.z = w == 2 ? q2.z : (w == 4 ? q4.z : (w == 8 ? q8.z : q16.z)); ql.w = w == 2 ? q2.w : (w == 4 ? q4.w : (w == 8 ? q8.w : q16.w));
            s[0] -= blo(ql.x); s[1] -= bhi(ql.x); s[2] -= blo(ql.y); s[3] -= bhi(ql.y); s[4] -= blo(ql.z); s[5] -= bhi(ql.z); s[6] -= blo(ql.w); s[7] -= bhi(ql.w);
        }
    }
    const int gt = F.vcu * NTHREADS + tid, NGT = F.G * NTHREADS;
    for (int i = gt; i < (2 + 32) * 15 * 256; i += NGT) {
        const int c4 = (i & 255) * 4, q = i >> 8, r = q % 15, sq = q / 15;
        const int row = sq < 2 ? SEQ * sq + 4081 + r : R_SAMPLE0 + 16 * (sq - 2) + 1 + r;
        const v2u uu = *(const v2u*)(U + (size_t)row * 2048 + 1024 + c4);
        float* dst = sq < 2 ? F.out + O_POOL_P + (size_t)(sq * 15 + r) * 1024 + c4 : F.out + O_POOL_S + (size_t)((sq - 2) * 15 + r) * 1024 + c4;
        *(f32x4*)dst = (f32x4){blo(uu.x), bhi(uu.x), blo(uu.y), bhi(uu.y)};
    }
}

__device__ __forceinline__ void gmeta_phase(const Frame& F) {
    const bf16* XN = (const bf16*)(F.ws + WS_XN); const bf16* WU = (const bf16*)(F.ws + WS_WUP); const float* ss = (const float*)(F.ws + WS_SS1); float* GM = (float*)(F.ws + WS_GMETA);
    const int gw = F.vcu * NWAVES + F.wave, NGW = F.G * NWAVES; const int lane = ltid() & 63;
    for (int jb = gw; jb < DFF; jb += 3 * NGW) {
        v4u xv[4][4], wv[3][4];
#pragma unroll
        for (int i = 0; i < 4; ++i) { const int c = 8 * lane + 512 * i;
#pragma unroll
            for (int q = 0; q < 4; ++q) xv[q][i] = *(const v4u*)(XN + (size_t)(R_REAL + 16 * (q >> 1) + 14 + (q & 1)) * LDP + c);
#pragma unroll
            for (int t = 0; t < 3; ++t) { const int j = jb + t * NGW; wv[t][i] = (v4u){0u, 0u, 0u, 0u}; if (j < DFF) wv[t][i] = *(const v4u*)(WU + (size_t)((j >> 7) * 256 + (j & 127)) * LDP + c); } }
#pragma unroll
        for (int t = 0; t < 3; ++t) { const int j = jb + t * NGW;
            float a[4] = {0.f, 0.f, 0.f, 0.f};
#pragma unroll
            for (int i = 0; i < 4; ++i) { const v4u w = wv[t][i]; const float wf[8] = {blo(w.x), bhi(w.x), blo(w.y), bhi(w.y), blo(w.z), bhi(w.z), blo(w.w), bhi(w.w)};
#pragma unroll
                for (int q = 0; q < 4; ++q) { const v4u x = xv[q][i];
                    a[q] += wf[0] * blo(x.x) + wf[1] * bhi(x.x) + wf[2] * blo(x.y) + wf[3] * bhi(x.y) + wf[4] * blo(x.z) + wf[5] * bhi(x.z) + wf[6] * blo(x.w) + wf[7] * bhi(x.w); } }
#pragma unroll
            for (int q = 0; q < 4; ++q) a[q] = wave_sum(a[q]);
            if (lane < 4 && j < DFF) { const int q = lane; const int Rm = R_REAL + 16 * (q >> 1) + 14 + (q & 1); const float v = q == 0 ? a[0] : (q == 1 ? a[1] : (q == 2 ? a[2] : a[3]));
                GM[(size_t)q * DFF + j] = v * rsqrtf(ss[Rm] * (1.0f / DM) + RMS_EPS); }
        }
    }
}

__device__ __forceinline__ void fixup_phase(const Frame& F) {
    const float* GF = (const float*)(F.ws + WS_GFIX); const float* VF = (const float*)(F.ws + WS_VFIX); const float* GS = (const float*)(F.ws + WS_GSRC); const float* GM = (const float*)(F.ws + WS_GMETA);
    const float* cw = inp(F, 23); const float* cb = inp(F, 24); const float* hist = inp(F, 5); bf16* H = (bf16*)(F.ws + WS_H);
    const int tid = ltid(); const int gt = F.vcu * NTHREADS + tid, NGT = F.G * NTHREADS;
    for (int idx = gt; idx < 320 * 704; idx += NGT) {
        const int id = idx / 704, j = (idx % 704) * 8;
        const float* g0p = GF + (size_t)id * DFF + j; const float* v0p = VF + (size_t)id * DFF + j; const float* p1p; const float* p2p; int R;
        if (id < 256) {
            const int pm = id >> 3, blk = (id & 7) >> 1, rr = id & 1; R = 256 * pm + 64 * blk + rr;
            const bool start = blk == 0 && (pm == 0 || pm == 16);
            const float* S0; const float* S1;
            if (start) { const int b = pm >> 4; S0 = GM + (size_t)(b * 2 + 0) * DFF; S1 = GM + (size_t)(b * 2 + 1) * DFF; }
            else { const int sb = blk > 0 ? pm * 8 + (blk - 1) * 2 : (pm - 1) * 8 + 6; S0 = GS + (size_t)sb * DFF; S1 = GS + (size_t)(sb + 1) * DFF; }
            if (rr == 0) { p1p = S1 + j; p2p = S0 + j; } else { p1p = GF + (size_t)(id - 1) * DFF + j; p2p = S1 + j; }
        } else {
            const int q = id - 256, sq = q >> 1, rr = q & 1; R = R_SAMPLE0 + 16 * sq + rr;
            const float* h0 = hist + (size_t)(sq * 2 + 0) * DFF; const float* h1 = hist + (size_t)(sq * 2 + 1) * DFF;
            if (rr == 0) { p1p = h1 + j; p2p = h0 + j; } else { p1p = GF + (size_t)(id - 1) * DFF + j; p2p = h1 + j; }
        }
        f32x4 g0[2], v0[2], p1[2], p2[2], w0[2], w1[2], w2[2], bb[2];
#pragma unroll
        for (int h = 0; h < 2; ++h) { g0[h] = *(const f32x4*)(g0p + 4 * h); v0[h] = *(const f32x4*)(v0p + 4 * h); p1[h] = *(const f32x4*)(p1p + 4 * h); p2[h] = *(const f32x4*)(p2p + 4 * h);
            w0[h] = *(const f32x4*)(cw + j + 4 * h); w1[h] = *(const f32x4*)(cw + DFF + j + 4 * h); w2[h] = *(const f32x4*)(cw + 2 * DFF + j + 4 * h); bb[h] = *(const f32x4*)(cb + j + 4 * h); }
        v4u o;
        { const f32x4 gc = bb[0] + p2[0] * w0[0] + p1[0] * w1[0] + g0[0] * w2[0];
          o.x = pk2(pg8::gelu_tanh(gc.x) * v0[0].x, pg8::gelu_tanh(gc.y) * v0[0].y); o.y = pk2(pg8::gelu_tanh(gc.z) * v0[0].z, pg8::gelu_tanh(gc.w) * v0[0].w); }
        { const f32x4 gc = bb[1] + p2[1] * w0[1] + p1[1] * w1[1] + g0[1] * w2[1];
          o.z = pk2(pg8::gelu_tanh(gc.x) * v0[1].x, pg8::gelu_tanh(gc.y) * v0[1].y); o.w = pk2(pg8::gelu_tanh(gc.z) * v0[1].z, pg8::gelu_tanh(gc.w) * v0[1].w); }
        *(v4u*)(H + (size_t)R * DFF + j) = o;
    }
}
__device__ __forceinline__ void final_phase(const Frame& F) {
    const float* gf = inp(F, 26); const float* gn = inp(F, 21); const bf16* XNb = (const bf16*)(F.ws + WS_XN);
    const bf16* FA = (const bf16*)(F.ws + WS_FA); const bf16* FBb = (const bf16*)(F.ws + WS_FB);
    const int gw = F.vcu * NWAVES + F.wave, NGW = F.G * NWAVES; const int lane = ltid() & 63;
    f32x4 rg[8];
#pragma unroll
    for (int j = 0; j < 8; ++j) { const f32x4 g = ((const f32x4*)gn)[64 * j + lane]; rg[j] = (f32x4){1.0f / g.x, 1.0f / g.y, 1.0f / g.z, 1.0f / g.w}; }
    v2u xb[8], xbn[8], xb2[8], fb[8], fbn[8], fb2[8]; int R = gw;
    auto fetch = [&](int Rr, v2u (&x)[8], v2u (&f)[8]) {
        if (Rr < R_REAL) { const v2u* xr = (const v2u*)(XNb + (size_t)Rr * LDP) + lane; const v2u* fr_ = (const v2u*)((Rr < F_SPLIT ? FA + (size_t)Rr * DM : FBb + (size_t)(Rr - F_SPLIT) * DM)) + lane;
#pragma unroll
            for (int j = 0; j < 8; ++j) { x[j] = xr[64 * j]; f[j] = fr_[64 * j]; } } };
    fetch(R, xb, fb); fetch(R + NGW, xbn, fbn);
    while (R < R_REAL) {
        fetch(R + 2 * NGW, xb2, fb2);
        f32x4 v[8]; float s = 0.f;
#pragma unroll
        for (int j = 0; j < 8; ++j) { v[j].x = blo(xb[j].x) * rg[j].x + blo(fb[j].x); v[j].y = bhi(xb[j].x) * rg[j].y + bhi(fb[j].x); v[j].z = blo(xb[j].y) * rg[j].z + blo(fb[j].y); v[j].w = bhi(xb[j].y) * rg[j].w + bhi(fb[j].y);
            s += (v[j].x * v[j].x + v[j].y * v[j].y) + (v[j].z * v[j].z + v[j].w * v[j].w); }
        const float rstd = rsqrtf(wave_sum(s) * (1.0f / DM) + RMS_EPS);
        f32x4* xo = (f32x4*)(F.out + (size_t)R * DM) + lane;
#pragma unroll
        for (int j = 0; j < 8; ++j) { const f32x4 g = ((const f32x4*)gf)[64 * j + lane]; __builtin_nontemporal_store(v[j] * rstd * g, xo + 64 * j); }
#pragma unroll
        for (int j = 0; j < 8; ++j) { xb[j] = xbn[j]; fb[j] = fbn[j]; xbn[j] = xb2[j]; fbn[j] = fb2[j]; }
        R += NGW;
    }
}

struct Args { const float* in[27]; float* out; unsigned char* ws; };
#ifndef PROBE
#define PROBE 0
#endif
__global__ void __launch_bounds__(NTHREADS, 2) hymba_fwd(Args args) {
    extern __shared__ __attribute__((aligned(16))) unsigned char lds[];
    cg::grid_group grid = cg::this_grid();
    Frame F;
    F.lds = (LAS unsigned char*)lds;
    F.wave = __builtin_amdgcn_readfirstlane((int)threadIdx.x >> 6);
    F.G = gridDim.x; { const int bx = blockIdx.x; F.vcu = (F.G % 8 == 0) ? (bx % 8) * (F.G / 8) + bx / 8 : bx; }
    if (threadIdx.x == 0) {
#pragma unroll
        for (int i = 0; i < 27; ++i) ((LAS unsigned long long*)(F.lds + TAB_OFF))[i] = (unsigned long long)args.in[i];
        ((LAS unsigned*)(F.lds + BARST_OFF))[0] = 0u; ((LAS unsigned*)(F.lds + BARST_OFF))[1] = 0u; ((LAS unsigned*)(F.lds + BARST_OFF + 64))[0] = 0u;
    }
    __syncthreads();
    const XcdBarrier bar = xcd_barrier_post((unsigned*)(args.ws + WS_BAR), (volatile LAS unsigned*)(F.lds + BARST_OFF));
#ifndef TPROBE_A
#define TPROBE_A -1
#define TPROBE_B -1
#endif
    int stamp_i_ = 0;
#define STAMP() do { if (TPROBE_A >= 0 && blockIdx.x == 0 && threadIdx.x == 0) ((volatile LAS unsigned long long*)(F.lds + BARST_OFF + 128))[stamp_i_] = __builtin_amdgcn_s_memrealtime(); ++stamp_i_; } while (0)
#define GRID_BAR() do { xcd_barrier(bar); STAMP(); } while (0)
    STAMP();
    F.out = (float*)(GAS float*)args.out; F.ws = (unsigned char*)(GAS unsigned char*)args.ws;
    unsigned char* ws = F.ws;
    bf16* XN = (bf16*)(ws + WS_XN); bf16* U = (bf16*)(ws + WS_U); bf16* YPRE = (bf16*)(ws + WS_YPRE); bf16* MB = (bf16*)(ws + WS_MB); bf16* YCAT = (bf16*)(ws + WS_YCAT); bf16* H = (bf16*)(ws + WS_H);
    float* SS1 = (float*)(ws + WS_SS1); float* SS2 = (float*)(ws + WS_SS2);
    const int gw = F.vcu * NWAVES + F.wave, NGW = F.G * NWAVES;
    LAS unsigned char* wl = F.lds + F.wave * S5_WLDS;

    auto forward_ = [&]() __attribute__((always_inline)) {
    p0_prologue(F);
    if (PROBE == 1) { __syncthreads(); p0_prologue(F); }
    if (args.ws == nullptr) grid.sync();
    GRID_BAR();
    { pg8::Gemm g{XN, (const bf16*)(ws + WS_WIN), LDP, LDP, 2048, 0}; pg8::RemSplit S; S.init(35, 8, 16, 8, F.G, (int)blockIdx.x);
      pg8::EpiBf16 E{U, 2048}; const pg8::SKBuf sk{(float*)(ws + WS_SLOTS), (unsigned*)(ws + WS_FLAGS), (int)blockIdx.x};
      pg8::gemm_phase<pg8::EpiBf16, pg8::RemSplit, true, true, true>(F.lds, g, S, E, sk); GRID_BAR(); pg8::gemm_reduce(S, E, sk);
      if (PROBE == 4) { GRID_BAR(); pg8::gemm_phase<pg8::EpiBf16, pg8::RemSplit, true, true, true>(F.lds, g, S, E, sk); GRID_BAR(); pg8::gemm_reduce(S, E, sk); } }
    GRID_BAR();
    for (int it = gw; it < 2 * 64 * NSEG; it += NGW) s5_prompt_item<false>(F, wl, it, ltid() & 63);
    for (int it = gw; it < DECB * 64; it += NGW) s5_sample_item(F, wl, it, ltid() & 63);
    pool_m_phase(F);
    if (PROBE == 2) { __syncthreads();
        for (int it = gw; it < 2 * 64 * NSEG; it += NGW) s5_prompt_item<false>(F, wl, it, ltid() & 63);
        for (int it = gw; it < DECB * 64; it += NGW) s5_sample_item(F, wl, it, ltid() & 63);
        pool_m_phase(F); }
    GRID_BAR();
    for (int it = gw; it < 2 * 64 * NSEG; it += NGW) s5_prompt_item<true>(F, wl, it, ltid() & 63);
    if (PROBE == 2) { for (int it = gw; it < 2 * 64 * NSEG; it += NGW) s5_prompt_item<true>(F, wl, it, ltid() & 63); }
    GRID_BAR();
    if (F.G > 140 + 35) {
        if ((int)blockIdx.x < 140) { pg8::Gemm g{YPRE, (const bf16*)(ws + WS_WGLU), 1024, 1024, 1024, 0}; pg8::StaticOrder S; S.init(35, 4, 16, 140, (int)blockIdx.x);
            pg8::EpiGlu E{YPRE, YCAT}; pg8::gemm_phase<pg8::EpiGlu, pg8::StaticOrder, true, true>(F.lds, g, S, E); }
        else { pg8::Gemm g{MB, (const bf16*)(ws + WS_WPOOL), 1024, 256, 256, 256}; pg8::StaticOrder S; S.init(35, 4, 4, F.G - 140, (int)blockIdx.x - 140);
            pg8::EpiPool E{YCAT, inp(F, 19)}; pg8::gemm_phase<pg8::EpiPool, pg8::StaticOrder, true, true>(F.lds, g, S, E); }
    } else {
        { pg8::Gemm g{MB, (const bf16*)(ws + WS_WPOOL), 1024, 256, 256, 256}; pg8::StaticOrder S; S.init(35, 4, 4, F.G, (int)blockIdx.x);
          pg8::EpiPool E{YCAT, inp(F, 19)}; pg8::gemm_phase<pg8::EpiPool, pg8::StaticOrder, true, true>(F.lds, g, S, E); }
        __syncthreads();
        { pg8::Gemm g{YPRE, (const bf16*)(ws + WS_WGLU), 1024, 1024, 1024, 0}; pg8::StaticOrder S; S.init(35, 4, 16, F.G, (int)blockIdx.x);
          pg8::EpiGlu E{YPRE, YCAT}; pg8::gemm_phase<pg8::EpiGlu, pg8::StaticOrder, true, true>(F.lds, g, S, E); }
    }
    GRID_BAR();
    if (PROBE == 12) { GRID_BAR();
        if ((int)blockIdx.x < 140) { pg8::Gemm g{YPRE, (const bf16*)(ws + WS_WGLU), 1024, 1024, 1024, 0}; pg8::StaticOrder S; S.init(35, 4, 16, 140, (int)blockIdx.x);
            pg8::EpiGlu E{YPRE, YCAT}; pg8::gemm_phase<pg8::EpiGlu, pg8::StaticOrder, true, true>(F.lds, g, S, E); }
        else { pg8::Gemm g{MB, (const bf16*)(ws + WS_WPOOL), 1024, 256, 256, 256}; pg8::StaticOrder S; S.init(35, 4, 4, F.G - 140, (int)blockIdx.x - 140);
            pg8::EpiPool E{YCAT, inp(F, 19)}; pg8::gemm_phase<pg8::EpiPool, pg8::StaticOrder, true, true>(F.lds, g, S, E); } }
    { pg8::Gemm g{YCAT, (const bf16*)(ws + WS_WOUT), LDP, LDP, 2048, 0}; pg8::RemSplit S; S.init(35, 8, 16, 8, F.G, (int)blockIdx.x);
      pg8::EpiOut E{SS2, inp(F, 7), inp(F, 21), XN, SS1};
      const pg8::SKBuf sk{(float*)(ws + WS_SLOTS), (unsigned*)(ws + WS_FLAGS) + 512, (int)blockIdx.x};
      pg8::gemm_phase<pg8::EpiOut, pg8::RemSplit, true, true, true>(F.lds, g, S, E, sk); GRID_BAR(); pg8::gemm_reduce(S, E, sk);
      if (PROBE == 11) { GRID_BAR(); for (int i = F.vcu * NTHREADS + ltid(); i < 9216; i += F.G * NTHREADS) SS1[i] = 0.f; GRID_BAR();
          pg8::gemm_phase<pg8::EpiOut, pg8::RemSplit, true, true, true>(F.lds, g, S, E, sk); GRID_BAR(); pg8::gemm_reduce(S, E, sk); } }
    GRID_BAR();
    gmeta_phase(F);
    { pg8::Gemm g{XN, (const bf16*)(ws + WS_WUP), LDP, LDP, 2048, 0}; pg8::StaticOrder S; S.init(34, 44, 32, F.G, (int)blockIdx.x);
      pg8::EpiUp E{SS1, inp(F, 23), inp(F, 24), H, (float*)(ws + WS_GFIX), (float*)(ws + WS_VFIX), (float*)(ws + WS_GSRC), F.out + O_CONV_P, F.out + O_CONV_S};
      pg8::gemm_phase<pg8::EpiUp, pg8::StaticOrder, true, true>(F.lds, g, S, E);
      if (PROBE == 3) { __syncthreads(); pg8::gemm_phase<pg8::EpiUp, pg8::StaticOrder, true, true>(F.lds, g, S, E); }
      if (PROBE == 13) { __syncthreads(); pg8::EpiBf16 E2{(bf16*)(ws + WS_FA), 0}; pg8::gemm_phase<pg8::EpiBf16, pg8::StaticOrder, true, true>(F.lds, g, S, E2); } }
    if (F.G == 256 && (int)blockIdx.x >= 216) { __syncthreads(); p0_convert(F, I_EARLY, I_EARLY + I_DOWN, ((int)blockIdx.x - 216) * NWAVES + F.wave, 40 * NWAVES, ltid() & 63); }
    GRID_BAR();
    fixup_phase(F);
    GRID_BAR();
    { pg8::Gemm g{H, (const bf16*)(ws + WS_WDOWN), DFF, DFF, DFF, 0}; pg8::RemSplit S; S.init(34, 8, 44, 16, F.G, (int)blockIdx.x);
      pg8::EpiF E{(bf16*)(ws + WS_FA), (bf16*)(ws + WS_FB), F_SPLIT};
      const pg8::SKBuf sk{(float*)(ws + WS_SLOTS), (unsigned*)(ws + WS_FLAGS) + 768, (int)blockIdx.x};
      pg8::gemm_phase<pg8::EpiF, pg8::RemSplit, true, true, true>(F.lds, g, S, E, sk); GRID_BAR(); pg8::gemm_reduce(S, E, sk); }
    GRID_BAR();
    if (PROBE == 9) { GRID_BAR(); pg8::Gemm g{H, (const bf16*)(ws + WS_WDOWN), DFF, DFF, DFF, 0}; pg8::RemSplit S; S.init(34, 8, 44, 16, F.G, (int)blockIdx.x);
        const pg8::SKBuf sk{(float*)(ws + WS_SLOTS), (unsigned*)(ws + WS_FLAGS) + 768, (int)blockIdx.x}; pg8::EpiBf16 E{XN, 2048};
        pg8::gemm_phase<pg8::EpiBf16, pg8::RemSplit, true, true, true>(F.lds, g, S, E, sk); GRID_BAR(); pg8::gemm_reduce(S, E, sk); }
    if (PROBE == 10) { GRID_BAR(); const int gw2 = F.vcu * NWAVES + F.wave, lane2 = ltid() & 63;
        for (int R = gw2; R < R_REAL; R += F.G * NWAVES) { f32x4* xr = (f32x4*)(F.out + (size_t)R * DM) + lane2;
#pragma unroll
            for (int j = 0; j < 8; ++j) { f32x4 v = xr[64 * j]; asm volatile("" : "+v"(v)); xr[64 * j] = v; } } }
    if (PROBE == 6) { pg8::Gemm g{H, (const bf16*)(ws + WS_WDOWN), DFF, DFF, DFF, 0}; pg8::StaticOrder S; S.init(34, 8, 88, F.G, (int)blockIdx.x);
        pg8::EpiBf16 E{XN, 2048}; pg8::gemm_phase<pg8::EpiBf16, pg8::StaticOrder, true, true>(F.lds, g, S, E); }
    if (PROBE == 7) { GRID_BAR(); GRID_BAR(); GRID_BAR(); GRID_BAR(); GRID_BAR(); GRID_BAR(); GRID_BAR(); GRID_BAR(); }
    final_phase(F);
    if (TPROBE_A >= 0) { asm volatile("s_waitcnt vmcnt(0)" ::: "memory"); __syncthreads(); STAMP();
        if (blockIdx.x == 0 && threadIdx.x == 0) { volatile LAS unsigned long long* ts = (volatile LAS unsigned long long*)(F.lds + BARST_OFF + 128);
            const unsigned long long d = ts[TPROBE_B] - ts[TPROBE_A], t0 = __builtin_amdgcn_s_memrealtime();
            while (__builtin_amdgcn_s_memrealtime() - t0 < d) __builtin_amdgcn_s_sleep(8); } }
    };
    forward_();
    if (PROBE == 8) { GRID_BAR(); forward_(); }
}

extern "C" void kernel_launch(void* const* d_in, const int* in_sizes, int n_in, void* d_out, int out_size, void* d_ws, size_t ws_size, hipStream_t stream) {
    static int grid = 0;
    if (grid == 0) {
        if (n_in != 27 || out_size != 19009536 || ws_size < WS_END) { fprintf(stderr, "kernel_launch: unexpected shapes (n_in %d, out %d, ws %zu)\n", n_in, out_size, ws_size); grid = -1; return; }
        int dev = 0, cus = 0, per_cu = 0;
        if (hipGetDevice(&dev) != hipSuccess || hipDeviceGetAttribute(&cus, hipDeviceAttributeMultiprocessorCount, dev) != hipSuccess) { grid = -1; return; }
        if (hipFuncSetAttribute((const void*)hymba_fwd, hipFuncAttributeMaxDynamicSharedMemorySize, LDS_BYTES) != hipSuccess) { fprintf(stderr, "kernel_launch: hipFuncSetAttribute failed\n"); grid = -1; return; }
        if (hipOccupancyMaxActiveBlocksPerMultiprocessor(&per_cu, (const void*)hymba_fwd, NTHREADS, LDS_BYTES) != hipSuccess || per_cu < 1) { fprintf(stderr, "kernel_launch: occupancy query says %d\n", per_cu); per_cu = 1; }
        (void)hipGetLastError();
        grid = cus;
    }
    if (grid < 0) return;
    if (hipMemsetAsync((char*)d_ws + WS_BAR, 0, XCD_BAR_WORDS * 4, stream) != hipSuccess) { fprintf(stderr, "kernel_launch: memset of barrier words failed\n"); return; }
    Args a{};
    for (int i = 0; i < 27; ++i) a.in[i] = (const float*)d_in[i];
    a.out = (float*)d_out; a.ws = (unsigned char*)d_ws;
    void* kargs[] = {&a};
    hipError_t e = hipLaunchCooperativeKernel((const void*)hymba_fwd, dim3(grid), dim3(NTHREADS), kargs, LDS_BYTES, stream);
    if (e != hipSuccess) fprintf(stderr, "kernel_launch: cooperative launch failed: %s (grid %d)\n", hipGetErrorString(e), grid);
}
```

```cpp
#include <hip/hip_runtime.h>
#include <hip/hip_cooperative_groups.h>
#include <cstdio>
#include <cstdint>
namespace cg = cooperative_groups;

namespace pg8 {
#define PG8_LAS __attribute__((address_space(3)))
typedef unsigned short bf16_t;
typedef short bf16x8 __attribute__((ext_vector_type(8)));
typedef float f32x4 __attribute__((ext_vector_type(4)));
typedef float f32x2 __attribute__((ext_vector_type(2)));
typedef unsigned u32x4 __attribute__((ext_vector_type(4)));
typedef unsigned u32x2 __attribute__((ext_vector_type(2)));
constexpr int BM = 256, BK = 64, HALF = 128, HTB = HALF * BK * 2  , STAGE_BYTES = 8 * HTB, NXCD = 8, WGM = 8;

__host__ __device__ __forceinline__ int lds_byte(int r, int c) { const int st = (r >> 4) * 2 + (c >> 5), rr = r & 15, cc = c & 31, ob = rr * 64 + cc * 2; return st * 1024 + (ob ^ (((ob >> 9) & 1) << 5)); }
__host__ __device__ __forceinline__ void stage_rc(int b, int& R, int& C) { const int st = b / 1024, sb = b % 1024, swz = sb ^ (((sb >> 9) & 1) << 5); R = (st >> 1) * 16 + swz / 64; C = (st & 1) * 32 + (swz % 64) / 2; }
__host__ __device__ __forceinline__ int perm32(int rho) { const int n = rho >> 4, i = rho & 15; return 8 * (i >> 2) + 4 * n + (i & 3); }

struct Unit { int pm, pn, k0, nt, kind, nwait; };
struct Gemm {
    const bf16_t* A; const bf16_t* Bt; int lda, ldb, K, a_pn_off;
    __device__ __forceinline__ const char* abase(const Unit& u) const { return (const char*)(A + ((size_t)u.pm * BM * lda + (size_t)u.pn * a_pn_off + (size_t)u.k0 * BK)); }
    __device__ __forceinline__ const char* bbase(const Unit& u) const { return (const char*)(Bt + ((size_t)u.pn * BM * ldb + (size_t)u.k0 * BK)); }
};

struct StaticOrder {
    int nM, nN, nwg, G, c, ntile;
    __host__ __device__ void init(int nM_, int nN_, int ntile_, int G_, int c_) { nM = nM_; nN = nN_; nwg = nM * nN; ntile = ntile_; G = G_; c = c_; }
    __host__ __device__ bool next(int i, Unit& u) const { const long L = (long)i * G + c; if (L >= nwg) return false; map((int)L, u); return true; }
    __host__ __device__ bool map(int L, Unit& u) const {
        int wgid = L; { const int q = nwg / NXCD, r = nwg % NXCD, xcd = wgid % NXCD, off = wgid / NXCD; wgid = (xcd < r ? xcd * (q + 1) : r * (q + 1) + (xcd - r) * q) + off; }
        const int nig = WGM * nN, gid = wgid / nig, fm = gid * WGM, gsz = (nM - fm) < WGM ? (nM - fm) : WGM;
        u.pm = fm + ((wgid % nig) % gsz); u.pn = (wgid % nig) / gsz; u.k0 = 0; u.nt = ntile; u.kind = 0; u.nwait = 0; return true;
    }
    __device__ __forceinline__ void a_ready(const Unit&) const {}
    __device__ __forceinline__ void done(const Unit&) const {}
};

struct RemSplit {
    StaticOrder so; int q, R, S, P, c;
    __device__ void init(int nM_, int nN_, int P_, int S_, int G_, int c_) { so.init(nM_, nN_, 2 * P_, G_, c_); q = so.nwg / G_; R = so.nwg % G_; S = S_; P = P_; c = c_; }
    __device__ bool next(int i, Unit& u) const {
        if (c < R * S) { if (i == 0) { so.map(q * so.G + c / S, u); const int sl = c % S, lo = sl * P / S, hi = (sl + 1) * P / S; u.k0 = 2 * lo; u.nt = 2 * (hi - lo); u.kind = 1; return true; } i -= 1; }
        if (i >= q) return false; so.map(i * so.G + c, u); return true;
    }
    __device__ bool reducer(Unit& u, unsigned& mask, int& base) const {
        if (c >= R * S) return false; so.map(q * so.G + c / S, u); base = (c / S) * S; const int j = c % S;
        mask = S == 16 ? 1u << ((j >> 3) * 8 + ((j >> 1) & 3) * 2 + (j & 1)) : 3u << ((j >> 2) * 8 + (j & 3) * 2); return true;
    }
    __device__ __forceinline__ void a_ready(const Unit&) const {}
    __device__ __forceinline__ void done(const Unit&) const {}
};
struct SKBuf { float* slots; unsigned* flags; int v; };

__device__ __forceinline__ unsigned cvt_pk_bf16(float lo, float hi) { unsigned r; asm volatile("v_cvt_pk_bf16_f32 %0, %1, %2" : "=v"(r) : "v"(lo), "v"(hi)); return r; }
__device__ __forceinline__ float bflo(unsigned w) { return __uint_as_float(w << 16); }
__device__ __forceinline__ float bfhi(unsigned w) { return __uint_as_float(w & 0xffff0000u); }
__device__ __forceinline__ float gelu_tanh(float x) {
    const float u = x * (1.0f + 0.044715f * x * x);
    const float e = __builtin_amdgcn_exp2f(u * (-2.0f * 0.7978845608028654f * 1.4426950408889634f));
    return x * __builtin_amdgcn_rcpf(1.0f + e);
}
__device__ __forceinline__ float sigmoidf_(float x) { return __builtin_amdgcn_rcpf(1.0f + __builtin_amdgcn_exp2f(x * -1.4426950408889634f)); }

struct EpiBf16 {
    static constexpr bool PERM = true, AFTER_DRAIN = false;
    bf16_t* O; int ldc;
    __device__ __forceinline__ void operator()(const f32x4 (&acc)[2][2][4][2], const Unit& u, int wr, int wc, int fr, int fq, unsigned mask = 0xFFFFu) const {
        const int row0 = u.pm * BM + wr * 64 + fr; const int col0 = u.pn * BM + wc * 32 + 8 * fq;
#pragma unroll
        for (int ai = 0; ai < 2; ++ai)
#pragma unroll
            for (int m = 0; m < 4; ++m) { bf16_t* rowp = O + (size_t)(row0 + ai * HALF + m * 16) * ldc + col0;
#pragma unroll
                for (int bj = 0; bj < 2; ++bj) { if (!((mask >> (ai * 8 + m * 2 + bj)) & 1u)) continue; const f32x4 v0 = acc[ai][bj][m][0], v1 = acc[ai][bj][m][1];
                    u32x4 w; w.x = cvt_pk_bf16(v0[0], v0[1]); w.y = cvt_pk_bf16(v0[2], v0[3]); w.z = cvt_pk_bf16(v1[0], v1[1]); w.w = cvt_pk_bf16(v1[2], v1[3]);
                    *(u32x4*)(rowp + bj * HALF) = w; } }
    }
};
struct EpiF {
    static constexpr bool PERM = true, AFTER_DRAIN = false;
    bf16_t* Oa; bf16_t* Ob; int split;
    __device__ __forceinline__ void operator()(const f32x4 (&acc)[2][2][4][2], const Unit& u, int wr, int wc, int fr, int fq, unsigned mask = 0xFFFFu) const {
        const int rowt = u.pm * BM; bf16_t* base = rowt < split ? Oa + (size_t)rowt * 2048 : Ob + (size_t)(rowt - split) * 2048;
        const int row0 = wr * 64 + fr; const int col0 = u.pn * BM + wc * 32 + 8 * fq;
#pragma unroll
        for (int ai = 0; ai < 2; ++ai)
#pragma unroll
            for (int m = 0; m < 4; ++m) { bf16_t* rowp = base + (size_t)(row0 + ai * HALF + m * 16) * 2048 + col0;
#pragma unroll
                for (int bj = 0; bj < 2; ++bj) { if (!((mask >> (ai * 8 + m * 2 + bj)) & 1u)) continue; const f32x4 v0 = acc[ai][bj][m][0], v1 = acc[ai][bj][m][1];
                    u32x4 w; w.x = cvt_pk_bf16(v0[0], v0[1]); w.y = cvt_pk_bf16(v0[2], v0[3]); w.z = cvt_pk_bf16(v1[0], v1[1]); w.w = cvt_pk_bf16(v1[2], v1[3]);
                    *(u32x4*)(rowp + bj * HALF) = w; } }
    }
};
struct EpiPool {
    static constexpr bool PERM = true, AFTER_DRAIN = false;
    bf16_t* O; const float* scale;
    __device__ __forceinline__ void operator()(const f32x4 (&acc)[2][2][4][2], const Unit& u, int wr, int wc, int fr, int fq) const {
        const int row0 = u.pm * BM + wr * 64 + fr; const int c0 = u.pn * BM + wc * 32 + 8 * fq;
        f32x4 sv[2][2];
#pragma unroll
        for (int bj = 0; bj < 2; ++bj)
#pragma unroll
            for (int n = 0; n < 2; ++n) sv[bj][n] = *(const f32x4*)(scale + c0 + bj * HALF + 4 * n);
#pragma unroll
        for (int ai = 0; ai < 2; ++ai)
#pragma unroll
            for (int m = 0; m < 4; ++m) { bf16_t* rowp = O + (size_t)(row0 + ai * HALF + m * 16) * 2112 + 1024 + c0;
#pragma unroll
                for (int bj = 0; bj < 2; ++bj) { const f32x4 v0 = acc[ai][bj][m][0] * sv[bj][0], v1 = acc[ai][bj][m][1] * sv[bj][1];
                    u32x4 w; w.x = cvt_pk_bf16(v0[0], v0[1]); w.y = cvt_pk_bf16(v0[2], v0[3]); w.z = cvt_pk_bf16(v1[0], v1[1]); w.w = cvt_pk_bf16(v1[2], v1[3]);
                    *(u32x4*)(rowp + bj * HALF) = w; } }
    }
};
struct EpiGlu {
    static constexpr bool PERM = true, AFTER_DRAIN = false;
    const bf16_t* YP; bf16_t* O;
    __device__ __forceinline__ void operator()(const f32x4 (&acc)[2][2][4][2], const Unit& u, int wr, int wc, int fr, int fq) const {
        const int row0 = u.pm * BM + wr * 64 + fr; const int c0 = u.pn * BM + wc * 32 + 8 * fq;
        u32x4 yp[2][4][2];
#pragma unroll
        for (int ai = 0; ai < 2; ++ai)
#pragma unroll
            for (int m = 0; m < 4; ++m)
#pragma unroll
                for (int bj = 0; bj < 2; ++bj) yp[ai][m][bj] = *(const u32x4*)(YP + (size_t)(row0 + ai * HALF + m * 16) * 1024 + c0 + bj * HALF);
#pragma unroll
        for (int ai = 0; ai < 2; ++ai)
#pragma unroll
            for (int m = 0; m < 4; ++m) { const size_t R = (size_t)(row0 + ai * HALF + m * 16);
#pragma unroll
                for (int bj = 0; bj < 2; ++bj) { const u32x4 y = yp[ai][m][bj];
                    const f32x4 a = acc[ai][bj][m][0], b = acc[ai][bj][m][1];
                    u32x4 w;
                    w.x = cvt_pk_bf16(bflo(y.x) * sigmoidf_(a[0]), bfhi(y.x) * sigmoidf_(a[1]));
                    w.y = cvt_pk_bf16(bflo(y.y) * sigmoidf_(a[2]), bfhi(y.y) * sigmoidf_(a[3]));
                    w.z = cvt_pk_bf16(bflo(y.z) * sigmoidf_(b[0]), bfhi(y.z) * sigmoidf_(b[1]));
                    w.w = cvt_pk_bf16(bflo(y.w) * sigmoidf_(b[2]), bfhi(y.w) * sigmoidf_(b[3]));
                    *(u32x4*)(O + R * 2112 + c0 + bj * HALF) = w; } }
    }
};
constexpr int R_SAMPLE0 = 8192, R_REAL = 8704, R_ALL = 8736, R_PAD = 8960;
constexpr int LDP = 2112;
struct EpiOut {
    static constexpr bool PERM = false, AFTER_DRAIN = false;
    const float *irs0, *gmix, *gffn; bf16_t* XN; float* ss;
    __device__ __forceinline__ void operator()(const f32x4 (&acc)[2][2][4][2], const Unit& u, int wr, int wc, int fr, int fq, unsigned mask = 0xFFFFu) const {
        const int col0 = u.pn * BM + wc * 32 + 4 * fq;
        f32x4 gv[2][2], rm[2][2];
#pragma unroll
        for (int bj = 0; bj < 2; ++bj)
#pragma unroll
            for (int n = 0; n < 2; ++n) { gv[bj][n] = *(const f32x4*)(gffn + col0 + bj * HALF + n * 16); const f32x4 g = *(const f32x4*)(gmix + col0 + bj * HALF + n * 16); rm[bj][n] = (f32x4){1.0f / g[0], 1.0f / g[1], 1.0f / g[2], 1.0f / g[3]}; }
#pragma unroll
        for (int ai = 0; ai < 2; ++ai)
#pragma unroll
            for (int m = 0; m < 4; ++m) { if (!((mask >> (ai * 8 + m * 2)) & 3u)) continue; const int R = u.pm * BM + ai * HALF + wr * 64 + m * 16 + fr; float s = 0.f;
                if (R < R_ALL) {
                    const float ir = irs0[R];
                    bf16_t* xn = XN + (size_t)R * LDP;
#pragma unroll
                    for (int bj = 0; bj < 2; ++bj)
#pragma unroll
                        for (int n = 0; n < 2; ++n) { if (!((mask >> (ai * 8 + m * 2 + bj)) & 1u)) continue; const int c = col0 + bj * HALF + n * 16; const u32x2 xq = *(const u32x2*)(xn + c);
                            const f32x4 x1 = (f32x4){bflo(xq.x), bfhi(xq.x), bflo(xq.y), bfhi(xq.y)} * rm[bj][n] * ir + acc[ai][bj][m][n];
                            s += (x1[0] * x1[0] + x1[1] * x1[1]) + (x1[2] * x1[2] + x1[3] * x1[3]);
                            const f32x4 xg = x1 * gv[bj][n]; u32x2 w; w.x = cvt_pk_bf16(xg[0], xg[1]); w.y = cvt_pk_bf16(xg[2], xg[3]); *(u32x2*)(xn + c) = w; }
                }
                s += __shfl_xor(s, 16); s += __shfl_xor(s, 32);
                if (fq == 0 && R < R_ALL) atomicAdd(ss + R, s); }
    }
};
struct EpiDown {
    static constexpr bool PERM = false, AFTER_DRAIN = false;
    float* out; float* ss;
    __device__ __forceinline__ void operator()(const f32x4 (&acc)[2][2][4][2], const Unit& u, int wr, int wc, int fr, int fq, unsigned mask = 0xFFFFu) const {
        const int col0 = u.pn * BM + wc * 32 + 4 * fq;
#pragma unroll
        for (int ai = 0; ai < 2; ++ai)
#pragma unroll
            for (int m = 0; m < 4; ++m) { if (!((mask >> (ai * 8 + m * 2)) & 3u)) continue; const int R = u.pm * BM + ai * HALF + wr * 64 + m * 16 + fr; float s = 0.f; float* dst = out + (size_t)R * 2048;
#pragma unroll
                for (int bj = 0; bj < 2; ++bj)
#pragma unroll
                    for (int n = 0; n < 2; ++n) { if (!((mask >> (ai * 8 + m * 2 + bj)) & 1u)) continue; const int c = col0 + bj * HALF + n * 16; const f32x4 x2 = *(const f32x4*)(dst + c) + acc[ai][bj][m][n];
                        *(f32x4*)(dst + c) = x2; s += (x2[0] * x2[0] + x2[1] * x2[1]) + (x2[2] * x2[2] + x2[3] * x2[3]); }
                s += __shfl_xor(s, 16); s += __shfl_xor(s, 32);
                if (fq == 0) atomicAdd(ss + R, s); }
    }
};
constexpr int DFF = 5632;
struct EpiUp {
    static constexpr bool PERM = true, AFTER_DRAIN = false;
    const float* ss; const float *cw, *cb; bf16_t* H; float *gfix, *vfix, *gsrc; float *conv_p, *conv_s;
    __device__ __forceinline__ void operator()(const f32x4 (&acc)[2][2][4][2], const Unit& u, int wr, int wc, int fr, int fq) const {
        const int j0 = u.pn * HALF + wc * 32 + 8 * fq;
        const bool samp = u.pm >= 32;
        const bool is15 = fr == 15, ge14 = fr >= 14;
        float rs[2][4];
#pragma unroll
        for (int ai = 0; ai < 2; ++ai)
#pragma unroll
            for (int m = 0; m < 4; ++m) rs[ai][m] = ss[u.pm * BM + ai * HALF + wr * 64 + m * 16 + fr];
        f32x4 w0[2], w1[2], w2[2], b0[2];
#pragma unroll
        for (int h = 0; h < 2; ++h) { w0[h] = *(const f32x4*)(cw + j0 + 4 * h); w1[h] = *(const f32x4*)(cw + DFF + j0 + 4 * h); w2[h] = *(const f32x4*)(cw + 2 * DFF + j0 + 4 * h); b0[h] = *(const f32x4*)(cb + j0 + 4 * h); }
#pragma unroll
        for (int ai = 0; ai < 2; ++ai) {
            f32x4 pp[2] = {(f32x4){0.f, 0.f, 0.f, 0.f}, (f32x4){0.f, 0.f, 0.f, 0.f}};
#pragma unroll
            for (int m = 0; m < 4; ++m) {
                const int rt = ai * HALF + wr * 64 + m * 16 + fr; const int R = u.pm * BM + rt;
                const float rstd = rsqrtf(rs[ai][m] * (1.0f / 2048.0f) + 1e-6f);
                f32x4 g4[2], v4[2], h4[2];
#pragma unroll
                for (int h = 0; h < 2; ++h) {
                    g4[h] = acc[ai][0][m][h] * rstd; v4[h] = acc[ai][1][m][h] * rstd;
                    f32x4 t1, t2, p1, p2;
#pragma unroll
                    for (int e = 0; e < 4; ++e) { t1[e] = is15 ? pp[h][e] : g4[h][e]; t2[e] = ge14 ? pp[h][e] : g4[h][e];
                        p1[e] = __int_as_float(__builtin_amdgcn_update_dpp(0, __float_as_int(t1[e]), 0x121, 0xf, 0xf, false));
                        p2[e] = __int_as_float(__builtin_amdgcn_update_dpp(0, __float_as_int(t2[e]), 0x122, 0xf, 0xf, false)); }
                    const f32x4 gc = b0[h] + p2 * w0[h] + p1 * w1[h] + g4[h] * w2[h];
                    const f32x4 uu = gc * (gc * gc * 0.044715f + 1.0f);
                    const f32x4 ee = uu * (-2.0f * 0.7978845608028654f * 1.4426950408889634f);
                    f32x4 dn;
#pragma unroll
                    for (int e = 0; e < 4; ++e) dn[e] = __builtin_amdgcn_rcpf(1.0f + __builtin_amdgcn_exp2f(ee[e]));
                    h4[h] = gc * dn * v4[h];
                }
                u32x4 w; w.x = cvt_pk_bf16(h4[0][0], h4[0][1]); w.y = cvt_pk_bf16(h4[0][2], h4[0][3]); w.z = cvt_pk_bf16(h4[1][0], h4[1][1]); w.w = cvt_pk_bf16(h4[1][2], h4[1][3]);
                *(u32x4*)(H + (size_t)R * DFF + j0) = w;
                const float gg[8] = {g4[0][0], g4[0][1], g4[0][2], g4[0][3], g4[1][0], g4[1][1], g4[1][2], g4[1][3]};
                const float vv[8] = {v4[0][0], v4[0][1], v4[0][2], v4[0][3], v4[1][0], v4[1][1], v4[1][2], v4[1][3]};
                const f32x4 gA = {gg[0], gg[1], gg[2], gg[3]}, gB = {gg[4], gg[5], gg[6], gg[7]};
                if (fr < 2 && (m == 0 || samp)) {
                    const int id = samp ? 256 + (u.pm - 32) * 32 + (rt >> 4) * 2 + fr : u.pm * 8 + (rt >> 6) * 2 + fr;
                    float* gp = gfix + (size_t)id * DFF + j0; float* vp = vfix + (size_t)id * DFF + j0;
                    *(f32x4*)gp = gA; *(f32x4*)(gp + 4) = gB;
                    *(f32x4*)vp = (f32x4){vv[0], vv[1], vv[2], vv[3]}; *(f32x4*)(vp + 4) = (f32x4){vv[4], vv[5], vv[6], vv[7]};
                }
                if (fr >= 14) {
                    if (samp) { float* cp = conv_s + (size_t)(((R - R_SAMPLE0) >> 4) * 2 + (fr - 14)) * DFF + j0; *(f32x4*)cp = gA; *(f32x4*)(cp + 4) = gB; }
                    else if (m == 3) {
                        float* sp = gsrc + (size_t)(u.pm * 8 + (rt >> 6) * 2 + (fr - 14)) * DFF + j0; *(f32x4*)sp = gA; *(f32x4*)(sp + 4) = gB;
                        if ((R & 4095) >= 4094) { float* cp = conv_p + (size_t)((R >> 12) * 2 + ((R & 4095) - 4094)) * DFF + j0; *(f32x4*)cp = gA; *(f32x4*)(cp + 4) = gB; }
                    }
                }
                pp[0] = g4[0]; pp[1] = g4[1];
            }
        }
    }
};

template <class Epi, class Sched, bool ALIGN_EPI = false, bool SP2 = false, bool STREAMK = false>
__device__ __forceinline__ void gemm_phase(PG8_LAS unsigned char* lds, const Gemm g, const Sched& S, const Epi& E, const SKBuf sk = SKBuf{nullptr, nullptr, 0}) {
    int tid_ = threadIdx.x; asm volatile("" : "+v"(tid_));
    const int tid = tid_, wid = __builtin_amdgcn_readfirstlane(tid >> 6), lane = tid & 63, wr = wid >> 2, wc = wid & 3, fr = lane & 15, fq = lane >> 4;
    unsigned voffA[2], voffB[2];
#pragma unroll
    for (int i = 0; i < 2; ++i) { int R, C; stage_rc(tid * 16 + i * 8192, R, C); const int Rb = Epi::PERM ? ((R & ~31) + perm32(R & 31)) : R;
        voffA[i] = (unsigned)(R * g.lda + C) * 2u; voffB[i] = (unsigned)(Rb * g.ldb + C) * 2u; }
    const size_t kstep = (size_t)(BK * 2);
    const size_t hstepA = (size_t)HALF * g.lda * 2, hstepB = (size_t)HALF * g.ldb * 2;
    const unsigned ldsw = (unsigned)wid * 1024u;
    const int aoff = lds_byte(wr * 64 + fr, fq * 8), boff = lds_byte(wc * 32 + fr, fq * 8);
#define PG8_SA(b, h) (((b) * 2 + (h)) * HTB)
#define PG8_SB(b, h) ((4 + (b) * 2 + (h)) * HTB)
#define PG8_STAGE(bufoff, gbase, voff) do { _Pragma("unroll") for (int _i = 0; _i < 2; ++_i) \
        __builtin_amdgcn_global_load_lds((const unsigned*)((const char*)(gbase) + (voff)[_i]), (PG8_LAS unsigned*)(lds + (bufoff) + ldsw + _i * 8192), 16, 0, 0); } while (0)
#define PG8_LDA(dst, b, h) do { _Pragma("unroll") for (int m = 0; m < 4; ++m) _Pragma("unroll") for (int k = 0; k < 2; ++k) dst[m][k] = *(const PG8_LAS bf16x8*)(lds + PG8_SA(b, h) + aoff + m * 2048 + k * 1024); } while (0)
#define PG8_LDB(dst, b, h) do { _Pragma("unroll") for (int n = 0; n < 2; ++n) _Pragma("unroll") for (int k = 0; k < 2; ++k) dst[n][k] = *(const PG8_LAS bf16x8*)(lds + PG8_SB(b, h) + boff + n * 2048 + k * 1024); } while (0)
#define PG8_MMA(ai, bj, At, Bt) do { __builtin_amdgcn_s_setprio(1); _Pragma("unroll") for (int m = 0; m < 4; ++m) _Pragma("unroll") for (int n = 0; n < 2; ++n) _Pragma("unroll") for (int k = 0; k < 2; ++k) \
        acc[ai][bj][m][n] = __builtin_amdgcn_mfma_f32_16x16x32_bf16(Bt[n][k], At[m][k], acc[ai][bj][m][n], 0, 0, 0); __builtin_amdgcn_s_setprio(0); } while (0)
#define PG8_WAIT_V(n) asm volatile("s_waitcnt vmcnt(" #n ")" ::: "memory")
#define PG8_WAIT_L(n) asm volatile("s_waitcnt lgkmcnt(" #n ")" ::: "memory")
#define PG8_BAR __builtin_amdgcn_s_barrier()
#define PG8_SCHED __builtin_amdgcn_sched_barrier(0)
    Unit cur, nxt; int ui = 0;
    if (!S.next(0, cur)) return;
    f32x4 acc[2][2][4][2];
#pragma unroll
    for (int a = 0; a < 2; ++a)
#pragma unroll
        for (int b = 0; b < 2; ++b)
#pragma unroll
            for (int m = 0; m < 4; ++m)
#pragma unroll
                for (int n = 0; n < 2; ++n) acc[a][b][m][n] = (f32x4){0.f, 0.f, 0.f, 0.f};
    bf16x8 At[4][2], B0[2][2], B1[2][2];
    const char* cA = g.abase(cur); const char* cB = g.bbase(cur);
    S.a_ready(cur);
    if constexpr (SP2) {
        PG8_STAGE(PG8_SB(0, 0), cB, voffB); PG8_STAGE(PG8_SB(0, 1), cB + hstepB, voffB); PG8_STAGE(PG8_SA(0, 0), cA, voffA); PG8_STAGE(PG8_SA(0, 1), cA + hstepA, voffA);
        if (wr == 1) PG8_BAR;
        PG8_WAIT_V(2); PG8_BAR;
        PG8_STAGE(PG8_SB(1, 0), cB + kstep, voffB); PG8_STAGE(PG8_SA(1, 0), cA + kstep, voffA); PG8_STAGE(PG8_SB(1, 1), cB + hstepB + kstep, voffB);
        PG8_WAIT_V(6); PG8_BAR;
    } else {
        PG8_STAGE(PG8_SB(0, 0), cB, voffB); PG8_STAGE(PG8_SA(0, 0), cA, voffA); PG8_STAGE(PG8_SB(0, 1), cB + hstepB, voffB); PG8_STAGE(PG8_SA(0, 1), cA + hstepA, voffA);
        if (wr == 1) PG8_BAR;
        PG8_WAIT_V(4); PG8_BAR;
        PG8_STAGE(PG8_SB(1, 0), cB + kstep, voffB); PG8_STAGE(PG8_SA(1, 0), cA + kstep, voffA); PG8_STAGE(PG8_SB(1, 1), cB + hstepB + kstep, voffB);
        PG8_WAIT_V(6); PG8_BAR;
    }
    for (;;) {
        const bool has_next = S.next(ui + 1, nxt);
        const char* nA = has_next ? g.abase(nxt) : cA; const char* nB = has_next ? g.bbase(nxt) : cB;
        const int nt = cur.nt;
        for (int t = 0; t < nt; t += 2) {
            const bool last = (t == nt - 2);
            const char* a1 = cA + (size_t)(t + 1) * kstep;
            const char* a2 = last ? nA : cA + (size_t)(t + 2) * kstep; const char* b2 = last ? nB : cB + (size_t)(t + 2) * kstep;
            const char* a3 = a2 + kstep; const char* b3 = b2 + kstep;
            if (last && has_next) S.a_ready(nxt);
            if constexpr (SP2) {
            PG8_LDB(B0, 0, 0); PG8_LDB(B1, 0, 1); PG8_SCHED; PG8_LDA(At, 0, 0); PG8_STAGE(PG8_SA(1, 1), a1 + hstepA, voffA);
            PG8_WAIT_V(8); PG8_WAIT_L(0); PG8_BAR; PG8_MMA(0, 0, At, B0); PG8_MMA(0, 1, At, B1); PG8_BAR; PG8_SCHED;
            PG8_LDA(At, 0, 1); PG8_STAGE(PG8_SB(0, 0), b2, voffB); PG8_STAGE(PG8_SB(0, 1), b2 + hstepB, voffB); PG8_STAGE(PG8_SA(0, 0), a2, voffA);
            PG8_WAIT_V(8); PG8_WAIT_L(0); PG8_BAR; PG8_MMA(1, 0, At, B0); PG8_MMA(1, 1, At, B1); PG8_BAR; PG8_SCHED;
            PG8_LDB(B0, 1, 0); PG8_LDB(B1, 1, 1); PG8_SCHED; PG8_LDA(At, 1, 0); PG8_STAGE(PG8_SA(0, 1), a2 + hstepA, voffA);
            PG8_WAIT_V(8); PG8_WAIT_L(0); PG8_BAR; PG8_MMA(0, 0, At, B0); PG8_MMA(0, 1, At, B1); PG8_BAR; PG8_SCHED;
            PG8_LDA(At, 1, 1); PG8_STAGE(PG8_SB(1, 0), b3, voffB); PG8_STAGE(PG8_SB(1, 1), b3 + hstepB, voffB); PG8_STAGE(PG8_SA(1, 0), a3, voffA);
            PG8_WAIT_V(8); PG8_WAIT_L(0); PG8_BAR; PG8_MMA(1, 0, At, B0); PG8_MMA(1, 1, At, B1); PG8_BAR; PG8_SCHED;
            } else {
            PG8_LDB(B0, 0, 0); PG8_SCHED; PG8_LDA(At, 0, 0); PG8_STAGE(PG8_SA(1, 1), a1 + hstepA, voffA);
            PG8_WAIT_L(8); PG8_BAR; PG8_WAIT_L(0); PG8_MMA(0, 0, At, B0); PG8_BAR; PG8_SCHED;
            PG8_LDB(B1, 0, 1); PG8_STAGE(PG8_SB(0, 0), b2, voffB);
            PG8_BAR; PG8_WAIT_L(0); PG8_MMA(0, 1, At, B1); PG8_BAR;
            PG8_LDA(At, 0, 1); PG8_STAGE(PG8_SA(0, 0), a2, voffA);
            PG8_BAR; PG8_WAIT_L(0); PG8_MMA(1, 0, At, B0); PG8_BAR; PG8_SCHED;
            PG8_STAGE(PG8_SB(0, 1), b2 + hstepB, voffB);
            PG8_WAIT_V(6); PG8_BAR; PG8_MMA(1, 1, At, B1); PG8_BAR;
            PG8_LDB(B0, 1, 0); PG8_SCHED; PG8_LDA(At, 1, 0); PG8_STAGE(PG8_SA(0, 1), a2 + hstepA, voffA);
            PG8_WAIT_L(8); PG8_BAR; PG8_WAIT_L(0); PG8_MMA(0, 0, At, B0); PG8_BAR; PG8_SCHED;
            PG8_LDB(B1, 1, 1); PG8_STAGE(PG8_SB(1, 0), b3, voffB);
            PG8_BAR; PG8_WAIT_L(0); PG8_MMA(0, 1, At, B1); PG8_BAR;
            PG8_LDA(At, 1, 1); PG8_STAGE(PG8_SA(1, 0), a3, voffA);
            PG8_BAR; PG8_WAIT_L(0); PG8_MMA(1, 0, At, B0); PG8_BAR; PG8_SCHED;
            PG8_STAGE(PG8_SB(1, 1), b3 + hstepB, voffB);
            PG8_WAIT_V(6); PG8_BAR; PG8_MMA(1, 1, At, B1); PG8_BAR;
            }
        }
        if constexpr (ALIGN_EPI) { if (wr == 0) PG8_BAR; }
        if constexpr (STREAMK) {
            if (cur.kind == 1) {
                __attribute__((address_space(1))) unsigned* p = (__attribute__((address_space(1))) unsigned*)sk.slots + (size_t)sk.v * 32768 + (size_t)tid * 4;
#pragma unroll
                for (int a = 0; a < 2; ++a)
#pragma unroll
                    for (int b = 0; b < 2; ++b)
#pragma unroll
                        for (int m = 0; m < 4; ++m) { const f32x4 v0 = acc[a][b][m][0], v1 = acc[a][b][m][1];
                            u32x4 w; w.x = cvt_pk_bf16(v0[0], v0[1]); w.y = cvt_pk_bf16(v0[2], v0[3]); w.z = cvt_pk_bf16(v1[0], v1[1]); w.w = cvt_pk_bf16(v1[2], v1[3]);
                            *(__attribute__((address_space(1))) u32x4*)p = w; p += 2048; asm volatile("" : "+v"(p)); }
            } else {
                E(acc, cur, wr, wc, fr, fq);
            }
        } else
        if constexpr (!Epi::AFTER_DRAIN) { E(acc, cur, wr, wc, fr, fq); S.done(cur); }
        if (!has_next) break;
#pragma unroll
        for (int a = 0; a < 2; ++a)
#pragma unroll
            for (int b = 0; b < 2; ++b)
#pragma unroll
                for (int m = 0; m < 4; ++m)
#pragma unroll
                    for (int n = 0; n < 2; ++n) acc[a][b][m][n] = (f32x4){0.f, 0.f, 0.f, 0.f};
        cur = nxt; cA = nA; cB = nB; ++ui;
        if constexpr (ALIGN_EPI) { if (wr == 1) PG8_BAR; }
    }
    PG8_WAIT_V(0);
    if constexpr (!ALIGN_EPI) { if (wr == 0) PG8_BAR; }
    PG8_BAR;
    if constexpr (Epi::AFTER_DRAIN) { E.fused(acc, cur, wr, wc, fr, fq, lds, wid, lane); S.done(cur); }
#undef PG8_SA
#undef PG8_SB
#undef PG8_STAGE
#undef PG8_LDA
#undef PG8_LDB
#undef PG8_MMA
#undef PG8_WAIT_V
#undef PG8_WAIT_L
#undef PG8_BAR
#undef PG8_SCHED
}

template <class Epi, class Sched>
__device__ __forceinline__ void gemm_reduce(const Sched& S, const Epi& E, const SKBuf sk) {
    int tid_ = threadIdx.x; asm volatile("" : "+v"(tid_));
    const int tid = tid_, wid = __builtin_amdgcn_readfirstlane(tid >> 6), lane = tid & 63, wr = wid >> 2, wc = wid & 3, fr = lane & 15, fq = lane >> 4;
    Unit ru; unsigned mask; int base;
    if (!S.reducer(ru, mask, base)) return;
    const unsigned* sb = (const unsigned*)sk.slots + (size_t)base * 32768 + (size_t)tid * 4;
    f32x4 racc[2][2][4][2];
#pragma unroll
    for (int a = 0; a < 2; ++a)
#pragma unroll
        for (int b = 0; b < 2; ++b)
#pragma unroll
            for (int m = 0; m < 4; ++m)
#pragma unroll
                for (int n = 0; n < 2; ++n) racc[a][b][m][n] = (f32x4){0.f, 0.f, 0.f, 0.f};
#pragma unroll
    for (int a = 0; a < 2; ++a)
#pragma unroll
        for (int m = 0; m < 4; ++m)
#pragma unroll
            for (int b = 0; b < 2; ++b)
                if ((mask >> (a * 8 + m * 2 + b)) & 1u) {
                    f32x4 r0 = (f32x4){0.f, 0.f, 0.f, 0.f}, r1 = r0; const unsigned* p = sb + (size_t)(((a * 2 + b) * 4 + m) * 2048);
                    for (int s8 = 0; s8 < S.S; s8 += 8) {
                        u32x4 t[8];
#pragma unroll
                        for (int k = 0; k < 8; ++k) t[k] = *(const u32x4*)(p + (size_t)k * 32768);
#pragma unroll
                        for (int k = 0; k < 8; ++k) { r0 += (f32x4){bflo(t[k].x), bfhi(t[k].x), bflo(t[k].y), bfhi(t[k].y)}; r1 += (f32x4){bflo(t[k].z), bfhi(t[k].z), bflo(t[k].w), bfhi(t[k].w)}; }
                        p += 8 * 32768; }
                    racc[a][b][m][0] = r0; racc[a][b][m][1] = r1;
                }
    E(racc, ru, wr, wc, fr, fq, mask);
}
}

#define GAS __attribute__((address_space(1)))
#define LAS __attribute__((address_space(3)))
typedef unsigned short bf16;
typedef unsigned v4u __attribute__((ext_vector_type(4)));
typedef unsigned v2u __attribute__((ext_vector_type(2)));
typedef float f32x4 __attribute__((ext_vector_type(4)));
typedef float f32x16 __attribute__((ext_vector_type(16)));
typedef short bf16x8 __attribute__((ext_vector_type(8)));
constexpr int NWAVES = 8, NTHREADS = 512;
constexpr int DM = 2048, SEQ = 4096, NMETA = 16, DECB = 32, DECL = 16;
constexpr int NG = 64, NS = 64, DFF = 5632;
constexpr int R_SAMPLE0 = 8192, R_REAL = 8704, R_ALL = 8736, R_PAD = 8960;
constexpr float RMS_EPS = 1e-6f;
constexpr int NSEG = 16;
constexpr size_t O_Y = 0, O_SRE_P = 17825792, O_SIM_P = 17833984, O_POOL_P = 17842176, O_CONV_P = 17872896,
                 O_SRE_S = 17895424, O_SIM_S = 18026496, O_POOL_S = 18157568, O_CONV_S = 18649088;
constexpr size_t MiB = 1u << 20;
constexpr int LDP = 2112;
constexpr size_t WS_WIN = 0, WS_WGLU = 9 * MiB, WS_WPOOL = 11 * MiB, WS_WOUT = 12 * MiB, WS_WUP = 21 * MiB, WS_WDOWN = 67 * MiB;
constexpr size_t WS_XN = 89 * MiB, WS_U = 126 * MiB, WS_YPRE = 161 * MiB, WS_MB = 179 * MiB, WS_YCAT = 197 * MiB;
constexpr size_t WS_H = 126 * MiB;
constexpr size_t WS_SMALL = 234 * MiB;
constexpr size_t WS_XMETA = WS_SMALL, WS_SS1 = WS_XMETA + 32 * 2048 * 4, WS_SS2 = WS_SS1 + 36864, WS_LBAR = WS_SS2 + 36864, WS_PW = WS_LBAR + 32768,
                 WS_BB = WS_PW + 32768, WS_CC = WS_BB + 262144, WS_EST = WS_CC + 262144, WS_GMETA = WS_EST + 2 * 64 * 16 * 64 * 8;
constexpr size_t WS_GFIX = 238 * MiB, WS_VFIX = 245 * MiB, WS_GSRC = 252 * MiB, WS_SLOTS = 258 * MiB, WS_FLAGS = 322 * MiB, WS_BAR = 322 * MiB + 65536, WS_FA = 323 * MiB, WS_FB = 0, WS_END = 351 * MiB;
static_assert(WS_GMETA + 4 * DFF * 4 <= WS_GFIX && WS_H + (size_t)R_REAL * DFF * 2 <= WS_YCAT + (size_t)R_PAD * LDP * 2 && WS_YCAT + (size_t)R_PAD * LDP * 2 <= WS_SMALL && 320 * (size_t)DFF * 4 <= 7 * MiB
              && WS_XN + (size_t)R_PAD * LDP * 2 <= WS_U && WS_WUP + (size_t)11264 * LDP * 2 <= WS_WDOWN && WS_WIN + (size_t)2048 * LDP * 2 <= WS_WGLU && WS_WOUT + (size_t)2048 * LDP * 2 <= WS_WUP, "ws map");
constexpr int F_SPLIT = 7168;
constexpr int LDS_BYTES = 147456;
constexpr int S5_WLDS = 32 * 528;

__device__ __forceinline__ unsigned f2bf(float f) { unsigned u = __builtin_bit_cast(unsigned, f); return (u + 0x7fffu + ((u >> 16) & 1u)) >> 16; }
__device__ __forceinline__ unsigned pk2(float lo, float hi) { return f2bf(lo) | (f2bf(hi) << 16); }
__device__ __forceinline__ float blo(unsigned w) { return __uint_as_float(w << 16); }
__device__ __forceinline__ float bhi(unsigned w) { return __uint_as_float(w & 0xffff0000u); }
#define LDS_WAIT() asm volatile("s_waitcnt lgkmcnt(0)" ::: "memory")

#define XB_TMO      128
#define XB_XCNT(j)  (256  + 64 * (j))
#define XB_XSUB(j)  (1280 + 64 * (j))
#define XB_XGEN(j)  (2304 + 64 * (j))
#define XB_TOP      3328
#define XB_TOPGEN   3392
#define XCD_BAR_WORDS 3456
#define XB_SPIN_CAP (1u << 18)

__device__ __forceinline__ unsigned xb_ld(unsigned* p)              { return __hip_atomic_load(p, __ATOMIC_RELAXED, __HIP_MEMORY_SCOPE_AGENT); }
__device__ __forceinline__ unsigned xb_add(unsigned* p, unsigned v) { return __hip_atomic_fetch_add(p, v, __ATOMIC_RELAXED, __HIP_MEMORY_SCOPE_AGENT); }
__device__ __forceinline__ unsigned xb_xcc_id() { return (unsigned)__builtin_amdgcn_s_getreg((3 << 11) | 20) & 0xFu; }
#define XB_SPIN(cond, bar) do { unsigned _sp = 0; while (cond) { __builtin_amdgcn_s_sleep(1); \
    if ((++_sp & 255u) == 0u) { if (xb_ld(&(bar)[XB_TMO])) break; if (_sp > XB_SPIN_CAP) { atomicAdd(&(bar)[XB_TMO], 1u); break; } } } } while (0)

struct XcdBarrier {
    unsigned* bar; unsigned x;
    volatile LAS unsigned* st;
};

__device__ __forceinline__ XcdBarrier xcd_barrier_post(unsigned* bar, volatile LAS unsigned* st) {
    XcdBarrier b; b.bar = bar; b.x = xb_xcc_id(); b.st = st;
    if (threadIdx.x == 0) (void)xb_add(&bar[XB_XCNT(b.x)], 1u);
    return b;
}
__device__ __forceinline__ void xcd_barrier_complete(unsigned* bar, unsigned x, unsigned& nloc, unsigned& nx) {
    const unsigned G = gridDim.x * gridDim.y * gridDim.z;
    unsigned sum, cnt, mine, sp = 0u;
    for (;;) {
        sum = 0u; cnt = 0u; mine = 0u;
#pragma unroll
        for (unsigned j = 0; j < 16; ++j) { const unsigned c = xb_ld(&bar[XB_XCNT(j)]); sum += c; cnt += (c > 0u) ? 1u : 0u; mine = (j == x) ? c : mine; }
        if (sum == G) break;
        __builtin_amdgcn_s_sleep(1);
        if ((++sp & 255u) == 0u) { if (xb_ld(&bar[XB_TMO])) break; if (sp > XB_SPIN_CAP) { atomicAdd(&bar[XB_TMO], 1u); break; } }
    }
    nloc = mine > 0u ? mine : 1u; nx = cnt > 0u ? cnt : 1u;
}

__device__ __forceinline__ void xcd_barrier(const XcdBarrier& b) {
    asm volatile("s_waitcnt vmcnt(0)" ::: "memory");
    __syncthreads();
    if (threadIdx.x == 0) {
        unsigned* bar = b.bar;
        __builtin_amdgcn_s_waitcnt(0);
        unsigned nloc = b.st[0], nx = b.st[1];
        if (nloc == 0u) { xcd_barrier_complete(bar, b.x, nloc, nx); b.st[0] = nloc; b.st[1] = nx; }
        const unsigned old = xb_add(&bar[XB_XSUB(b.x)], 1u);
        const unsigned gen = old / nloc;
        if (old + 1u == (gen + 1u) * nloc) {
            __builtin_amdgcn_fence(__ATOMIC_RELEASE, "agent");
            asm volatile("s_waitcnt vmcnt(0)" ::: "memory");
            const unsigned og = xb_add(&bar[XB_TOP], 1u);
            const unsigned tg = og / nx;
            if (og + 1u == (tg + 1u) * nx) xb_add(&bar[XB_TOPGEN], 1u);
            else XB_SPIN(xb_ld(&bar[XB_TOPGEN]) == tg, bar);
            __builtin_amdgcn_fence(__ATOMIC_ACQUIRE, "agent");
            xb_add(&bar[XB_XGEN(b.x)], 1u);
            asm volatile("s_waitcnt vmcnt(0)" ::: "memory");
        } else {
            XB_SPIN(xb_ld(&bar[XB_XGEN(b.x)]) == gen, bar);
            __builtin_amdgcn_fence(__ATOMIC_ACQUIRE, "agent");
            asm volatile("s_waitcnt vmcnt(0)" ::: "memory");
        }
    }
    __syncthreads();
}

struct Frame {
    LAS unsigned char* lds; int wave, vcu, G;
    float* out; unsigned char* ws;
};
constexpr int BARST_OFF = 143360 + 256;
constexpr int TAB_OFF = 143360;
__device__ __forceinline__ const float* inp(const Frame& F, int i) {
    const LAS unsigned* t = (const LAS unsigned*)(F.lds + TAB_OFF) + 2 * i; const unsigned lo = __builtin_amdgcn_readfirstlane(t[0]), hi = __builtin_amdgcn_readfirstlane(t[1]);
    return (const float*)(const GAS float*)(((unsigned long long)hi << 32) | lo);
}
__device__ __forceinline__ int ltid() { int t = threadIdx.x; asm volatile("" : "+v"(t)); return t; }
__device__ __forceinline__ float wave_sum(float v) {
#pragma unroll
    for (int o = 1; o < 64; o <<= 1) v += __shfl_xor(v, o);
    return v;
}
struct TItem { const float* src; bf16* dst; int K, N; };
__device__ __forceinline__ void p0_item_load(const TItem& t, f32x4 (&buf)[16], int lane) {
    const float* p = t.src + (size_t)(lane >> 4) * t.N + 4 * (lane & 15);
#pragma unroll
    for (int i = 0; i < 16; ++i) buf[i] = __builtin_nontemporal_load((const f32x4*)(p + (size_t)(4 * i) * t.N));
}
__device__ __forceinline__ void p0_item_to_lds(const f32x4 (&buf)[16], LAS float* scr, int lane) {
    LAS float* q = scr + (lane >> 4) * 65 + 4 * (lane & 15);
#pragma unroll
    for (int i = 0; i < 16; ++i) { q[(4 * i) * 65 + 0] = buf[i][0]; q[(4 * i) * 65 + 1] = buf[i][1]; q[(4 * i) * 65 + 2] = buf[i][2]; q[(4 * i) * 65 + 3] = buf[i][3]; }
}
__device__ __forceinline__ void p0_item_store(const TItem& t, LAS float* scr, int lane) {
    const int c = lane & 7;
#pragma unroll
    for (int j = 0; j < 8; ++j) { const int n = (lane >> 3) + 8 * j; const LAS float* sp = scr + (8 * c) * 65 + n;
        v4u o; o.x = pk2(sp[0 * 65], sp[1 * 65]); o.y = pk2(sp[2 * 65], sp[3 * 65]); o.z = pk2(sp[4 * 65], sp[5 * 65]); o.w = pk2(sp[6 * 65], sp[7 * 65]);
        *(v4u*)(t.dst + (size_t)n * t.K + 8 * c) = o; }
}
__device__ __forceinline__ const float* xrow(const Frame& F, int R) {
    return R < R_SAMPLE0 ? inp(F, 0) + (size_t)R * DM : (R < R_REAL ? inp(F, 1) + (size_t)(R - R_SAMPLE0) * DM : inp(F, 6) + (size_t)((R - R_REAL) & 15) * DM);
}

constexpr int I_IN = 32 * 32, I_GLU = 16 * 16, I_POOL = 4 * 4 * 4, I_OUT = 32 * 32, I_UP = 32 * 176, I_DOWN = 88 * 32;
constexpr int I_EARLY = I_IN + I_GLU + I_POOL + I_OUT + I_UP;
__device__ __forceinline__ void p0_decode(const Frame& F, int it, TItem& t) {
    unsigned char* ws = F.ws; int r = it;
    if (r < I_IN) { const int kb = r / 32, nb = r % 32; t.K = LDP; t.N = 2048; t.src = inp(F, 8) + (size_t)(64 * kb) * 2048 + 64 * nb; t.dst = (bf16*)(ws + WS_WIN) + (size_t)(64 * nb) * LDP + 64 * kb; return; } r -= I_IN;
    if (r < I_GLU) { const int kb = r / 16, nb = r % 16; t.K = 1024; t.N = 1024; t.src = inp(F, 17) + (size_t)(64 * kb) * 1024 + 64 * nb; t.dst = (bf16*)(ws + WS_WGLU) + (size_t)(64 * nb) * 1024 + 64 * kb; return; } r -= I_GLU;
    if (r < I_POOL) { const int g = r / 16, q = r % 16, kb = q / 4, nb = q % 4; t.K = 256; t.N = 256; t.src = inp(F, 18) + (size_t)g * 65536 + (size_t)(64 * kb) * 256 + 64 * nb; t.dst = (bf16*)(ws + WS_WPOOL) + (size_t)g * 65536 + (size_t)(64 * nb) * 256 + 64 * kb; return; } r -= I_POOL;
    if (r < I_OUT) { const int kb = r / 32, nb = r % 32; t.K = LDP; t.N = 2048; t.src = inp(F, 20) + (size_t)(64 * kb) * 2048 + 64 * nb; t.dst = (bf16*)(ws + WS_WOUT) + (size_t)(64 * nb) * LDP + 64 * kb; return; } r -= I_OUT;
    if (r < I_UP) { const int kb = r / 176, nb = r % 176, n0 = 64 * nb; const int drow = n0 < DFF ? (n0 / 128) * 256 + (n0 % 128) : ((n0 - DFF) / 128) * 256 + 128 + ((n0 - DFF) % 128);
        t.K = LDP; t.N = 2 * DFF; t.src = inp(F, 22) + (size_t)(64 * kb) * (2 * DFF) + n0; t.dst = (bf16*)(ws + WS_WUP) + (size_t)drow * LDP + 64 * kb; return; } r -= I_UP;
    { const int kb = r / 32, nb = r % 32; t.K = DFF; t.N = 2048; t.src = inp(F, 25) + (size_t)(64 * kb) * 2048 + 64 * nb; t.dst = (bf16*)(ws + WS_WDOWN) + (size_t)(64 * nb) * DFF + 64 * kb; }
}
__device__ __forceinline__ void p0_convert(const Frame& F, int lo, int hi, int w, int nw, int lane) {
    LAS float* scr = (LAS float*)(F.lds + F.wave * 16640);
    f32x4 bufA[16], bufB[16]; TItem ta, tb; int it = lo + w;
    if (it < hi) { p0_decode(F, it, ta); p0_item_load(ta, bufA, lane); }
    while (it < hi) {
        p0_item_to_lds(bufA, scr, lane);
        if (it + nw < hi) { p0_decode(F, it + nw, tb); p0_item_load(tb, bufB, lane); }
        LDS_WAIT(); asm volatile("" ::: "memory");
        p0_item_store(ta, scr, lane);
        LDS_WAIT(); asm volatile("" ::: "memory");
        it += nw; if (it >= hi) break;
        p0_item_to_lds(bufB, scr, lane);
        if (it + nw < hi) { p0_decode(F, it + nw, ta); p0_item_load(ta, bufA, lane); }
        LDS_WAIT(); asm volatile("" ::: "memory");
        p0_item_store(tb, scr, lane);
        LDS_WAIT(); asm volatile("" ::: "memory");
        it += nw;
    }
}
__device__ __forceinline__ void p0_prologue(Frame& F) {
    unsigned char* ws = F.ws; const int tid = ltid(), lane = tid & 63;
    const int gw = F.vcu * NWAVES + F.wave, NGW = F.G * NWAVES;
    p0_convert(F, 0, F.G == 256 ? I_EARLY : I_EARLY + I_DOWN, gw, NGW, lane);
    const float* gm = inp(F, 7);
    {
        f32x4 v[8], vn[8], v2[8]; int R = gw;
        auto fetch = [&](int Rr, f32x4 (&d)[8]) { if (Rr < R_ALL) { const f32x4* xr = (const f32x4*)xrow(F, Rr) + lane;
#pragma unroll
            for (int j = 0; j < 8; ++j) d[j] = __builtin_nontemporal_load(xr + 64 * j); } };
        fetch(R, v); fetch(R + NGW, vn);
        while (R < R_ALL) {
            fetch(R + 2 * NGW, v2);
            float s = 0.f;
#pragma unroll
            for (int j = 0; j < 8; ++j) s += (v[j].x * v[j].x + v[j].y * v[j].y) + (v[j].z * v[j].z + v[j].w * v[j].w);
            const float ms = wave_sum(s) * (1.0f / DM) + RMS_EPS; const float rstd = rsqrtf(ms);
            if (lane == 0) ((float*)(ws + WS_SS2))[R] = sqrtf(ms);
            unsigned long long* o8 = (unsigned long long*)((bf16*)(ws + WS_XN) + (size_t)R * LDP) + lane;
#pragma unroll
            for (int j = 0; j < 8; ++j) { const f32x4 g = ((const f32x4*)gm)[64 * j + lane];
                o8[64 * j] = (unsigned long long)pk2(v[j].x * rstd * g.x, v[j].y * rstd * g.y) | ((unsigned long long)pk2(v[j].z * rstd * g.z, v[j].w * rstd * g.w) << 32); }
#pragma unroll
            for (int j = 0; j < 8; ++j) { v[j] = vn[j]; vn[j] = v2[j]; }
            R += NGW;
        }
    }
    const int gt = F.vcu * NTHREADS + tid, NGT = F.G * NTHREADS;
    for (int i = gt; i < 9216; i += NGT) ((float*)(ws + WS_SS1))[i] = 0.f;
    for (int i = gt; i < 4 * 256; i += NGT) __hip_atomic_store((unsigned*)(ws + WS_FLAGS) + i, 0u, __ATOMIC_RELAXED, __HIP_MEMORY_SCOPE_SYSTEM);
    for (int i2 = gt; i2 < NG * NS * 16; i2 += NGT) {
        const int i = i2 >> 4, n = i2 & 15, g = i >> 6, p = i & 63;
        const float lr = inp(F, 9)[i], li = inp(F, 10)[i], dt = expf(inp(F, 11)[g]);
        const float er = expf(lr * dt); const float sn = sinf(li * dt), cs = cosf(li * dt);
        const float br = er * cs, bi = er * sn;
        if (n == 0) {
            ((float2*)(ws + WS_LBAR))[i] = make_float2(br, bi);
            float pr = br, pi = bi;
#pragma unroll
            for (int k = 0; k < 8; ++k) { const float nr = pr * pr - pi * pi, ni = 2.f * pr * pi; pr = nr; pi = ni; }
            ((float2*)(ws + WS_PW))[i] = make_float2(pr, pi);
        }
        const float nr = br - 1.f, ni = bi, den = 1.f / (lr * lr + li * li);
        const float cr = (nr * lr + ni * li) * den, ci = (ni * lr - nr * li) * den;
        bf16* bb = (bf16*)(ws + WS_BB) + (size_t)g * 128 * 16;
        const float b_r = inp(F, 12)[(size_t)i * 16 + n], b_i = inp(F, 13)[(size_t)i * 16 + n];
        bb[p * 16 + n] = (bf16)f2bf(cr * b_r - ci * b_i); bb[(64 + p) * 16 + n] = (bf16)f2bf(cr * b_i + ci * b_r);
    }
    for (int i = gt; i < NG * 16 * 128; i += NGT) {
        const int k = i & 127, gn = i >> 7;
        ((bf16*)(ws + WS_CC))[i] = (bf16)f2bf(k < 64 ? inp(F, 14)[(size_t)gn * 64 + k] : -inp(F, 15)[(size_t)gn * 64 + (k - 64)]);
    }
}

struct S5Ctx { bf16x8 bb[4]; bf16x8 cc[8]; float lbr, lbi; int g; f32x4 dsk[2]; };
struct S5In { bf16x8 a; v2u us[2]; };
__device__ __forceinline__ void s5_load_ctx(S5Ctx& c, const Frame& F, int g, int lane) {
    const unsigned char* ws = F.ws; c.g = g;
    const bf16* bb = (const bf16*)(ws + WS_BB) + (size_t)g * 2048; const bf16* cc = (const bf16*)(ws + WS_CC) + (size_t)g * 2048;
#pragma unroll
    for (int cb = 0; cb < 4; ++cb) c.bb[cb] = *(const bf16x8*)(bb + (32 * cb + (lane & 31)) * 16 + 8 * (lane >> 5));
#pragma unroll
    for (int kb = 0; kb < 8; ++kb) { bf16x8 z = {0, 0, 0, 0, 0, 0, 0, 0}; if ((lane & 31) < 16) z = *(const bf16x8*)(cc + (lane & 31) * 128 + 16 * kb + 8 * (lane >> 5)); c.cc[kb] = z; }
    const float2 lb = ((const float2*)(ws + WS_LBAR))[g * 64 + lane]; c.lbr = lb.x; c.lbi = lb.y;
    c.dsk[0] = *(const f32x4*)(inp(F, 16) + g * 16 + 4 * (lane >> 5)); c.dsk[1] = *(const f32x4*)(inp(F, 16) + g * 16 + 8 + 4 * (lane >> 5));
}
template <int NV, bool FULL>
__device__ __forceinline__ void s5_fetch(S5In& in, const Frame& F, int g, int row0, int lane) {
    const bf16* U = (const bf16*)(F.ws + WS_U); const int ti = lane & 31, kh = lane >> 5;
    in.a = (bf16x8){0, 0, 0, 0, 0, 0, 0, 0}; in.us[0] = (v2u){0u, 0u}; in.us[1] = (v2u){0u, 0u};
    if (ti < NV) { const bf16* ur = U + (size_t)(row0 + ti) * 2048 + g * 16; in.a = *(const bf16x8*)(ur + 8 * kh);
        if (FULL) { in.us[0] = *(const v2u*)(ur + 4 * kh); in.us[1] = *(const v2u*)(ur + 8 + 4 * kh); } }
}
template <int NV, bool FULL>
__device__ __forceinline__ void s5_block(const S5Ctx& c, const Frame& F, LAS unsigned char* wl, int row0, const S5In& in, float& hr, float& hi, int lane) {
    const int ti = lane & 31, kh = lane >> 5;
    const bf16x8 a = in.a;
    LAS float* L = (LAS float*)wl;
#pragma unroll
    for (int cb = 0; cb < 4; ++cb) {
        f32x16 d = {0.f, 0.f, 0.f, 0.f, 0.f, 0.f, 0.f, 0.f, 0.f, 0.f, 0.f, 0.f, 0.f, 0.f, 0.f, 0.f};
        d = __builtin_amdgcn_mfma_f32_32x32x16_bf16(a, c.bb[cb], d, 0, 0, 0);
#pragma unroll
        for (int r = 0; r < 16; ++r) { const int i = (r & 3) + 8 * (r >> 2) + 4 * kh; if (i < NV) L[i * 132 + 32 * cb + ti] = d[r]; }
    }
    LDS_WAIT(); asm volatile("" ::: "memory");
    float bre[NV], bim[NV];
#pragma unroll
    for (int t = 0; t < NV; ++t) { bre[t] = L[t * 132 + lane]; bim[t] = L[t * 132 + 64 + lane]; }
    LDS_WAIT(); asm volatile("" ::: "memory");
    LAS bf16* Hh = (LAS bf16*)wl;
#pragma unroll
    for (int t = 0; t < NV; ++t) {
        const float nr = c.lbr * hr - c.lbi * hi + bre[t], ni = c.lbr * hi + c.lbi * hr + bim[t]; hr = nr; hi = ni;
        if (FULL) { Hh[t * 264 + lane] = (bf16)f2bf(hr); Hh[t * 264 + 64 + lane] = (bf16)f2bf(hi); }
    }
    if (FULL) {
        LDS_WAIT(); asm volatile("" ::: "memory");
        f32x16 y = {0.f, 0.f, 0.f, 0.f, 0.f, 0.f, 0.f, 0.f, 0.f, 0.f, 0.f, 0.f, 0.f, 0.f, 0.f, 0.f};
#pragma unroll
        for (int kb = 0; kb < 8; ++kb) { const bf16x8 hb = *(const LAS bf16x8*)(wl + ti * 528 + (16 * kb + 8 * kh) * 2); y = __builtin_amdgcn_mfma_f32_32x32x16_bf16(c.cc[kb], hb, y, 0, 0, 0); }
        LDS_WAIT(); asm volatile("" ::: "memory");
        if (ti < NV) {
            bf16* YP = (bf16*)(F.ws + WS_YPRE) + (size_t)(row0 + ti) * 1024 + c.g * 16;
#pragma unroll
            for (int rr = 0; rr < 2; ++rr) { const int n0 = 8 * rr + 4 * kh; const v2u uu = in.us[rr]; const f32x4 dd = c.dsk[rr];
                const float y0 = pg8::gelu_tanh(y[4 * rr + 0] + dd.x * blo(uu.x)), y1 = pg8::gelu_tanh(y[4 * rr + 1] + dd.y * bhi(uu.x)),
                            y2 = pg8::gelu_tanh(y[4 * rr + 2] + dd.z * blo(uu.y)), y3 = pg8::gelu_tanh(y[4 * rr + 3] + dd.w * bhi(uu.y));
                v2u o; o.x = pk2(y0, y1); o.y = pk2(y2, y3); *(v2u*)(YP + n0) = o; }
        }
    }
}
template <bool FULL>
__device__ __forceinline__ void s5_prompt_item(const Frame& F, LAS unsigned char* wl, int item, int lane) {
    const int seg = item & (NSEG - 1), g = (item >> 4) & 63, b = item >> 10;
    float2* est = (float2*)(F.ws + WS_EST) + ((size_t)(b * 64 + g) * NSEG) * 64;
    if (!FULL && seg == NSEG - 1) return;
    S5Ctx c; s5_load_ctx(c, F, g, lane);
    float hr = 0.f, hi = 0.f;
    if (FULL) { const float2 pw = ((const float2*)(F.ws + WS_PW))[g * 64 + lane];
        float2 ev[NSEG - 1];
#pragma unroll
        for (int s = 0; s < NSEG - 1; ++s) { ev[s] = make_float2(0.f, 0.f); if (s < seg) ev[s] = est[s * 64 + lane]; }
#pragma unroll
        for (int s = 0; s < NSEG - 1; ++s) if (s < seg) { const float nr = pw.x * hr - pw.y * hi + ev[s].x, ni = pw.x * hi + pw.y * hr + ev[s].y; hr = nr; hi = ni; } }
    S5In cur, nxt, nx2;
    const int rbase = SEQ * b + 32 * (8 * seg);
    if (seg == 0) { s5_fetch<16, FULL>(cur, F, g, R_REAL + 16 * b, lane); s5_fetch<32, FULL>(nxt, F, g, rbase, lane); s5_fetch<32, FULL>(nx2, F, g, rbase + 32, lane);
        s5_block<16, FULL>(c, F, wl, R_REAL + 16 * b, cur, hr, hi, lane); cur = nxt; nxt = nx2; }
    else { s5_fetch<32, FULL>(cur, F, g, rbase, lane); s5_fetch<32, FULL>(nxt, F, g, rbase + 32, lane); }
    for (int j = 0; j < 8; ++j) {
        const int row0 = rbase + 32 * j;
        if (j < 6) s5_fetch<32, FULL>(nx2, F, g, row0 + 64, lane);
        s5_block<32, FULL>(c, F, wl, row0, cur, hr, hi, lane); cur = nxt; nxt = nx2; }
    if (!FULL) est[seg * 64 + lane] = make_float2(hr, hi);
    else if (seg == NSEG - 1) { F.out[O_SRE_P + (size_t)(b * 64 + g) * 64 + lane] = hr; F.out[O_SIM_P + (size_t)(b * 64 + g) * 64 + lane] = hi; }
}
__device__ __forceinline__ void s5_sample_item(const Frame& F, LAS unsigned char* wl, int item, int lane) {
    const int g = item & 63, s = item >> 6;
    S5Ctx c; s5_load_ctx(c, F, g, lane);
    float hr = inp(F, 2)[(size_t)(s * 64 + g) * 64 + lane], hi = inp(F, 3)[(size_t)(s * 64 + g) * 64 + lane];
    S5In cur; s5_fetch<16, true>(cur, F, g, R_SAMPLE0 + 16 * s, lane);
    s5_block<16, true>(c, F, wl, R_SAMPLE0 + 16 * s, cur, hr, hi, lane);
    F.out[O_SRE_S + (size_t)(s * 64 + g) * 64 + lane] = hr; F.out[O_SIM_S + (size_t)(s * 64 + g) * 64 + lane] = hi;
}

__device__ __forceinline__ void pool_m_phase(const Frame& F) {
    const bf16* U = (const bf16*)(F.ws + WS_U); bf16* MB = (bf16*)(F.ws + WS_MB); const int tid = ltid();
    const int sub = tid >> 7, t128 = tid & 127, c0 = 8 * t128, w = 2 << (c0 >> 8);
    for (int run = F.vcu * 4 + sub; run < 546; run += F.G * 4) {
        const bool samp = run >= 514; int rowbase, pos0; const float* hist = nullptr; int b = 0;
        if (samp) { const int sq = run - 514; rowbase = R_SAMPLE0 + 16 * sq; pos0 = 0; hist = inp(F, 4) + (size_t)sq * 15 * 1024 + c0; }
        else { b = run / 257; const int j = run % 257; pos0 = 16 * j; rowbase = j == 0 ? R_REAL + 16 * b : SEQ * b + 16 * (j - 1); }
        v4u zr[31];
#pragma unroll
        for (int i = 0; i < 31; ++i) {
            const int rel = i - 15; v4u q = {0u, 0u, 0u, 0u};
            if (rel >= 0) q = *(const v4u*)(U + (size_t)(rowbase + rel) * 2048 + 1024 + c0);
            else if (samp) { const f32x4 a = *(const f32x4*)(hist + (size_t)(15 + rel) * 1024), b2 = *(const f32x4*)(hist + (size_t)(15 + rel) * 1024 + 4); q.x = pk2(a.x, a.y); q.y = pk2(a.z, a.w); q.z = pk2(b2.x, b2.y); q.w = pk2(b2.z, b2.w); }
            else { const int pos = pos0 + rel; if (pos >= 0) { const int row = pos < 16 ? R_REAL + 16 * b + pos : SEQ * b + (pos - 16); q = *(const v4u*)(U + (size_t)row * 2048 + 1024 + c0); } }
            zr[i] = q;
        }
        float s[8];
#pragma unroll
        for (int e = 0; e < 8; ++e) s[e] = 0.f;
#pragma unroll
        for (int jj = 1; jj < 16; ++jj) { const v4u q = zr[15 - jj]; const float f = jj < w ? 1.f : 0.f;
            s[0] += f * blo(q.x); s[1] += f * bhi(q.x); s[2] += f * blo(q.y); s[3] += f * bhi(q.y); s[4] += f * blo(q.z); s[5] += f * bhi(q.z); s[6] += f * blo(q.w); s[7] += f * bhi(q.w); }
#pragma unroll
        for (int t = 0; t < 16; ++t) {
            const v4u q = zr[15 + t]; const float z[8] = {blo(q.x), bhi(q.x), blo(q.y), bhi(q.y), blo(q.z), bhi(q.z), blo(q.w), bhi(q.w)};
            const int pos = pos0 + t; const float inv = 1.0f / (float)((samp || pos + 1 >= w) ? w : pos + 1);
            float mo[8];
#pragma unroll
            for (int e = 0; e < 8; ++e) { s[e] += z[e]; mo[e] = s[e] * inv - z[e]; }
            v4u o; o.x = pk2(mo[0], mo[1]); o.y = pk2(mo[2], mo[3]); o.z = pk2(mo[4], mo[5]); o.w = pk2(mo[6], mo[7]);
            *(v4u*)(MB + (size_t)(rowbase + t) * 1024 + c0) = o;
            const v4u q2 = zr[15 + t - 1], q4 = zr[15 + t - 3], q8 = zr[15 + t - 7], q16 = zr[15 + t - 15];
            v4u ql; ql.x = w == 2 ? q2.x : (w == 4 ? q4.x : (w == 8 ? q8.x : q16.x)); ql.y = w == 2 ? q2.y : (w == 4 ? q4.y : (w == 8 ? q8.y : q16.y));
            ql.z = w == 2 ? q2.z : (w == 4 ? q4.z : (w == 8 ? q8.z : q16.z)); ql.w = w == 2 ? q2.w : (w == 4 ? q4.w : (w == 8 ? q8.w : q16.w));
            s[0] -= blo(ql.x); s[1] -= bhi(ql.x); s[2] -= blo(ql.y); s[3] -= bhi(ql.y); s[4] -= blo(ql.z); s[5] -= bhi(ql.z); s[6] -= blo(ql.w); s[7] -= bhi(ql.w);
        }
    }
    const int gt = F.vcu * NTHREADS + tid, NGT = F.G * NTHREADS;
    for (int i = gt; i < (2 + 32) * 15 * 256; i += NGT) {
        const int c4 = (i & 255) * 4, q = i >> 8, r = q % 15, sq = q / 15;
        const int row = sq < 2 ? SEQ * sq + 4081 + r : R_SAMPLE0 + 16 * (sq - 2) + 1 + r;
        const v2u uu = *(const v2u*)(U + (size_t)row * 2048 + 1024 + c4);
        float* dst = sq < 2 ? F.out + O_POOL_P + (size_t)(sq * 15 + r) * 1024 + c4 : F.out + O_POOL_S + (size_t)((sq - 2) * 15 + r) * 1024 + c4;
        *(f32x4*)dst = (f32x4){blo(uu.x), bhi(uu.x), blo(uu.y), bhi(uu.y)};
    }
}

__device__ __forceinline__ void gmeta_phase(const Frame& F) {
    const bf16* XN = (const bf16*)(F.ws + WS_XN); const bf16* WU = (const bf16*)(F.ws + WS_WUP); const float* ss = (const float*)(F.ws + WS_SS1); float* GM = (float*)(F.ws + WS_GMETA);
    const int gw = F.vcu * NWAVES + F.wave, NGW = F.G * NWAVES; const int lane = ltid() & 63;
    for (int jb = gw; jb < DFF; jb += 3 * NGW) {
        v4u xv[4][4], wv[3][4];
#pragma unroll
        for (int i = 0; i < 4; ++i) { const int c = 8 * lane + 512 * i;
#pragma unroll
            for (int q = 0; q < 4; ++q) xv[q][i] = *(const v4u*)(XN + (size_t)(R_REAL + 16 * (q >> 1) + 14 + (q & 1)) * LDP + c);
#pragma unroll
            for (int t = 0; t < 3; ++t) { const int j = jb + t * NGW; wv[t][i] = (v4u){0u, 0u, 0u, 0u}; if (j < DFF) wv[t][i] = *(const v4u*)(WU + (size_t)((j >> 7) * 256 + (j & 127)) * LDP + c); } }
#pragma unroll
        for (int t = 0; t < 3; ++t) { const int j = jb + t * NGW;
            float a[4] = {0.f, 0.f, 0.f, 0.f};
#pragma unroll
            for (int i = 0; i < 4; ++i) { const v4u w = wv[t][i]; const float wf[8] = {blo(w.x), bhi(w.x), blo(w.y), bhi(w.y), blo(w.z), bhi(w.z), blo(w.w), bhi(w.w)};
#pragma unroll
                for (int q = 0; q < 4; ++q) { const v4u x = xv[q][i];
                    a[q] += wf[0] * blo(x.x) + wf[1] * bhi(x.x) + wf[2] * blo(x.y) + wf[3] * bhi(x.y) + wf[4] * blo(x.z) + wf[5] * bhi(x.z) + wf[6] * blo(x.w) + wf[7] * bhi(x.w); } }
#pragma unroll
            for (int q = 0; q < 4; ++q) a[q] = wave_sum(a[q]);
            if (lane < 4 && j < DFF) { const int q = lane; const int Rm = R_REAL + 16 * (q >> 1) + 14 + (q & 1); const float v = q == 0 ? a[0] : (q == 1 ? a[1] : (q == 2 ? a[2] : a[3]));
                GM[(size_t)q * DFF + j] = v * rsqrtf(ss[Rm] * (1.0f / DM) + RMS_EPS); }
        }
    }
}

__device__ __forceinline__ void fixup_phase(const Frame& F) {
    const float* GF = (const float*)(F.ws + WS_GFIX); const float* VF = (const float*)(F.ws + WS_VFIX); const float* GS = (const float*)(F.ws + WS_GSRC); const float* GM = (const float*)(F.ws + WS_GMETA);
    const float* cw = inp(F, 23); const float* cb = inp(F, 24); const float* hist = inp(F, 5); bf16* H = (bf16*)(F.ws + WS_H);
    const int tid = ltid(); const int gt = F.vcu * NTHREADS + tid, NGT = F.G * NTHREADS;
    for (int idx = gt; idx < 320 * 1408; idx += NGT) {
        const int id = idx / 1408, j = (idx % 1408) * 4;
        const f32x4 g0 = *(const f32x4*)(GF + (size_t)id * DFF + j), v0 = *(const f32x4*)(VF + (size_t)id * DFF + j);
        f32x4 p1, p2; int R;
        if (id < 256) {
            const int pm = id >> 3, blk = (id & 7) >> 1, rr = id & 1; R = 256 * pm + 64 * blk + rr;
            const bool start = blk == 0 && (pm == 0 || pm == 16);
            const float* S0; const float* S1;
            if (start) { const int b = pm >> 4; S0 = GM + (size_t)(b * 2 + 0) * DFF; S1 = GM + (size_t)(b * 2 + 1) * DFF; }
            else { const int sb = blk > 0 ? pm * 8 + (blk - 1) * 2 : (pm - 1) * 8 + 6; S0 = GS + (size_t)sb * DFF; S1 = GS + (size_t)(sb + 1) * DFF; }
            if (rr == 0) { p1 = *(const f32x4*)(S1 + j); p2 = *(const f32x4*)(S0 + j); }
            else { p1 = *(const f32x4*)(GF + (size_t)(id - 1) * DFF + j); p2 = *(const f32x4*)(S1 + j); }
        } else {
            const int q = id - 256, sq = q >> 1, rr = q & 1; R = R_SAMPLE0 + 16 * sq + rr;
            const float* h0 = hist + (size_t)(sq * 2 + 0) * DFF; const float* h1 = hist + (size_t)(sq * 2 + 1) * DFF;
            if (rr == 0) { p1 = *(const f32x4*)(h1 + j); p2 = *(const f32x4*)(h0 + j); }
            else { p1 = *(const f32x4*)(GF + (size_t)(id - 1) * DFF + j); p2 = *(const f32x4*)(h1 + j); }
        }
        const f32x4 w0 = *(const f32x4*)(cw + j), w1 = *(const f32x4*)(cw + DFF + j), w2 = *(const f32x4*)(cw + 2 * DFF + j), bb = *(const f32x4*)(cb + j);
        const f32x4 gc = bb + p2 * w0 + p1 * w1 + g0 * w2;
        v2u o; o.x = pk2(pg8::gelu_tanh(gc.x) * v0.x, pg8::gelu_tanh(gc.y) * v0.y); o.y = pk2(pg8::gelu_tanh(gc.z) * v0.z, pg8::gelu_tanh(gc.w) * v0.w);
        *(v2u*)(H + (size_t)R * DFF + j) = o;
    }
}
__device__ __forceinline__ void final_phase(const Frame& F) {
    const float* gf = inp(F, 26); const float* gn = inp(F, 21); const bf16* XNb = (const bf16*)(F.ws + WS_XN);
    const bf16* FA = (const bf16*)(F.ws + WS_FA); const bf16* FBb = (const bf16*)(F.ws + WS_FB);
    const int gw = F.vcu * NWAVES + F.wave, NGW = F.G * NWAVES; const int lane = ltid() & 63;
    f32x4 rg[8];
#pragma unroll
    for (int j = 0; j < 8; ++j) { const f32x4 g = ((const f32x4*)gn)[64 * j + lane]; rg[j] = (f32x4){1.0f / g.x, 1.0f / g.y, 1.0f / g.z, 1.0f / g.w}; }
    v2u xb[8], xbn[8], xb2[8], fb[8], fbn[8], fb2[8]; int R = gw;
    auto fetch = [&](int Rr, v2u (&x)[8], v2u (&f)[8]) {
        if (Rr < R_REAL) { const v2u* xr = (const v2u*)(XNb + (size_t)Rr * LDP) + lane; const v2u* fr_ = (const v2u*)((Rr < F_SPLIT ? FA + (size_t)Rr * DM : FBb + (size_t)(Rr - F_SPLIT) * DM)) + lane;
#pragma unroll
            for (int j = 0; j < 8; ++j) { x[j] = xr[64 * j]; f[j] = fr_[64 * j]; } } };
    fetch(R, xb, fb); fetch(R + NGW, xbn, fbn);
    while (R < R_REAL) {
        fetch(R + 2 * NGW, xb2, fb2);
        f32x4 v[8]; float s = 0.f;
#pragma unroll
        for (int j = 0; j < 8; ++j) { v[j].x = blo(xb[j].x) * rg[j].x + blo(fb[j].x); v[j].y = bhi(xb[j].x) * rg[j].y + bhi(fb[j].x); v[j].z = blo(xb[j].y) * rg[j].z + blo(fb[j].y); v[j].w = bhi(xb[j].y) * rg[j].w + bhi(fb[j].y);
            s += (v[j].x * v[j].x + v[j].y * v[j].y) + (v[j].z * v[j].z + v[j].w * v[j].w); }
        const float rstd = rsqrtf(wave_sum(s) * (1.0f / DM) + RMS_EPS);
        f32x4* xo = (f32x4*)(F.out + (size_t)R * DM) + lane;
#pragma unroll
        for (int j = 0; j < 8; ++j) { const f32x4 g = ((const f32x4*)gf)[64 * j + lane]; __builtin_nontemporal_store(v[j] * rstd * g, xo + 64 * j); }
#pragma unroll
        for (int j = 0; j < 8; ++j) { xb[j] = xbn[j]; fb[j] = fbn[j]; xbn[j] = xb2[j]; fbn[j] = fb2[j]; }
        R += NGW;
    }
}

struct Args { const float* in[27]; float* out; unsigned char* ws; };
#ifndef PROBE
#define PROBE 0
#endif
__global__ void __launch_bounds__(NTHREADS, 2) hymba_fwd(Args args) {
    extern __shared__ __attribute__((aligned(16))) unsigned char lds[];
    cg::grid_group grid = cg::this_grid();
    Frame F;
    F.lds = (LAS unsigned char*)lds;
    F.wave = __builtin_amdgcn_readfirstlane((int)threadIdx.x >> 6);
    F.G = gridDim.x; { const int bx = blockIdx.x; F.vcu = (F.G % 8 == 0) ? (bx % 8) * (F.G / 8) + bx / 8 : bx; }
    if (threadIdx.x == 0) {
#pragma unroll
        for (int i = 0; i < 27; ++i) ((LAS unsigned long long*)(F.lds + TAB_OFF))[i] = (unsigned long long)args.in[i];
        ((LAS unsigned*)(F.lds + BARST_OFF))[0] = 0u; ((LAS unsigned*)(F.lds + BARST_OFF))[1] = 0u; ((LAS unsigned*)(F.lds + BARST_OFF + 64))[0] = 0u;
    }
    __syncthreads();
    const XcdBarrier bar = xcd_barrier_post((unsigned*)(args.ws + WS_BAR), (volatile LAS unsigned*)(F.lds + BARST_OFF));
#ifndef TPROBE_A
#define TPROBE_A -1
#define TPROBE_B -1
#endif
    int stamp_i_ = 0;
#define STAMP() do { if (TPROBE_A >= 0 && blockIdx.x == 0 && threadIdx.x == 0) ((volatile LAS unsigned long long*)(F.lds + BARST_OFF + 128))[stamp_i_] = __builtin_amdgcn_s_memrealtime(); ++stamp_i_; } while (0)
#define GRID_BAR() do { xcd_barrier(bar); STAMP(); } while (0)
    STAMP();
    F.out = (float*)(GAS float*)args.out; F.ws = (unsigned char*)(GAS unsigned char*)args.ws;
    unsigned char* ws = F.ws;
    bf16* XN = (bf16*)(ws + WS_XN); bf16* U = (bf16*)(ws + WS_U); bf16* YPRE = (bf16*)(ws + WS_YPRE); bf16* MB = (bf16*)(ws + WS_MB); bf16* YCAT = (bf16*)(ws + WS_YCAT); bf16* H = (bf16*)(ws + WS_H);
    float* SS1 = (float*)(ws + WS_SS1); float* SS2 = (float*)(ws + WS_SS2);
    const int gw = F.vcu * NWAVES + F.wave, NGW = F.G * NWAVES;
    LAS unsigned char* wl = F.lds + F.wave * S5_WLDS;

    auto forward_ = [&]() __attribute__((always_inline)) {
    p0_prologue(F);
    if (PROBE == 1) { __syncthreads(); p0_prologue(F); }
    if (args.ws == nullptr) grid.sync();
    GRID_BAR();
    { pg8::Gemm g{XN, (const bf16*)(ws + WS_WIN), LDP, LDP, 2048, 0}; pg8::RemSplit S; S.init(35, 8, 16, 8, F.G, (int)blockIdx.x);
      pg8::EpiBf16 E{U, 2048}; const pg8::SKBuf sk{(float*)(ws + WS_SLOTS), (unsigned*)(ws + WS_FLAGS), (int)blockIdx.x};
      pg8::gemm_phase<pg8::EpiBf16, pg8::RemSplit, true, true, true>(F.lds, g, S, E, sk); GRID_BAR(); pg8::gemm_reduce(S, E, sk);
      if (PROBE == 4) { GRID_BAR(); pg8::gemm_phase<pg8::EpiBf16, pg8::RemSplit, true, true, true>(F.lds, g, S, E, sk); GRID_BAR(); pg8::gemm_reduce(S, E, sk); } }
    GRID_BAR();
    for (int it = gw; it < 2 * 64 * NSEG; it += NGW) s5_prompt_item<false>(F, wl, it, ltid() & 63);
    for (int it = gw; it < DECB * 64; it += NGW) s5_sample_item(F, wl, it, ltid() & 63);
    pool_m_phase(F);
    if (PROBE == 2) { __syncthreads();
        for (int it = gw; it < 2 * 64 * NSEG; it += NGW) s5_prompt_item<false>(F, wl, it, ltid() & 63);
        for (int it = gw; it < DECB * 64; it += NGW) s5_sample_item(F, wl, it, ltid() & 63);
        pool_m_phase(F); }
    GRID_BAR();
    for (int it = gw; it < 2 * 64 * NSEG; it += NGW) s5_prompt_item<true>(F, wl, it, ltid() & 63);
    if (PROBE == 2) { for (int it = gw; it < 2 * 64 * NSEG; it += NGW) s5_prompt_item<true>(F, wl, it, ltid() & 63); }
    GRID_BAR();
    if (F.G > 140 + 35) {
        if ((int)blockIdx.x < 140) { pg8::Gemm g{YPRE, (const bf16*)(ws + WS_WGLU), 1024, 1024, 1024, 0}; pg8::StaticOrder S; S.init(35, 4, 16, 140, (int)blockIdx.x);
            pg8::EpiGlu E{YPRE, YCAT}; pg8::gemm_phase<pg8::EpiGlu, pg8::StaticOrder, true, true>(F.lds, g, S, E); }
        else { pg8::Gemm g{MB, (const bf16*)(ws + WS_WPOOL), 1024, 256, 256, 256}; pg8::StaticOrder S; S.init(35, 4, 4, F.G - 140, (int)blockIdx.x - 140);
            pg8::EpiPool E{YCAT, inp(F, 19)}; pg8::gemm_phase<pg8::EpiPool, pg8::StaticOrder, true, true>(F.lds, g, S, E); }
    } else {
        { pg8::Gemm g{MB, (const bf16*)(ws + WS_WPOOL), 1024, 256, 256, 256}; pg8::StaticOrder S; S.init(35, 4, 4, F.G, (int)blockIdx.x);
          pg8::EpiPool E{YCAT, inp(F, 19)}; pg8::gemm_phase<pg8::EpiPool, pg8::StaticOrder, true, true>(F.lds, g, S, E); }
        __syncthreads();
        { pg8::Gemm g{YPRE, (const bf16*)(ws + WS_WGLU), 1024, 1024, 1024, 0}; pg8::StaticOrder S; S.init(35, 4, 16, F.G, (int)blockIdx.x);
          pg8::EpiGlu E{YPRE, YCAT}; pg8::gemm_phase<pg8::EpiGlu, pg8::StaticOrder, true, true>(F.lds, g, S, E); }
    }
    GRID_BAR();
    if (PROBE == 12) { GRID_BAR();
        if ((int)blockIdx.x < 140) { pg8::Gemm g{YPRE, (const bf16*)(ws + WS_WGLU), 1024, 1024, 1024, 0}; pg8::StaticOrder S; S.init(35, 4, 16, 140, (int)blockIdx.x);
            pg8::EpiGlu E{YPRE, YCAT}; pg8::gemm_phase<pg8::EpiGlu, pg8::StaticOrder, true, true>(F.lds, g, S, E); }
        else { pg8::Gemm g{MB, (const bf16*)(ws + WS_WPOOL), 1024, 256, 256, 256}; pg8::StaticOrder S; S.init(35, 4, 4, F.G - 140, (int)blockIdx.x - 140);
            pg8::EpiPool E{YCAT, inp(F, 19)}; pg8::gemm_phase<pg8::EpiPool, pg8::StaticOrder, true, true>(F.lds, g, S, E); } }
    { pg8::Gemm g{YCAT, (const bf16*)(ws + WS_WOUT), LDP, LDP, 2048, 0}; pg8::RemSplit S; S.init(35, 8, 16, 8, F.G, (int)blockIdx.x);
      pg8::EpiOut E{SS2, inp(F, 7), inp(F, 21), XN, SS1};
      const pg8::SKBuf sk{(float*)(ws + WS_SLOTS), (unsigned*)(ws + WS_FLAGS) + 512, (int)blockIdx.x};
      pg8::gemm_phase<pg8::EpiOut, pg8::RemSplit, true, true, true>(F.lds, g, S, E, sk); GRID_BAR(); pg8::gemm_reduce(S, E, sk);
      if (PROBE == 11) { GRID_BAR(); for (int i = F.vcu * NTHREADS + ltid(); i < 9216; i += F.G * NTHREADS) SS1[i] = 0.f; GRID_BAR();
          pg8::gemm_phase<pg8::EpiOut, pg8::RemSplit, true, true, true>(F.lds, g, S, E, sk); GRID_BAR(); pg8::gemm_reduce(S, E, sk); } }
    GRID_BAR();
    gmeta_phase(F);
    { pg8::Gemm g{XN, (const bf16*)(ws + WS_WUP), LDP, LDP, 2048, 0}; pg8::StaticOrder S; S.init(34, 44, 32, F.G, (int)blockIdx.x);
      pg8::EpiUp E{SS1, inp(F, 23), inp(F, 24), H, (float*)(ws + WS_GFIX), (float*)(ws + WS_VFIX), (float*)(ws + WS_GSRC), F.out + O_CONV_P, F.out + O_CONV_S};
      pg8::gemm_phase<pg8::EpiUp, pg8::StaticOrder, true, true>(F.lds, g, S, E);
      if (PROBE == 3) { __syncthreads(); pg8::gemm_phase<pg8::EpiUp, pg8::StaticOrder, true, true>(F.lds, g, S, E); }
      if (PROBE == 13) { __syncthreads(); pg8::EpiBf16 E2{(bf16*)(ws + WS_FA), 0}; pg8::gemm_phase<pg8::EpiBf16, pg8::StaticOrder, true, true>(F.lds, g, S, E2); } }
    if (F.G == 256 && (int)blockIdx.x >= 216) { __syncthreads(); p0_convert(F, I_EARLY, I_EARLY + I_DOWN, ((int)blockIdx.x - 216) * NWAVES + F.wave, 40 * NWAVES, ltid() & 63); }
    GRID_BAR();
    fixup_phase(F);
    GRID_BAR();
    { pg8::Gemm g{H, (const bf16*)(ws + WS_WDOWN), DFF, DFF, DFF, 0}; pg8::RemSplit S; S.init(34, 8, 44, 16, F.G, (int)blockIdx.x);
      pg8::EpiF E{(bf16*)(ws + WS_FA), (bf16*)(ws + WS_FB), F_SPLIT};
      const pg8::SKBuf sk{(float*)(ws + WS_SLOTS), (unsigned*)(ws + WS_FLAGS) + 768, (int)blockIdx.x};
      pg8::gemm_phase<pg8::EpiF, pg8::RemSplit, true, true, true>(F.lds, g, S, E, sk); GRID_BAR(); pg8::gemm_reduce(S, E, sk); }
    GRID_BAR();
    if (PROBE == 9) { GRID_BAR(); pg8::Gemm g{H, (const bf16*)(ws + WS_WDOWN), DFF, DFF, DFF, 0}; pg8::RemSplit S; S.init(34, 8, 44, 16, F.G, (int)blockIdx.x);
        const pg8::SKBuf sk{(float*)(ws + WS_SLOTS), (unsigned*)(ws + WS_FLAGS) + 768, (int)blockIdx.x}; pg8::EpiBf16 E{XN, 2048};
        pg8::gemm_phase<pg8::EpiBf16, pg8::RemSplit, true, true, true>(F.lds, g, S, E, sk); GRID_BAR(); pg8::gemm_reduce(S, E, sk); }
    if (PROBE == 10) { GRID_BAR(); const int gw2 = F.vcu * NWAVES + F.wave, lane2 = ltid() & 63;
        for (int R = gw2; R < R_REAL; R += F.G * NWAVES) { f32x4* xr = (f32x4*)(F.out + (size_t)R * DM) + lane2;
#pragma unroll
            for (int j = 0; j < 8; ++j) { f32x4 v = xr[64 * j]; asm volatile("" : "+v"(v)); xr[64 * j] = v; } } }
    if (PROBE == 6) { pg8::Gemm g{H, (const bf16*)(ws + WS_WDOWN), DFF, DFF, DFF, 0}; pg8::StaticOrder S; S.init(34, 8, 88, F.G, (int)blockIdx.x);
        pg8::EpiBf16 E{XN, 2048}; pg8::gemm_phase<pg8::EpiBf16, pg8::StaticOrder, true, true>(F.lds, g, S, E); }
    if (PROBE == 7) { GRID_BAR(); GRID_BAR(); GRID_BAR(); GRID_BAR(); GRID_BAR(); GRID_BAR(); GRID_BAR(); GRID_BAR(); }
    final_phase(F);
    if (TPROBE_A >= 0) { asm volatile("s_waitcnt vmcnt(0)" ::: "memory"); __syncthreads(); STAMP();
        if (blockIdx.x == 0 && threadIdx.x == 0) { volatile LAS unsigned long long* ts = (volatile LAS unsigned long long*)(F.lds + BARST_OFF + 128);
            const unsigned long long d = ts[TPROBE_B] - ts[TPROBE_A], t0 = __builtin_amdgcn_s_memrealtime();
            while (__builtin_amdgcn_s_memrealtime() - t0 < d) __builtin_amdgcn_s_sleep(8); } }
    };
    forward_();
    if (PROBE == 8) { GRID_BAR(); forward_(); }
}

extern "C" void kernel_launch(void* const* d_in, const int* in_sizes, int n_in, void* d_out, int out_size, void* d_ws, size_t ws_size, hipStream_t stream) {
    static int grid = 0;
    if (grid == 0) {
        if (n_in != 27 || out_size != 19009536 || ws_size < WS_END) { fprintf(stderr, "kernel_launch: unexpected shapes (n_in %d, out %d, ws %zu)\n", n_in, out_size, ws_size); grid = -1; return; }
        int dev = 0, cus = 0, per_cu = 0;
        if (hipGetDevice(&dev) != hipSuccess || hipDeviceGetAttribute(&cus, hipDeviceAttributeMultiprocessorCount, dev) != hipSuccess) { grid = -1; return; }
        if (hipFuncSetAttribute((const void*)hymba_fwd, hipFuncAttributeMaxDynamicSharedMemorySize, LDS_BYTES) != hipSuccess) { fprintf(stderr, "kernel_launch: hipFuncSetAttribute failed\n"); grid = -1; return; }
        if (hipOccupancyMaxActiveBlocksPerMultiprocessor(&per_cu, (const void*)hymba_fwd, NTHREADS, LDS_BYTES) != hipSuccess || per_cu < 1) { fprintf(stderr, "kernel_launch: occupancy query says %d\n", per_cu); per_cu = 1; }
        (void)hipGetLastError();
        grid = cus;
    }
    if (grid < 0) return;
    if (hipMemsetAsync((char*)d_ws + WS_BAR, 0, XCD_BAR_WORDS * 4, stream) != hipSuccess) { fprintf(stderr, "kernel_launch: memset of barrier words failed\n"); return; }
    Args a{};
    for (int i = 0; i < 27; ++i) a.in[i] = (const float*)d_in[i];
    a.out = (float*)d_out; a.ws = (unsigned char*)d_ws;
    void* kargs[] = {&a};
    hipError_t e = hipLaunchCooperativeKernel((const void*)hymba_fwd, dim3(grid), dim3(NTHREADS), kargs, LDS_BYTES, stream);
    if (e != hipSuccess) fprintf(stderr, "kernel_launch: cooperative launch failed: %s (grid %d)\n", hipGetErrorString(e), grid);
}
```

```cpp
#include <hip/hip_runtime.h>
#include <hip/hip_cooperative_groups.h>
#include <cstdio>
#include <cstdint>
namespace cg = cooperative_groups;

namespace pg8 {
#define PG8_LAS __attribute__((address_space(3)))
typedef unsigned short bf16_t;
typedef short bf16x8 __attribute__((ext_vector_type(8)));
typedef float f32x4 __attribute__((ext_vector_type(4)));
typedef float f32x2 __attribute__((ext_vector_type(2)));
typedef unsigned u32x4 __attribute__((ext_vector_type(4)));
typedef unsigned u32x2 __attribute__((ext_vector_type(2)));
constexpr int BM = 256, BK = 64, HALF = 128, HTB = HALF * BK * 2  , STAGE_BYTES = 8 * HTB, NXCD = 8, WGM = 8;

__host__ __device__ __forceinline__ int lds_byte(int r, int c) { const int st = (r >> 4) * 2 + (c >> 5), rr = r & 15, cc = c & 31, ob = rr * 64 + cc * 2; return st * 1024 + (ob ^ (((ob >> 9) & 1) << 5)); }
__host__ __device__ __forceinline__ void stage_rc(int b, int& R, int& C) { const int st = b / 1024, sb = b % 1024, swz = sb ^ (((sb >> 9) & 1) << 5); R = (st >> 1) * 16 + swz / 64; C = (st & 1) * 32 + (swz % 64) / 2; }
__host__ __device__ __forceinline__ int perm32(int rho) { const int n = rho >> 4, i = rho & 15; return 8 * (i >> 2) + 4 * n + (i & 3); }

struct Unit { int pm, pn, k0, nt, kind, nwait; };
struct Gemm {
    const bf16_t* A; const bf16_t* Bt; int lda, ldb, K, a_pn_off;
    __device__ __forceinline__ const char* abase(const Unit& u) const { return (const char*)(A + ((size_t)u.pm * BM * lda + (size_t)u.pn * a_pn_off + (size_t)u.k0 * BK)); }
    __device__ __forceinline__ const char* bbase(const Unit& u) const { return (const char*)(Bt + ((size_t)u.pn * BM * ldb + (size_t)u.k0 * BK)); }
};

struct StaticOrder {
    int nM, nN, nwg, G, c, ntile;
    __host__ __device__ void init(int nM_, int nN_, int ntile_, int G_, int c_) { nM = nM_; nN = nN_; nwg = nM * nN; ntile = ntile_; G = G_; c = c_; }
    __host__ __device__ bool next(int i, Unit& u) const { const long L = (long)i * G + c; if (L >= nwg) return false; map((int)L, u); return true; }
    __host__ __device__ bool map(int L, Unit& u) const {
        int wgid = L; { const int q = nwg / NXCD, r = nwg % NXCD, xcd = wgid % NXCD, off = wgid / NXCD; wgid = (xcd < r ? xcd * (q + 1) : r * (q + 1) + (xcd - r) * q) + off; }
        const int nig = WGM * nN, gid = wgid / nig, fm = gid * WGM, gsz = (nM - fm) < WGM ? (nM - fm) : WGM;
        u.pm = fm + ((wgid % nig) % gsz); u.pn = (wgid % nig) / gsz; u.k0 = 0; u.nt = ntile; u.kind = 0; u.nwait = 0; return true;
    }
    __device__ __forceinline__ void a_ready(const Unit&) const {}
    __device__ __forceinline__ void done(const Unit&) const {}
};

struct RemSplit {
    StaticOrder so; int q, R, S, P, c;
    __device__ void init(int nM_, int nN_, int P_, int S_, int G_, int c_) { so.init(nM_, nN_, 2 * P_, G_, c_); q = so.nwg / G_; R = so.nwg % G_; S = S_; P = P_; c = c_; }
    __device__ bool next(int i, Unit& u) const {
        if (c < R * S) { if (i == 0) { so.map(q * so.G + c / S, u); const int sl = c % S, lo = sl * P / S, hi = (sl + 1) * P / S; u.k0 = 2 * lo; u.nt = 2 * (hi - lo); u.kind = 1; return true; } i -= 1; }
        if (i >= q) return false; so.map(i * so.G + c, u); return true;
    }
    __device__ bool reducer(Unit& u, unsigned& mask, int& base) const {
        if (c >= R * S) return false; so.map(q * so.G + c / S, u); base = (c / S) * S; const int j = c % S;
        mask = S == 16 ? 1u << ((j >> 3) * 8 + ((j >> 1) & 3) * 2 + (j & 1)) : 3u << ((j >> 2) * 8 + (j & 3) * 2); return true;
    }
    __device__ __forceinline__ void a_ready(const Unit&) const {}
    __device__ __forceinline__ void done(const Unit&) const {}
};
struct SKBuf { float* slots; unsigned* flags; int v; };

__device__ __forceinline__ unsigned cvt_pk_bf16(float lo, float hi) { unsigned r; asm volatile("v_cvt_pk_bf16_f32 %0, %1, %2" : "=v"(r) : "v"(lo), "v"(hi)); return r; }
__device__ __forceinline__ float bflo(unsigned w) { return __uint_as_float(w << 16); }
__device__ __forceinline__ float bfhi(unsigned w) { return __uint_as_float(w & 0xffff0000u); }
__device__ __forceinline__ float gelu_tanh(float x) {
    const float u = x * (1.0f + 0.044715f * x * x);
    const float e = __builtin_amdgcn_exp2f(u * (-2.0f * 0.7978845608028654f * 1.4426950408889634f));
    return x * __builtin_amdgcn_rcpf(1.0f + e);
}
__device__ __forceinline__ float sigmoidf_(float x) { return __builtin_amdgcn_rcpf(1.0f + __builtin_amdgcn_exp2f(x * -1.4426950408889634f)); }

struct EpiBf16 {
    static constexpr bool PERM = true, AFTER_DRAIN = false;
    bf16_t* O; int ldc;
    __device__ __forceinline__ void operator()(const f32x4 (&acc)[2][2][4][2], const Unit& u, int wr, int wc, int fr, int fq, unsigned mask = 0xFFFFu) const {
        const int row0 = u.pm * BM + wr * 64 + fr; const int col0 = u.pn * BM + wc * 32 + 8 * fq;
#pragma unroll
        for (int ai = 0; ai < 2; ++ai)
#pragma unroll
            for (int m = 0; m < 4; ++m) { bf16_t* rowp = O + (size_t)(row0 + ai * HALF + m * 16) * ldc + col0;
#pragma unroll
                for (int bj = 0; bj < 2; ++bj) { if (!((mask >> (ai * 8 + m * 2 + bj)) & 1u)) continue; const f32x4 v0 = acc[ai][bj][m][0], v1 = acc[ai][bj][m][1];
                    u32x4 w; w.x = cvt_pk_bf16(v0[0], v0[1]); w.y = cvt_pk_bf16(v0[2], v0[3]); w.z = cvt_pk_bf16(v1[0], v1[1]); w.w = cvt_pk_bf16(v1[2], v1[3]);
                    *(u32x4*)(rowp + bj * HALF) = w; } }
    }
};
struct EpiF {
    static constexpr bool PERM = true, AFTER_DRAIN = false;
    bf16_t* Oa; bf16_t* Ob; int split;
    __device__ __forceinline__ void operator()(const f32x4 (&acc)[2][2][4][2], const Unit& u, int wr, int wc, int fr, int fq, unsigned mask = 0xFFFFu) const {
        const int rowt = u.pm * BM; bf16_t* base = rowt < split ? Oa + (size_t)rowt * 2048 : Ob + (size_t)(rowt - split) * 2048;
        const int row0 = wr * 64 + fr; const int col0 = u.pn * BM + wc * 32 + 8 * fq;
#pragma unroll
        for (int ai = 0; ai < 2; ++ai)
#pragma unroll
            for (int m = 0; m < 4; ++m) { bf16_t* rowp = base + (size_t)(row0 + ai * HALF + m * 16) * 2048 + col0;
#pragma unroll
                for (int bj = 0; bj < 2; ++bj) { if (!((mask >> (ai * 8 + m * 2 + bj)) & 1u)) continue; const f32x4 v0 = acc[ai][bj][m][0], v1 = acc[ai][bj][m][1];
                    u32x4 w; w.x = cvt_pk_bf16(v0[0], v0[1]); w.y = cvt_pk_bf16(v0[2], v0[3]); w.z = cvt_pk_bf16(v1[0], v1[1]); w.w = cvt_pk_bf16(v1[2], v1[3]);
                    *(u32x4*)(rowp + bj * HALF) = w; } }
    }
};
struct EpiPool {
    static constexpr bool PERM = true, AFTER_DRAIN = false;
    bf16_t* O; const float* scale;
    __device__ __forceinline__ void operator()(const f32x4 (&acc)[2][2][4][2], const Unit& u, int wr, int wc, int fr, int fq) const {
        const int row0 = u.pm * BM + wr * 64 + fr; const int c0 = u.pn * BM + wc * 32 + 8 * fq;
        f32x4 sv[2][2];
#pragma unroll
        for (int bj = 0; bj < 2; ++bj)
#pragma unroll
            for (int n = 0; n < 2; ++n) sv[bj][n] = *(const f32x4*)(scale + c0 + bj * HALF + 4 * n);
#pragma unroll
        for (int ai = 0; ai < 2; ++ai)
#pragma unroll
            for (int m = 0; m < 4; ++m) { bf16_t* rowp = O + (size_t)(row0 + ai * HALF + m * 16) * 2112 + 1024 + c0;
#pragma unroll
                for (int bj = 0; bj < 2; ++bj) { const f32x4 v0 = acc[ai][bj][m][0] * sv[bj][0], v1 = acc[ai][bj][m][1] * sv[bj][1];
                    u32x4 w; w.x = cvt_pk_bf16(v0[0], v0[1]); w.y = cvt_pk_bf16(v0[2], v0[3]); w.z = cvt_pk_bf16(v1[0], v1[1]); w.w = cvt_pk_bf16(v1[2], v1[3]);
                    *(u32x4*)(rowp + bj * HALF) = w; } }
    }
};
struct EpiGlu {
    static constexpr bool PERM = true, AFTER_DRAIN = false;
    const bf16_t* YP; bf16_t* O;
    __device__ __forceinline__ void operator()(const f32x4 (&acc)[2][2][4][2], const Unit& u, int wr, int wc, int fr, int fq) const {
        const int row0 = u.pm * BM + wr * 64 + fr; const int c0 = u.pn * BM + wc * 32 + 8 * fq;
        u32x4 yp[2][4][2];
#pragma unroll
        for (int ai = 0; ai < 2; ++ai)
#pragma unroll
            for (int m = 0; m < 4; ++m)
#pragma unroll
                for (int bj = 0; bj < 2; ++bj) yp[ai][m][bj] = *(const u32x4*)(YP + (size_t)(row0 + ai * HALF + m * 16) * 1024 + c0 + bj * HALF);
#pragma unroll
        for (int ai = 0; ai < 2; ++ai)
#pragma unroll
            for (int m = 0; m < 4; ++m) { const size_t R = (size_t)(row0 + ai * HALF + m * 16);
#pragma unroll
                for (int bj = 0; bj < 2; ++bj) { const u32x4 y = yp[ai][m][bj];
                    const f32x4 a = acc[ai][bj][m][0], b = acc[ai][bj][m][1];
                    u32x4 w;
                    w.x = cvt_pk_bf16(bflo(y.x) * sigmoidf_(a[0]), bfhi(y.x) * sigmoidf_(a[1]));
                    w.y = cvt_pk_bf16(bflo(y.y) * sigmoidf_(a[2]), bfhi(y.y) * sigmoidf_(a[3]));
                    w.z = cvt_pk_bf16(bflo(y.z) * sigmoidf_(b[0]), bfhi(y.z) * sigmoidf_(b[1]));
                    w.w = cvt_pk_bf16(bflo(y.w) * sigmoidf_(b[2]), bfhi(y.w) * sigmoidf_(b[3]));
                    *(u32x4*)(O + R * 2112 + c0 + bj * HALF) = w; } }
    }
};
constexpr int R_SAMPLE0 = 8192, R_REAL = 8704, R_ALL = 8736, R_PAD = 8960;
constexpr int LDP = 2112;
struct EpiOut {
    static constexpr bool PERM = false, AFTER_DRAIN = false;
    const float *irs0, *gmix, *gffn; bf16_t* XN; float* ss;
    __device__ __forceinline__ void operator()(const f32x4 (&acc)[2][2][4][2], const Unit& u, int wr, int wc, int fr, int fq, unsigned mask = 0xFFFFu) const {
        const int col0 = u.pn * BM + wc * 32 + 4 * fq;
        f32x4 gv[2][2], rm[2][2];
#pragma unroll
        for (int bj = 0; bj < 2; ++bj)
#pragma unroll
            for (int n = 0; n < 2; ++n) { gv[bj][n] = *(const f32x4*)(gffn + col0 + bj * HALF + n * 16); const f32x4 g = *(const f32x4*)(gmix + col0 + bj * HALF + n * 16); rm[bj][n] = (f32x4){1.0f / g[0], 1.0f / g[1], 1.0f / g[2], 1.0f / g[3]}; }
#pragma unroll
        for (int ai = 0; ai < 2; ++ai)
#pragma unroll
            for (int m = 0; m < 4; ++m) { if (!((mask >> (ai * 8 + m * 2)) & 3u)) continue; const int R = u.pm * BM + ai * HALF + wr * 64 + m * 16 + fr; float s = 0.f;
                if (R < R_ALL) {
                    const float ir = irs0[R];
                    bf16_t* xn = XN + (size_t)R * LDP;
#pragma unroll
                    for (int bj = 0; bj < 2; ++bj)
#pragma unroll
                        for (int n = 0; n < 2; ++n) { if (!((mask >> (ai * 8 + m * 2 + bj)) & 1u)) continue; const int c = col0 + bj * HALF + n * 16; const u32x2 xq = *(const u32x2*)(xn + c);
                            const f32x4 x1 = (f32x4){bflo(xq.x), bfhi(xq.x), bflo(xq.y), bfhi(xq.y)} * rm[bj][n] * ir + acc[ai][bj][m][n];
                            s += (x1[0] * x1[0] + x1[1] * x1[1]) + (x1[2] * x1[2] + x1[3] * x1[3]);
                            const f32x4 xg = x1 * gv[bj][n]; u32x2 w; w.x = cvt_pk_bf16(xg[0], xg[1]); w.y = cvt_pk_bf16(xg[2], xg[3]); *(u32x2*)(xn + c) = w; }
                }
                s += __shfl_xor(s, 16); s += __shfl_xor(s, 32);
                if (fq == 0 && R < R_ALL) atomicAdd(ss + R, s); }
    }
};
struct EpiDown {
    static constexpr bool PERM = false, AFTER_DRAIN = false;
    float* out; float* ss;
    __device__ __forceinline__ void operator()(const f32x4 (&acc)[2][2][4][2], const Unit& u, int wr, int wc, int fr, int fq, unsigned mask = 0xFFFFu) const {
        const int col0 = u.pn * BM + wc * 32 + 4 * fq;
#pragma unroll
        for (int ai = 0; ai < 2; ++ai)
#pragma unroll
            for (int m = 0; m < 4; ++m) { if (!((mask >> (ai * 8 + m * 2)) & 3u)) continue; const int R = u.pm * BM + ai * HALF + wr * 64 + m * 16 + fr; float s = 0.f; float* dst = out + (size_t)R * 2048;
#pragma unroll
                for (int bj = 0; bj < 2; ++bj)
#pragma unroll
                    for (int n = 0; n < 2; ++n) { if (!((mask >> (ai * 8 + m * 2 + bj)) & 1u)) continue; const int c = col0 + bj * HALF + n * 16; const f32x4 x2 = *(const f32x4*)(dst + c) + acc[ai][bj][m][n];
                        *(f32x4*)(dst + c) = x2; s += (x2[0] * x2[0] + x2[1] * x2[1]) + (x2[2] * x2[2] + x2[3] * x2[3]); }
                s += __shfl_xor(s, 16); s += __shfl_xor(s, 32);
                if (fq == 0) atomicAdd(ss + R, s); }
    }
};
constexpr int DFF = 5632;
struct EpiUp {
    static constexpr bool PERM = true, AFTER_DRAIN = false;
    const float* ss; const float *cw, *cb; bf16_t* H; float *gfix, *vfix, *gsrc; float *conv_p, *conv_s;
    __device__ __forceinline__ void operator()(const f32x4 (&acc)[2][2][4][2], const Unit& u, int wr, int wc, int fr, int fq) const {
        const int j0 = u.pn * HALF + wc * 32 + 8 * fq;
        const bool samp = u.pm >= 32;
        const bool is15 = fr == 15, ge14 = fr >= 14;
        float rs[2][4];
#pragma unroll
        for (int ai = 0; ai < 2; ++ai)
#pragma unroll
            for (int m = 0; m < 4; ++m) rs[ai][m] = ss[u.pm * BM + ai * HALF + wr * 64 + m * 16 + fr];
        f32x4 w0[2], w1[2], w2[2], b0[2];
#pragma unroll
        for (int h = 0; h < 2; ++h) { w0[h] = *(const f32x4*)(cw + j0 + 4 * h); w1[h] = *(const f32x4*)(cw + DFF + j0 + 4 * h); w2[h] = *(const f32x4*)(cw + 2 * DFF + j0 + 4 * h); b0[h] = *(const f32x4*)(cb + j0 + 4 * h); }
#pragma unroll
        for (int ai = 0; ai < 2; ++ai) {
            f32x4 pp[2] = {(f32x4){0.f, 0.f, 0.f, 0.f}, (f32x4){0.f, 0.f, 0.f, 0.f}};
#pragma unroll
            for (int m = 0; m < 4; ++m) {
                const int rt = ai * HALF + wr * 64 + m * 16 + fr; const int R = u.pm * BM + rt;
                const float rstd = rsqrtf(rs[ai][m] * (1.0f / 2048.0f) + 1e-6f);
                f32x4 g4[2], v4[2], h4[2];
#pragma unroll
                for (int h = 0; h < 2; ++h) {
                    g4[h] = acc[ai][0][m][h] * rstd; v4[h] = acc[ai][1][m][h] * rstd;
                    f32x4 t1, t2, p1, p2;
#pragma unroll
                    for (int e = 0; e < 4; ++e) { t1[e] = is15 ? pp[h][e] : g4[h][e]; t2[e] = ge14 ? pp[h][e] : g4[h][e];
                        p1[e] = __int_as_float(__builtin_amdgcn_update_dpp(0, __float_as_int(t1[e]), 0x121, 0xf, 0xf, false));
                        p2[e] = __int_as_float(__builtin_amdgcn_update_dpp(0, __float_as_int(t2[e]), 0x122, 0xf, 0xf, false)); }
                    const f32x4 gc = b0[h] + p2 * w0[h] + p1 * w1[h] + g4[h] * w2[h];
                    const f32x4 uu = gc * (gc * gc * 0.044715f + 1.0f);
                    const f32x4 ee = uu * (-2.0f * 0.7978845608028654f * 1.4426950408889634f);
                    f32x4 dn;
#pragma unroll
                    for (int e = 0; e < 4; ++e) dn[e] = __builtin_amdgcn_rcpf(1.0f + __builtin_amdgcn_exp2f(ee[e]));
                    h4[h] = gc * dn * v4[h];
                }
                u32x4 w; w.x = cvt_pk_bf16(h4[0][0], h4[0][1]); w.y = cvt_pk_bf16(h4[0][2], h4[0][3]); w.z = cvt_pk_bf16(h4[1][0], h4[1][1]); w.w = cvt_pk_bf16(h4[1][2], h4[1][3]);
                *(u32x4*)(H + (size_t)R * DFF + j0) = w;
                const float gg[8] = {g4[0][0], g4[0][1], g4[0][2], g4[0][3], g4[1][0], g4[1][1], g4[1][2], g4[1][3]};
                const float vv[8] = {v4[0][0], v4[0][1], v4[0][2], v4[0][3], v4[1][0], v4[1][1], v4[1][2], v4[1][3]};
                const f32x4 gA = {gg[0], gg[1], gg[2], gg[3]}, gB = {gg[4], gg[5], gg[6], gg[7]};
                if (fr < 2 && (m == 0 || samp)) {
                    const int id = samp ? 256 + (u.pm - 32) * 32 + (rt >> 4) * 2 + fr : u.pm * 8 + (rt >> 6) * 2 + fr;
                    float* gp = gfix + (size_t)id * DFF + j0; float* vp = vfix + (size_t)id * DFF + j0;
                    *(f32x4*)gp = gA; *(f32x4*)(gp + 4) = gB;
                    *(f32x4*)vp = (f32x4){vv[0], vv[1], vv[2], vv[3]}; *(f32x4*)(vp + 4) = (f32x4){vv[4], vv[5], vv[6], vv[7]};
                }
                if (fr >= 14) {
                    if (samp) { float* cp = conv_s + (size_t)(((R - R_SAMPLE0) >> 4) * 2 + (fr - 14)) * DFF + j0; *(f32x4*)cp = gA; *(f32x4*)(cp + 4) = gB; }
                    else if (m == 3) {
                        float* sp = gsrc + (size_t)(u.pm * 8 + (rt >> 6) * 2 + (fr - 14)) * DFF + j0; *(f32x4*)sp = gA; *(f32x4*)(sp + 4) = gB;
                        if ((R & 4095) >= 4094) { float* cp = conv_p + (size_t)((R >> 12) * 2 + ((R & 4095) - 4094)) * DFF + j0; *(f32x4*)cp = gA; *(f32x4*)(cp + 4) = gB; }
                    }
                }
                pp[0] = g4[0]; pp[1] = g4[1];
            }
        }
    }
};

template <class Epi, class Sched, bool ALIGN_EPI = false, bool SP2 = false, bool STREAMK = false>
__device__ __forceinline__ void gemm_phase(PG8_LAS unsigned char* lds, const Gemm g, const Sched& S, const Epi& E, const SKBuf sk = SKBuf{nullptr, nullptr, 0}) {
    int tid_ = threadIdx.x; asm volatile("" : "+v"(tid_));
    const int tid = tid_, wid = __builtin_amdgcn_readfirstlane(tid >> 6), lane = tid & 63, wr = wid >> 2, wc = wid & 3, fr = lane & 15, fq = lane >> 4;
    unsigned voffA[2], voffB[2];
#pragma unroll
    for (int i = 0; i < 2; ++i) { int R, C; stage_rc(tid * 16 + i * 8192, R, C); const int Rb = Epi::PERM ? ((R & ~31) + perm32(R & 31)) : R;
        voffA[i] = (unsigned)(R * g.lda + C) * 2u; voffB[i] = (unsigned)(Rb * g.ldb + C) * 2u; }
    const size_t kstep = (size_t)(BK * 2);
    const size_t hstepA = (size_t)HALF * g.lda * 2, hstepB = (size_t)HALF * g.ldb * 2;
    const unsigned ldsw = (unsigned)wid * 1024u;
    const int aoff = lds_byte(wr * 64 + fr, fq * 8), boff = lds_byte(wc * 32 + fr, fq * 8);
#define PG8_SA(b, h) (((b) * 2 + (h)) * HTB)
#define PG8_SB(b, h) ((4 + (b) * 2 + (h)) * HTB)
#define PG8_STAGE(bufoff, gbase, voff) do { _Pragma("unroll") for (int _i = 0; _i < 2; ++_i) \
        __builtin_amdgcn_global_load_lds((const unsigned*)((const char*)(gbase) + (voff)[_i]), (PG8_LAS unsigned*)(lds + (bufoff) + ldsw + _i * 8192), 16, 0, 0); } while (0)
#define PG8_LDA(dst, b, h) do { _Pragma("unroll") for (int m = 0; m < 4; ++m) _Pragma("unroll") for (int k = 0; k < 2; ++k) dst[m][k] = *(const PG8_LAS bf16x8*)(lds + PG8_SA(b, h) + aoff + m * 2048 + k * 1024); } while (0)
#define PG8_LDB(dst, b, h) do { _Pragma("unroll") for (int n = 0; n < 2; ++n) _Pragma("unroll") for (int k = 0; k < 2; ++k) dst[n][k] = *(const PG8_LAS bf16x8*)(lds + PG8_SB(b, h) + boff + n * 2048 + k * 1024); } while (0)
#define PG8_MMA(ai, bj, At, Bt) do { __builtin_amdgcn_s_setprio(1); _Pragma("unroll") for (int m = 0; m < 4; ++m) _Pragma("unroll") for (int n = 0; n < 2; ++n) _Pragma("unroll") for (int k = 0; k < 2; ++k) \
        acc[ai][bj][m][n] = __builtin_amdgcn_mfma_f32_16x16x32_bf16(Bt[n][k], At[m][k], acc[ai][bj][m][n], 0, 0, 0); __builtin_amdgcn_s_setprio(0); } while (0)
#define PG8_WAIT_V(n) asm volatile("s_waitcnt vmcnt(" #n ")" ::: "memory")
#define PG8_WAIT_L(n) asm volatile("s_waitcnt lgkmcnt(" #n ")" ::: "memory")
#define PG8_BAR __builtin_amdgcn_s_barrier()
#define PG8_SCHED __builtin_amdgcn_sched_barrier(0)
    Unit cur, nxt; int ui = 0;
    if (!S.next(0, cur)) return;
    f32x4 acc[2][2][4][2];
#pragma unroll
    for (int a = 0; a < 2; ++a)
#pragma unroll
        for (int b = 0; b < 2; ++b)
#pragma unroll
            for (int m = 0; m < 4; ++m)
#pragma unroll
                for (int n = 0; n < 2; ++n) acc[a][b][m][n] = (f32x4){0.f, 0.f, 0.f, 0.f};
    bf16x8 At[4][2], B0[2][2], B1[2][2];
    const char* cA = g.abase(cur); const char* cB = g.bbase(cur);
    S.a_ready(cur);
    if constexpr (SP2) {
        PG8_STAGE(PG8_SB(0, 0), cB, voffB); PG8_STAGE(PG8_SB(0, 1), cB + hstepB, voffB); PG8_STAGE(PG8_SA(0, 0), cA, voffA); PG8_STAGE(PG8_SA(0, 1), cA + hstepA, voffA);
        if (wr == 1) PG8_BAR;
        PG8_WAIT_V(2); PG8_BAR;
        PG8_STAGE(PG8_SB(1, 0), cB + kstep, voffB); PG8_STAGE(PG8_SA(1, 0), cA + kstep, voffA); PG8_STAGE(PG8_SB(1, 1), cB + hstepB + kstep, voffB);
        PG8_WAIT_V(6); PG8_BAR;
    } else {
        PG8_STAGE(PG8_SB(0, 0), cB, voffB); PG8_STAGE(PG8_SA(0, 0), cA, voffA); PG8_STAGE(PG8_SB(0, 1), cB + hstepB, voffB); PG8_STAGE(PG8_SA(0, 1), cA + hstepA, voffA);
        if (wr == 1) PG8_BAR;
        PG8_WAIT_V(4); PG8_BAR;
        PG8_STAGE(PG8_SB(1, 0), cB + kstep, voffB); PG8_STAGE(PG8_SA(1, 0), cA + kstep, voffA); PG8_STAGE(PG8_SB(1, 1), cB + hstepB + kstep, voffB);
        PG8_WAIT_V(6); PG8_BAR;
    }
    for (;;) {
        const bool has_next = S.next(ui + 1, nxt);
        const char* nA = has_next ? g.abase(nxt) : cA; const char* nB = has_next ? g.bbase(nxt) : cB;
        const int nt = cur.nt;
        for (int t = 0; t < nt; t += 2) {
            const bool last = (t == nt - 2);
            const char* a1 = cA + (size_t)(t + 1) * kstep;
            const char* a2 = last ? nA : cA + (size_t)(t + 2) * kstep; const char* b2 = last ? nB : cB + (size_t)(t + 2) * kstep;
            const char* a3 = a2 + kstep; const char* b3 = b2 + kstep;
            if (last && has_next) S.a_ready(nxt);
            if constexpr (SP2) {
            PG8_LDB(B0, 0, 0); PG8_LDB(B1, 0, 1); PG8_SCHED; PG8_LDA(At, 0, 0); PG8_STAGE(PG8_SA(1, 1), a1 + hstepA, voffA);
            PG8_WAIT_V(8); PG8_WAIT_L(0); PG8_BAR; PG8_MMA(0, 0, At, B0); PG8_MMA(0, 1, At, B1); PG8_BAR; PG8_SCHED;
            PG8_LDA(At, 0, 1); PG8_STAGE(PG8_SB(0, 0), b2, voffB); PG8_STAGE(PG8_SB(0, 1), b2 + hstepB, voffB); PG8_STAGE(PG8_SA(0, 0), a2, voffA);
            PG8_WAIT_V(8); PG8_WAIT_L(0); PG8_BAR; PG8_MMA(1, 0, At, B0); PG8_MMA(1, 1, At, B1); PG8_BAR; PG8_SCHED;
            PG8_LDB(B0, 1, 0); PG8_LDB(B1, 1, 1); PG8_SCHED; PG8_LDA(At, 1, 0); PG8_STAGE(PG8_SA(0, 1), a2 + hstepA, voffA);
            PG8_WAIT_V(8); PG8_WAIT_L(0); PG8_BAR; PG8_MMA(0, 0, At, B0); PG8_MMA(0, 1, At, B1); PG8_BAR; PG8_SCHED;
            PG8_LDA(At, 1, 1); PG8_STAGE(PG8_SB(1, 0), b3, voffB); PG8_STAGE(PG8_SB(1, 1), b3 + hstepB, voffB); PG8_STAGE(PG8_SA(1, 0), a3, voffA);
            PG8_WAIT_V(8); PG8_WAIT_L(0); PG8_BAR; PG8_MMA(1, 0, At, B0); PG8_MMA(1, 1, At, B1); PG8_BAR; PG8_SCHED;
            } else {
            PG8_LDB(B0, 0, 0); PG8_SCHED; PG8_LDA(At, 0, 0); PG8_STAGE(PG8_SA(1, 1), a1 + hstepA, voffA);
            PG8_WAIT_L(8); PG8_BAR; PG8_WAIT_L(0); PG8_MMA(0, 0, At, B0); PG8_BAR; PG8_SCHED;
            PG8_LDB(B1, 0, 1); PG8_STAGE(PG8_SB(0, 0), b2, voffB);
            PG8_BAR; PG8_WAIT_L(0); PG8_MMA(0, 1, At, B1); PG8_BAR;
            PG8_LDA(At, 0, 1); PG8_STAGE(PG8_SA(0, 0), a2, voffA);
            PG8_BAR; PG8_WAIT_L(0); PG8_MMA(1, 0, At, B0); PG8_BAR; PG8_SCHED;
            PG8_STAGE(PG8_SB(0, 1), b2 + hstepB, voffB);
            PG8_WAIT_V(6); PG8_BAR; PG8_MMA(1, 1, At, B1); PG8_BAR;
            PG8_LDB(B0, 1, 0); PG8_SCHED; PG8_LDA(At, 1, 0); PG8_STAGE(PG8_SA(0, 1), a2 + hstepA, voffA);
            PG8_WAIT_L(8); PG8_BAR; PG8_WAIT_L(0); PG8_MMA(0, 0, At, B0); PG8_BAR; PG8_SCHED;
            PG8_LDB(B1, 1, 1); PG8_STAGE(PG8_SB(1, 0), b3, voffB);
            PG8_BAR; PG8_WAIT_L(0); PG8_MMA(0, 1, At, B1); PG8_BAR;
            PG8_LDA(At, 1, 1); PG8_STAGE(PG8_SA(1, 0), a3, voffA);
            PG8_BAR; PG8_WAIT_L(0); PG8_MMA(1, 0, At, B0); PG8_BAR; PG8_SCHED;
            PG8_STAGE(PG8_SB(1, 1), b3 + hstepB, voffB);
            PG8_WAIT_V(6); PG8_BAR; PG8_MMA(1, 1, At, B1); PG8_BAR;
            }
        }
        if constexpr (ALIGN_EPI) { if (wr == 0) PG8_BAR; }
        if constexpr (STREAMK) {
            if (cur.kind == 1) {
                __attribute__((address_space(1))) unsigned* p = (__attribute__((address_space(1))) unsigned*)sk.slots + (size_t)sk.v * 32768 + (size_t)tid * 4;
#pragma unroll
                for (int a = 0; a < 2; ++a)
#pragma unroll
                    for (int b = 0; b < 2; ++b)
#pragma unroll
                        for (int m = 0; m < 4; ++m) { const f32x4 v0 = acc[a][b][m][0], v1 = acc[a][b][m][1];
                            u32x4 w; w.x = cvt_pk_bf16(v0[0], v0[1]); w.y = cvt_pk_bf16(v0[2], v0[3]); w.z = cvt_pk_bf16(v1[0], v1[1]); w.w = cvt_pk_bf16(v1[2], v1[3]);
                            *(__attribute__((address_space(1))) u32x4*)p = w; p += 2048; asm volatile("" : "+v"(p)); }
            } else {
                E(acc, cur, wr, wc, fr, fq);
            }
        } else
        if constexpr (!Epi::AFTER_DRAIN) { E(acc, cur, wr, wc, fr, fq); S.done(cur); }
        if (!has_next) break;
#pragma unroll
        for (int a = 0; a < 2; ++a)
#pragma unroll
            for (int b = 0; b < 2; ++b)
#pragma unroll
                for (int m = 0; m < 4; ++m)
#pragma unroll
                    for (int n = 0; n < 2; ++n) acc[a][b][m][n] = (f32x4){0.f, 0.f, 0.f, 0.f};
        cur = nxt; cA = nA; cB = nB; ++ui;
        if constexpr (ALIGN_EPI) { if (wr == 1) PG8_BAR; }
    }
    PG8_WAIT_V(0);
    if constexpr (!ALIGN_EPI) { if (wr == 0) PG8_BAR; }
    PG8_BAR;
    if constexpr (Epi::AFTER_DRAIN) { E.fused(acc, cur, wr, wc, fr, fq, lds, wid, lane); S.done(cur); }
#undef PG8_SA
#undef PG8_SB
#undef PG8_STAGE
#undef PG8_LDA
#undef PG8_LDB
#undef PG8_MMA
#undef PG8_WAIT_V
#undef PG8_WAIT_L
#undef PG8_BAR
#undef PG8_SCHED
}

template <class Epi, class Sched>
__device__ __forceinline__ void gemm_reduce(const Sched& S, const Epi& E, const SKBuf sk) {
    int tid_ = threadIdx.x; asm volatile("" : "+v"(tid_));
    const int tid = tid_, wid = __builtin_amdgcn_readfirstlane(tid >> 6), lane = tid & 63, wr = wid >> 2, wc = wid & 3, fr = lane & 15, fq = lane >> 4;
    Unit ru; unsigned mask; int base;
    if (!S.reducer(ru, mask, base)) return;
    const unsigned* sb = (const unsigned*)sk.slots + (size_t)base * 32768 + (size_t)tid * 4;
    f32x4 racc[2][2][4][2];
#pragma unroll
    for (int a = 0; a < 2; ++a)
#pragma unroll
        for (int b = 0; b < 2; ++b)
#pragma unroll
            for (int m = 0; m < 4; ++m)
#pragma unroll
                for (int n = 0; n < 2; ++n) racc[a][b][m][n] = (f32x4){0.f, 0.f, 0.f, 0.f};
#pragma unroll
    for (int a = 0; a < 2; ++a)
#pragma unroll
        for (int m = 0; m < 4; ++m)
#pragma unroll
            for (int b = 0; b < 2; ++b)
                if ((mask >> (a * 8 + m * 2 + b)) & 1u) {
                    f32x4 r0 = (f32x4){0.f, 0.f, 0.f, 0.f}, r1 = r0; const unsigned* p = sb + (size_t)(((a * 2 + b) * 4 + m) * 2048);
                    for (int s8 = 0; s8 < S.S; s8 += 8) {
                        u32x4 t[8];
#pragma unroll
                        for (int k = 0; k < 8; ++k) t[k] = *(const u32x4*)(p + (size_t)k * 32768);
#pragma unroll
                        for (int k = 0; k < 8; ++k) { r0 += (f32x4){bflo(t[k].x), bfhi(t[k].x), bflo(t[k].y), bfhi(t[k].y)}; r1 += (f32x4){bflo(t[k].z), bfhi(t[k].z), bflo(t[k].w), bfhi(t[k].w)}; }
                        p += 8 * 32768; }
                    racc[a][b][m][0] = r0; racc[a][b][m][1] = r1;
                }
    E(racc, ru, wr, wc, fr, fq, mask);
}
}

#define GAS __attribute__((address_space(1)))
#define LAS __attribute__((address_space(3)))
typedef unsigned short bf16;
typedef unsigned v4u __attribute__((ext_vector_type(4)));
typedef unsigned v2u __attribute__((ext_vector_type(2)));
typedef float f32x4 __attribute__((ext_vector_type(4)));
typedef float f32x16 __attribute__((ext_vector_type(16)));
typedef short bf16x8 __attribute__((ext_vector_type(8)));
constexpr int NWAVES = 8, NTHREADS = 512;
constexpr int DM = 2048, SEQ = 4096, NMETA = 16, DECB = 32, DECL = 16;
constexpr int NG = 64, NS = 64, DFF = 5632;
constexpr int R_SAMPLE0 = 8192, R_REAL = 8704, R_ALL = 8736, R_PAD = 8960;
constexpr float RMS_EPS = 1e-6f;
constexpr int NSEG = 16;
constexpr size_t O_Y = 0, O_SRE_P = 17825792, O_SIM_P = 17833984, O_POOL_P = 17842176, O_CONV_P = 17872896,
                 O_SRE_S = 17895424, O_SIM_S = 18026496, O_POOL_S = 18157568, O_CONV_S = 18649088;
constexpr size_t MiB = 1u << 20;
constexpr int LDP = 2112;
constexpr size_t WS_WIN = 0, WS_WGLU = 9 * MiB, WS_WPOOL = 11 * MiB, WS_WOUT = 12 * MiB, WS_WUP = 21 * MiB, WS_WDOWN = 67 * MiB;
constexpr size_t WS_XN = 89 * MiB, WS_U = 126 * MiB, WS_YPRE = 161 * MiB, WS_MB = 179 * MiB, WS_YCAT = 197 * MiB;
constexpr size_t WS_H = 126 * MiB;
constexpr size_t WS_SMALL = 234 * MiB;
constexpr size_t WS_XMETA = WS_SMALL, WS_SS1 = WS_XMETA + 32 * 2048 * 4, WS_SS2 = WS_SS1 + 36864, WS_LBAR = WS_SS2 + 36864, WS_PW = WS_LBAR + 32768,
                 WS_BB = WS_PW + 32768, WS_CC = WS_BB + 262144, WS_EST = WS_CC + 262144, WS_GMETA = WS_EST + 2 * 64 * 16 * 64 * 8;
constexpr size_t WS_GFIX = 238 * MiB, WS_VFIX = 245 * MiB, WS_GSRC = 252 * MiB, WS_SLOTS = 258 * MiB, WS_FLAGS = 322 * MiB, WS_BAR = 322 * MiB + 65536, WS_FA = 323 * MiB, WS_FB = 0, WS_END = 351 * MiB;
static_assert(WS_GMETA + 4 * DFF * 4 <= WS_GFIX && WS_H + (size_t)R_REAL * DFF * 2 <= WS_YCAT + (size_t)R_PAD * LDP * 2 && WS_YCAT + (size_t)R_PAD * LDP * 2 <= WS_SMALL && 320 * (size_t)DFF * 4 <= 7 * MiB
              && WS_XN + (size_t)R_PAD * LDP * 2 <= WS_U && WS_WUP + (size_t)11264 * LDP * 2 <= WS_WDOWN && WS_WIN + (size_t)2048 * LDP * 2 <= WS_WGLU && WS_WOUT + (size_t)2048 * LDP * 2 <= WS_WUP, "ws map");
constexpr int F_SPLIT = 7168;
constexpr int LDS_BYTES = 147456;
constexpr int S5_WLDS = 32 * 528;

__device__ __forceinline__ unsigned f2bf(float f) { unsigned u = __builtin_bit_cast(unsigned, f); return (u + 0x7fffu + ((u >> 16) & 1u)) >> 16; }
__device__ __forceinline__ unsigned pk2(float lo, float hi) { return f2bf(lo) | (f2bf(hi) << 16); }
__device__ __forceinline__ float blo(unsigned w) { return __uint_as_float(w << 16); }
__device__ __forceinline__ float bhi(unsigned w) { return __uint_as_float(w & 0xffff0000u); }
#define LDS_WAIT() asm volatile("s_waitcnt lgkmcnt(0)" ::: "memory")

#define XB_TMO      128
#define XB_XCNT(j)  (256  + 64 * (j))
#define XB_XSUB(j)  (1280 + 64 * (j))
#define XB_XGEN(j)  (2304 + 64 * (j))
#define XB_TOP      3328
#define XB_TOPGEN   3392
#define XCD_BAR_WORDS 3456
#define XB_SPIN_CAP (1u << 18)

__device__ __forceinline__ unsigned xb_ld(unsigned* p)              { return __hip_atomic_load(p, __ATOMIC_RELAXED, __HIP_MEMORY_SCOPE_AGENT); }
__device__ __forceinline__ unsigned xb_add(unsigned* p, unsigned v) { return __hip_atomic_fetch_add(p, v, __ATOMIC_RELAXED, __HIP_MEMORY_SCOPE_AGENT); }
__device__ __forceinline__ unsigned xb_xcc_id() { return (unsigned)__builtin_amdgcn_s_getreg((3 << 11) | 20) & 0xFu; }
#define XB_SPIN(cond, bar) do { unsigned _sp = 0; while (cond) { __builtin_amdgcn_s_sleep(1); \
    if ((++_sp & 255u) == 0u) { if (xb_ld(&(bar)[XB_TMO])) break; if (_sp > XB_SPIN_CAP) { atomicAdd(&(bar)[XB_TMO], 1u); break; } } } } while (0)

struct XcdBarrier {
    unsigned* bar; unsigned x;
    volatile LAS unsigned* st;
};

__device__ __forceinline__ XcdBarrier xcd_barrier_post(unsigned* bar, volatile LAS unsigned* st) {
    XcdBarrier b; b.bar = bar; b.x = xb_xcc_id(); b.st = st;
    if (threadIdx.x == 0) (void)xb_add(&bar[XB_XCNT(b.x)], 1u);
    return b;
}
__device__ __forceinline__ void xcd_barrier_complete(unsigned* bar, unsigned x, unsigned& nloc, unsigned& nx) {
    const unsigned G = gridDim.x * gridDim.y * gridDim.z;
    unsigned sum, cnt, mine, sp = 0u;
    for (;;) {
        sum = 0u; cnt = 0u; mine = 0u;
#pragma unroll
        for (unsigned j = 0; j < 16; ++j) { const unsigned c = xb_ld(&bar[XB_XCNT(j)]); sum += c; cnt += (c > 0u) ? 1u : 0u; mine = (j == x) ? c : mine; }
        if (sum == G) break;
        __builtin_amdgcn_s_sleep(1);
        if ((++sp & 255u) == 0u) { if (xb_ld(&bar[XB_TMO])) break; if (sp > XB_SPIN_CAP) { atomicAdd(&bar[XB_TMO], 1u); break; } }
    }
    nloc = mine > 0u ? mine : 1u; nx = cnt > 0u ? cnt : 1u;
}

__device__ __forceinline__ void xcd_barrier(const XcdBarrier& b) {
    asm volatile("s_waitcnt vmcnt(0)" ::: "memory");
    __syncthreads();
    if (threadIdx.x == 0) {
        unsigned* bar = b.bar;
        __builtin_amdgcn_s_waitcnt(0);
        unsigned nloc = b.st[0], nx = b.st[1];
        if (nloc == 0u) { xcd_barrier_complete(bar, b.x, nloc, nx); b.st[0] = nloc; b.st[1] = nx; }
        const unsigned old = xb_add(&bar[XB_XSUB(b.x)], 1u);
        const unsigned gen = old / nloc;
        if (old + 1u == (gen + 1u) * nloc) {
            __builtin_amdgcn_fence(__ATOMIC_RELEASE, "agent");
            asm volatile("s_waitcnt vmcnt(0)" ::: "memory");
            const unsigned og = xb_add(&bar[XB_TOP], 1u);
            const unsigned tg = og / nx;
            if (og + 1u == (tg + 1u) * nx) xb_add(&bar[XB_TOPGEN], 1u);
            else XB_SPIN(xb_ld(&bar[XB_TOPGEN]) == tg, bar);
            __builtin_amdgcn_fence(__ATOMIC_ACQUIRE, "agent");
            xb_add(&bar[XB_XGEN(b.x)], 1u);
            asm volatile("s_waitcnt vmcnt(0)" ::: "memory");
        } else {
            XB_SPIN(xb_ld(&bar[XB_XGEN(b.x)]) == gen, bar);
            __builtin_amdgcn_fence(__ATOMIC_ACQUIRE, "agent");
            asm volatile("s_waitcnt vmcnt(0)" ::: "memory");
        }
    }
    __syncthreads();
}

struct Frame {
    LAS unsigned char* lds; int wave, vcu, G;
    float* out; unsigned char* ws;
};
constexpr int BARST_OFF = 143360 + 256;
constexpr int TAB_OFF = 143360;
__device__ __forceinline__ const float* inp(const Frame& F, int i) {
    const LAS unsigned* t = (const LAS unsigned*)(F.lds + TAB_OFF) + 2 * i; const unsigned lo = __builtin_amdgcn_readfirstlane(t[0]), hi = __builtin_amdgcn_readfirstlane(t[1]);
    return (const float*)(const GAS float*)(((unsigned long long)hi << 32) | lo);
}
__device__ __forceinline__ int ltid() { int t = threadIdx.x; asm volatile("" : "+v"(t)); return t; }
__device__ __forceinline__ float wave_sum(float v) {
#pragma unroll
    for (int o = 1; o < 64; o <<= 1) v += __shfl_xor(v, o);
    return v;
}
struct TItem { const float* src; bf16* dst; int K, N; };
__device__ __forceinline__ void p0_item_load(const TItem& t, f32x4 (&buf)[16], int lane) {
    const float* p = t.src + (size_t)(lane >> 4) * t.N + 4 * (lane & 15);
#pragma unroll
    for (int i = 0; i < 16; ++i) buf[i] = __builtin_nontemporal_load((const f32x4*)(p + (size_t)(4 * i) * t.N));
}
__device__ __forceinline__ void p0_item_to_lds(const f32x4 (&buf)[16], LAS float* scr, int lane) {
    LAS float* q = scr + (lane >> 4) * 65 + 4 * (lane & 15);
#pragma unroll
    for (int i = 0; i < 16; ++i) { q[(4 * i) * 65 + 0] = buf[i][0]; q[(4 * i) * 65 + 1] = buf[i][1]; q[(4 * i) * 65 + 2] = buf[i][2]; q[(4 * i) * 65 + 3] = buf[i][3]; }
}
__device__ __forceinline__ void p0_item_store(const TItem& t, LAS float* scr, int lane) {
    const int c = lane & 7;
#pragma unroll
    for (int j = 0; j < 8; ++j) { const int n = (lane >> 3) + 8 * j; const LAS float* sp = scr + (8 * c) * 65 + n;
        v4u o; o.x = pk2(sp[0 * 65], sp[1 * 65]); o.y = pk2(sp[2 * 65], sp[3 * 65]); o.z = pk2(sp[4 * 65], sp[5 * 65]); o.w = pk2(sp[6 * 65], sp[7 * 65]);
        *(v4u*)(t.dst + (size_t)n * t.K + 8 * c) = o; }
}
__device__ __forceinline__ const float* xrow(const Frame& F, int R) {
    return R < R_SAMPLE0 ? inp(F, 0) + (size_t)R * DM : (R < R_REAL ? inp(F, 1) + (size_t)(R - R_SAMPLE0) * DM : inp(F, 6) + (size_t)((R - R_REAL) & 15) * DM);
}

constexpr int I_IN = 32 * 32, I_GLU = 16 * 16, I_POOL = 4 * 4 * 4, I_OUT = 32 * 32, I_UP = 32 * 176, I_DOWN = 88 * 32;
constexpr int I_EARLY = I_IN + I_GLU + I_POOL + I_OUT + I_UP;
__device__ __forceinline__ void p0_decode(const Frame& F, int it, TItem& t) {
    unsigned char* ws = F.ws; int r = it;
    if (r < I_IN) { const int kb = r / 32, nb = r % 32; t.K = LDP; t.N = 2048; t.src = inp(F, 8) + (size_t)(64 * kb) * 2048 + 64 * nb; t.dst = (bf16*)(ws + WS_WIN) + (size_t)(64 * nb) * LDP + 64 * kb; return; } r -= I_IN;
    if (r < I_GLU) { const int kb = r / 16, nb = r % 16; t.K = 1024; t.N = 1024; t.src = inp(F, 17) + (size_t)(64 * kb) * 1024 + 64 * nb; t.dst = (bf16*)(ws + WS_WGLU) + (size_t)(64 * nb) * 1024 + 64 * kb; return; } r -= I_GLU;
    if (r < I_POOL) { const int g = r / 16, q = r % 16, kb = q / 4, nb = q % 4; t.K = 256; t.N = 256; t.src = inp(F, 18) + (size_t)g * 65536 + (size_t)(64 * kb) * 256 + 64 * nb; t.dst = (bf16*)(ws + WS_WPOOL) + (size_t)g * 65536 + (size_t)(64 * nb) * 256 + 64 * kb; return; } r -= I_POOL;
    if (r < I_OUT) { const int kb = r / 32, nb = r % 32; t.K = LDP; t.N = 2048; t.src = inp(F, 20) + (size_t)(64 * kb) * 2048 + 64 * nb; t.dst = (bf16*)(ws + WS_WOUT) + (size_t)(64 * nb) * LDP + 64 * kb; return; } r -= I_OUT;
    if (r < I_UP) { const int kb = r / 176, nb = r % 176, n0 = 64 * nb; const int drow = n0 < DFF ? (n0 / 128) * 256 + (n0 % 128) : ((n0 - DFF) / 128) * 256 + 128 + ((n0 - DFF) % 128);
        t.K = LDP; t.N = 2 * DFF; t.src = inp(F, 22) + (size_t)(64 * kb) * (2 * DFF) + n0; t.dst = (bf16*)(ws + WS_WUP) + (size_t)drow * LDP + 64 * kb; return; } r -= I_UP;
    { const int kb = r / 32, nb = r % 32; t.K = DFF; t.N = 2048; t.src = inp(F, 25) + (size_t)(64 * kb) * 2048 + 64 * nb; t.dst = (bf16*)(ws + WS_WDOWN) + (size_t)(64 * nb) * DFF + 64 * kb; }
}
__device__ __forceinline__ void p0_convert(const Frame& F, int lo, int hi, int w, int nw, int lane) {
    LAS float* scr = (LAS float*)(F.lds + F.wave * 16640);
    f32x4 bufA[16], bufB[16]; TItem ta, tb; int it = lo + w;
    if (it < hi) { p0_decode(F, it, ta); p0_item_load(ta, bufA, lane); }
    while (it < hi) {
        p0_item_to_lds(bufA, scr, lane);
        if (it + nw < hi) { p0_decode(F, it + nw, tb); p0_item_load(tb, bufB, lane); }
        LDS_WAIT(); asm volatile("" ::: "memory");
        p0_item_store(ta, scr, lane);
        LDS_WAIT(); asm volatile("" ::: "memory");
        it += nw; if (it >= hi) break;
        p0_item_to_lds(bufB, scr, lane);
        if (it + nw < hi) { p0_decode(F, it + nw, ta); p0_item_load(ta, bufA, lane); }
        LDS_WAIT(); asm volatile("" ::: "memory");
        p0_item_store(tb, scr, lane);
        LDS_WAIT(); asm volatile("" ::: "memory");
        it += nw;
    }
}
__device__ __forceinline__ void p0_prologue(Frame& F) {
    unsigned char* ws = F.ws; const int tid = ltid(), lane = tid & 63;
    const int gw = F.vcu * NWAVES + F.wave, NGW = F.G * NWAVES;
    p0_convert(F, 0, F.G == 256 ? I_EARLY : I_EARLY + I_DOWN, gw, NGW, lane);
    const float* gm = inp(F, 7);
    {
        f32x4 v[8], vn[8]; int R = gw;
        if (R < R_ALL) { const f32x4* xr = (const f32x4*)xrow(F, R) + lane;
#pragma unroll
            for (int j = 0; j < 8; ++j) v[j] = __builtin_nontemporal_load(xr + 64 * j); }
        while (R < R_ALL) {
            const int Rn = R + NGW;
            if (Rn < R_ALL) { const f32x4* xr = (const f32x4*)xrow(F, Rn) + lane;
#pragma unroll
                for (int j = 0; j < 8; ++j) vn[j] = __builtin_nontemporal_load(xr + 64 * j); }
            float s = 0.f;
#pragma unroll
            for (int j = 0; j < 8; ++j) s += (v[j].x * v[j].x + v[j].y * v[j].y) + (v[j].z * v[j].z + v[j].w * v[j].w);
            const float ms = wave_sum(s) * (1.0f / DM) + RMS_EPS; const float rstd = rsqrtf(ms);
            if (lane == 0) ((float*)(ws + WS_SS2))[R] = sqrtf(ms);
            unsigned long long* o8 = (unsigned long long*)((bf16*)(ws + WS_XN) + (size_t)R * LDP) + lane;
#pragma unroll
            for (int j = 0; j < 8; ++j) { const f32x4 g = ((const f32x4*)gm)[64 * j + lane];
                o8[64 * j] = (unsigned long long)pk2(v[j].x * rstd * g.x, v[j].y * rstd * g.y) | ((unsigned long long)pk2(v[j].z * rstd * g.z, v[j].w * rstd * g.w) << 32); }
#pragma unroll
            for (int j = 0; j < 8; ++j) v[j] = vn[j];
            R = Rn;
        }
    }
    const int gt = F.vcu * NTHREADS + tid, NGT = F.G * NTHREADS;
    for (int i = gt; i < 9216; i += NGT) ((float*)(ws + WS_SS1))[i] = 0.f;
    for (int i = gt; i < 4 * 256; i += NGT) __hip_atomic_store((unsigned*)(ws + WS_FLAGS) + i, 0u, __ATOMIC_RELAXED, __HIP_MEMORY_SCOPE_SYSTEM);
    for (int i2 = gt; i2 < NG * NS * 16; i2 += NGT) {
        const int i = i2 >> 4, n = i2 & 15, g = i >> 6, p = i & 63;
        const float lr = inp(F, 9)[i], li = inp(F, 10)[i], dt = expf(inp(F, 11)[g]);
        const float er = expf(lr * dt); const float sn = sinf(li * dt), cs = cosf(li * dt);
        const float br = er * cs, bi = er * sn;
        if (n == 0) {
            ((float2*)(ws + WS_LBAR))[i] = make_float2(br, bi);
            float pr = br, pi = bi;
#pragma unroll
            for (int k = 0; k < 8; ++k) { const float nr = pr * pr - pi * pi, ni = 2.f * pr * pi; pr = nr; pi = ni; }
            ((float2*)(ws + WS_PW))[i] = make_float2(pr, pi);
        }
        const float nr = br - 1.f, ni = bi, den = 1.f / (lr * lr + li * li);
        const float cr = (nr * lr + ni * li) * den, ci = (ni * lr - nr * li) * den;
        bf16* bb = (bf16*)(ws + WS_BB) + (size_t)g * 128 * 16;
        const float b_r = inp(F, 12)[(size_t)i * 16 + n], b_i = inp(F, 13)[(size_t)i * 16 + n];
        bb[p * 16 + n] = (bf16)f2bf(cr * b_r - ci * b_i); bb[(64 + p) * 16 + n] = (bf16)f2bf(cr * b_i + ci * b_r);
    }
    for (int i = gt; i < NG * 16 * 128; i += NGT) {
        const int k = i & 127, gn = i >> 7;
        ((bf16*)(ws + WS_CC))[i] = (bf16)f2bf(k < 64 ? inp(F, 14)[(size_t)gn * 64 + k] : -inp(F, 15)[(size_t)gn * 64 + (k - 64)]);
    }
}

struct S5Ctx { bf16x8 bb[4]; bf16x8 cc[8]; float lbr, lbi; int g; f32x4 dsk[2]; };
struct S5In { bf16x8 a; v2u us[2]; };
__device__ __forceinline__ void s5_load_ctx(S5Ctx& c, const Frame& F, int g, int lane) {
    const unsigned char* ws = F.ws; c.g = g;
    const bf16* bb = (const bf16*)(ws + WS_BB) + (size_t)g * 2048; const bf16* cc = (const bf16*)(ws + WS_CC) + (size_t)g * 2048;
#pragma unroll
    for (int cb = 0; cb < 4; ++cb) c.bb[cb] = *(const bf16x8*)(bb + (32 * cb + (lane & 31)) * 16 + 8 * (lane >> 5));
#pragma unroll
    for (int kb = 0; kb < 8; ++kb) { bf16x8 z = {0, 0, 0, 0, 0, 0, 0, 0}; if ((lane & 31) < 16) z = *(const bf16x8*)(cc + (lane & 31) * 128 + 16 * kb + 8 * (lane >> 5)); c.cc[kb] = z; }
    const float2 lb = ((const float2*)(ws + WS_LBAR))[g * 64 + lane]; c.lbr = lb.x; c.lbi = lb.y;
    c.dsk[0] = *(const f32x4*)(inp(F, 16) + g * 16 + 4 * (lane >> 5)); c.dsk[1] = *(const f32x4*)(inp(F, 16) + g * 16 + 8 + 4 * (lane >> 5));
}
template <int NV, bool FULL>
__device__ __forceinline__ void s5_fetch(S5In& in, const Frame& F, int g, int row0, int lane) {
    const bf16* U = (const bf16*)(F.ws + WS_U); const int ti = lane & 31, kh = lane >> 5;
    in.a = (bf16x8){0, 0, 0, 0, 0, 0, 0, 0}; in.us[0] = (v2u){0u, 0u}; in.us[1] = (v2u){0u, 0u};
    if (ti < NV) { const bf16* ur = U + (size_t)(row0 + ti) * 2048 + g * 16; in.a = *(const bf16x8*)(ur + 8 * kh);
        if (FULL) { in.us[0] = *(const v2u*)(ur + 4 * kh); in.us[1] = *(const v2u*)(ur + 8 + 4 * kh); } }
}
template <int NV, bool FULL>
__device__ __forceinline__ void s5_block(const S5Ctx& c, const Frame& F, LAS unsigned char* wl, int row0, const S5In& in, float& hr, float& hi, int lane) {
    const int ti = lane & 31, kh = lane >> 5;
    const bf16x8 a = in.a;
    LAS float* L = (LAS float*)wl;
#pragma unroll
    for (int cb = 0; cb < 4; ++cb) {
        f32x16 d = {0.f, 0.f, 0.f, 0.f, 0.f, 0.f, 0.f, 0.f, 0.f, 0.f, 0.f, 0.f, 0.f, 0.f, 0.f, 0.f};
        d = __builtin_amdgcn_mfma_f32_32x32x16_bf16(a, c.bb[cb], d, 0, 0, 0);
#pragma unroll
        for (int r = 0; r < 16; ++r) { const int i = (r & 3) + 8 * (r >> 2) + 4 * kh; if (i < NV) L[i * 132 + 32 * cb + ti] = d[r]; }
    }
    LDS_WAIT(); asm volatile("" ::: "memory");
    float bre[NV], bim[NV];
#pragma unroll
    for (int t = 0; t < NV; ++t) { bre[t] = L[t * 132 + lane]; bim[t] = L[t * 132 + 64 + lane]; }
    LDS_WAIT(); asm volatile("" ::: "memory");
    LAS bf16* Hh = (LAS bf16*)wl;
#pragma unroll
    for (int t = 0; t < NV; ++t) {
        const float nr = c.lbr * hr - c.lbi * hi + bre[t], ni = c.lbr * hi + c.lbi * hr + bim[t]; hr = nr; hi = ni;
        if (FULL) { Hh[t * 264 + lane] = (bf16)f2bf(hr); Hh[t * 264 + 64 + lane] = (bf16)f2bf(hi); }
    }
    if (FULL) {
        LDS_WAIT(); asm volatile("" ::: "memory");
        f32x16 y = {0.f, 0.f, 0.f, 0.f, 0.f, 0.f, 0.f, 0.f, 0.f, 0.f, 0.f, 0.f, 0.f, 0.f, 0.f, 0.f};
#pragma unroll
        for (int kb = 0; kb < 8; ++kb) { const bf16x8 hb = *(const LAS bf16x8*)(wl + ti * 528 + (16 * kb + 8 * kh) * 2); y = __builtin_amdgcn_mfma_f32_32x32x16_bf16(c.cc[kb], hb, y, 0, 0, 0); }
        LDS_WAIT(); asm volatile("" ::: "memory");
        if (ti < NV) {
            bf16* YP = (bf16*)(F.ws + WS_YPRE) + (size_t)(row0 + ti) * 1024 + c.g * 16;
#pragma unroll
            for (int rr = 0; rr < 2; ++rr) { const int n0 = 8 * rr + 4 * kh; const v2u uu = in.us[rr]; const f32x4 dd = c.dsk[rr];
                const float y0 = pg8::gelu_tanh(y[4 * rr + 0] + dd.x * blo(uu.x)), y1 = pg8::gelu_tanh(y[4 * rr + 1] + dd.y * bhi(uu.x)),
                            y2 = pg8::gelu_tanh(y[4 * rr + 2] + dd.z * blo(uu.y)), y3 = pg8::gelu_tanh(y[4 * rr + 3] + dd.w * bhi(uu.y));
                v2u o; o.x = pk2(y0, y1); o.y = pk2(y2, y3); *(v2u*)(YP + n0) = o; }
        }
    }
}
template <bool FULL>
__device__ __forceinline__ void s5_prompt_item(const Frame& F, LAS unsigned char* wl, int item, int lane) {
    const int seg = item & (NSEG - 1), g = (item >> 4) & 63, b = item >> 10;
    float2* est = (float2*)(F.ws + WS_EST) + ((size_t)(b * 64 + g) * NSEG) * 64;
    if (!FULL && seg == NSEG - 1) return;
    S5Ctx c; s5_load_ctx(c, F, g, lane);
    float hr = 0.f, hi = 0.f;
    if (FULL) { const float2 pw = ((const float2*)(F.ws + WS_PW))[g * 64 + lane];
        float2 ev[NSEG - 1];
#pragma unroll
        for (int s = 0; s < NSEG - 1; ++s) { ev[s] = make_float2(0.f, 0.f); if (s < seg) ev[s] = est[s * 64 + lane]; }
#pragma unroll
        for (int s = 0; s < NSEG - 1; ++s) if (s < seg) { const float nr = pw.x * hr - pw.y * hi + ev[s].x, ni = pw.x * hi + pw.y * hr + ev[s].y; hr = nr; hi = ni; } }
    S5In cur, nxt, nx2;
    const int rbase = SEQ * b + 32 * (8 * seg);
    if (seg == 0) { s5_fetch<16, FULL>(cur, F, g, R_REAL + 16 * b, lane); s5_fetch<32, FULL>(nxt, F, g, rbase, lane); s5_fetch<32, FULL>(nx2, F, g, rbase + 32, lane);
        s5_block<16, FULL>(c, F, wl, R_REAL + 16 * b, cur, hr, hi, lane); cur = nxt; nxt = nx2; }
    else { s5_fetch<32, FULL>(cur, F, g, rbase, lane); s5_fetch<32, FULL>(nxt, F, g, rbase + 32, lane); }
    for (int j = 0; j < 8; ++j) {
        const int row0 = rbase + 32 * j;
        if (j < 6) s5_fetch<32, FULL>(nx2, F, g, row0 + 64, lane);
        s5_block<32, FULL>(c, F, wl, row0, cur, hr, hi, lane); cur = nxt; nxt = nx2; }
    if (!FULL) est[seg * 64 + lane] = make_float2(hr, hi);
    else if (seg == NSEG - 1) { F.out[O_SRE_P + (size_t)(b * 64 + g) * 64 + lane] = hr; F.out[O_SIM_P + (size_t)(b * 64 + g) * 64 + lane] = hi; }
}
__device__ __forceinline__ void s5_sample_item(const Frame& F, LAS unsigned char* wl, int item, int lane) {
    const int g = item & 63, s = item >> 6;
    S5Ctx c; s5_load_ctx(c, F, g, lane);
    float hr = inp(F, 2)[(size_t)(s * 64 + g) * 64 + lane], hi = inp(F, 3)[(size_t)(s * 64 + g) * 64 + lane];
    S5In cur; s5_fetch<16, true>(cur, F, g, R_SAMPLE0 + 16 * s, lane);
    s5_block<16, true>(c, F, wl, R_SAMPLE0 + 16 * s, cur, hr, hi, lane);
    F.out[O_SRE_S + (size_t)(s * 64 + g) * 64 + lane] = hr; F.out[O_SIM_S + (size_t)(s * 64 + g) * 64 + lane] = hi;
}

__device__ __forceinline__ void pool_m_phase(const Frame& F) {
    const bf16* U = (const bf16*)(F.ws + WS_U); bf16* MB = (bf16*)(F.ws + WS_MB); const int tid = ltid();
    const int sub = tid >> 7, t128 = tid & 127, c0 = 8 * t128, w = 2 << (c0 >> 8);
    for (int run = F.vcu * 4 + sub; run < 546; run += F.G * 4) {
        const bool samp = run >= 514; int rowbase, pos0; const float* hist = nullptr; int b = 0;
        if (samp) { const int sq = run - 514; rowbase = R_SAMPLE0 + 16 * sq; pos0 = 0; hist = inp(F, 4) + (size_t)sq * 15 * 1024 + c0; }
        else { b = run / 257; const int j = run % 257; pos0 = 16 * j; rowbase = j == 0 ? R_REAL + 16 * b : SEQ * b + 16 * (j - 1); }
        v4u zr[31];
#pragma unroll
        for (int i = 0; i < 31; ++i) {
            const int rel = i - 15; v4u q = {0u, 0u, 0u, 0u};
            if (rel >= 0) q = *(const v4u*)(U + (size_t)(rowbase + rel) * 2048 + 1024 + c0);
            else if (samp) { const f32x4 a = *(const f32x4*)(hist + (size_t)(15 + rel) * 1024), b2 = *(const f32x4*)(hist + (size_t)(15 + rel) * 1024 + 4); q.x = pk2(a.x, a.y); q.y = pk2(a.z, a.w); q.z = pk2(b2.x, b2.y); q.w = pk2(b2.z, b2.w); }
            else { const int pos = pos0 + rel; if (pos >= 0) { const int row = pos < 16 ? R_REAL + 16 * b + pos : SEQ * b + (pos - 16); q = *(const v4u*)(U + (size_t)row * 2048 + 1024 + c0); } }
            zr[i] = q;
        }
        float s[8];
#pragma unroll
        for (int e = 0; e < 8; ++e) s[e] = 0.f;
#pragma unroll
        for (int jj = 1; jj < 16; ++jj) { const v4u q = zr[15 - jj]; const float f = jj < w ? 1.f : 0.f;
            s[0] += f * blo(q.x); s[1] += f * bhi(q.x); s[2] += f * blo(q.y); s[3] += f * bhi(q.y); s[4] += f * blo(q.z); s[5] += f * bhi(q.z); s[6] += f * blo(q.w); s[7] += f * bhi(q.w); }
#pragma unroll
        for (int t = 0; t < 16; ++t) {
            const v4u q = zr[15 + t]; const float z[8] = {blo(q.x), bhi(q.x), blo(q.y), bhi(q.y), blo(q.z), bhi(q.z), blo(q.w), bhi(q.w)};
            const int pos = pos0 + t; const float inv = 1.0f / (float)((samp || pos + 1 >= w) ? w : pos + 1);
            float mo[8];
#pragma unroll
            for (int e = 0; e < 8; ++e) { s[e] += z[e]; mo[e] = s[e] * inv - z[e]; }
            v4u o; o.x = pk2(mo[0], mo[1]); o.y = pk2(mo[2], mo[3]); o.z = pk2(mo[4], mo[5]); o.w = pk2(mo[6], mo[7]);
            *(v4u*)(MB + (size_t)(rowbase + t) * 1024 + c0) = o;
            const v4u q2 = zr[15 + t - 1], q4 = zr[15 + t - 3], q8 = zr[15 + t - 7], q16 = zr[15 + t - 15];
            v4u ql; ql.x = w == 2 ? q2.x : (w == 4 ? q4.x : (w == 8 ? q8.x : q16.x)); ql.y = w == 2 ? q2.y : (w == 4 ? q4.y : (w == 8 ? q8.y : q16.y));
            ql.z = w == 2 ? q2.z : (w == 4 ? q4.z : (w == 8 ? q8.z : q16.z)); ql.w = w == 2 ? q2.w : (w == 4 ? q4.w : (w == 8 ? q8.w : q16.w));
            s[0] -= blo(ql.x); s[1] -= bhi(ql.x); s[2] -= blo(ql.y); s[3] -= bhi(ql.y); s[4] -= blo(ql.z); s[5] -= bhi(ql.z); s[6] -= blo(ql.w); s[7] -= bhi(ql.w);
        }
    }
    const int gt = F.vcu * NTHREADS + tid, NGT = F.G * NTHREADS;
    for (int i = gt; i < (2 + 32) * 15 * 256; i += NGT) {
        const int c4 = (i & 255) * 4, q = i >> 8, r = q % 15, sq = q / 15;
        const int row = sq < 2 ? SEQ * sq + 4081 + r : R_SAMPLE0 + 16 * (sq - 2) + 1 + r;
        const v2u uu = *(const v2u*)(U + (size_t)row * 2048 + 1024 + c4);
        float* dst = sq < 2 ? F.out + O_POOL_P + (size_t)(sq * 15 + r) * 1024 + c4 : F.out + O_POOL_S + (size_t)((sq - 2) * 15 + r) * 1024 + c4;
        *(f32x4*)dst = (f32x4){blo(uu.x), bhi(uu.x), blo(uu.y), bhi(uu.y)};
    }
}

__device__ __forceinline__ void gmeta_phase(const Frame& F) {
    const bf16* XN = (const bf16*)(F.ws + WS_XN); const bf16* WU = (const bf16*)(F.ws + WS_WUP); const float* ss = (const float*)(F.ws + WS_SS1); float* GM = (float*)(F.ws + WS_GMETA);
    const int gw = F.vcu * NWAVES + F.wave, NGW = F.G * NWAVES; const int lane = ltid() & 63;
    for (int jb = gw; jb < DFF; jb += 3 * NGW) {
        v4u xv[4][4], wv[3][4];
#pragma unroll
        for (int i = 0; i < 4; ++i) { const int c = 8 * lane + 512 * i;
#pragma unroll
            for (int q = 0; q < 4; ++q) xv[q][i] = *(const v4u*)(XN + (size_t)(R_REAL + 16 * (q >> 1) + 14 + (q & 1)) * LDP + c);
#pragma unroll
            for (int t = 0; t < 3; ++t) { const int j = jb + t * NGW; wv[t][i] = (v4u){0u, 0u, 0u, 0u}; if (j < DFF) wv[t][i] = *(const v4u*)(WU + (size_t)((j >> 7) * 256 + (j & 127)) * LDP + c); } }
#pragma unroll
        for (int t = 0; t < 3; ++t) { const int j = jb + t * NGW;
            float a[4] = {0.f, 0.f, 0.f, 0.f};
#pragma unroll
            for (int i = 0; i < 4; ++i) { const v4u w = wv[t][i]; const float wf[8] = {blo(w.x), bhi(w.x), blo(w.y), bhi(w.y), blo(w.z), bhi(w.z), blo(w.w), bhi(w.w)};
#pragma unroll
                for (int q = 0; q < 4; ++q) { const v4u x = xv[q][i];
                    a[q] += wf[0] * blo(x.x) + wf[1] * bhi(x.x) + wf[2] * blo(x.y) + wf[3] * bhi(x.y) + wf[4] * blo(x.z) + wf[5] * bhi(x.z) + wf[6] * blo(x.w) + wf[7] * bhi(x.w); } }
#pragma unroll
            for (int q = 0; q < 4; ++q) a[q] = wave_sum(a[q]);
            if (lane < 4 && j < DFF) { const int q = lane; const int Rm = R_REAL + 16 * (q >> 1) + 14 + (q & 1); const float v = q == 0 ? a[0] : (q == 1 ? a[1] : (q == 2 ? a[2] : a[3]));
                GM[(size_t)q * DFF + j] = v * rsqrtf(ss[Rm] * (1.0f / DM) + RMS_EPS); }
        }
    }
}

__device__ __forceinline__ void fixup_phase(const Frame& F) {
    const float* GF = (const float*)(F.ws + WS_GFIX); const float* VF = (const float*)(F.ws + WS_VFIX); const float* GS = (const float*)(F.ws + WS_GSRC); const float* GM = (const float*)(F.ws + WS_GMETA);
    const float* cw = inp(F, 23); const float* cb = inp(F, 24); const float* hist = inp(F, 5); bf16* H = (bf16*)(F.ws + WS_H);
    const int tid = ltid(); const int gt = F.vcu * NTHREADS + tid, NGT = F.G * NTHREADS;
    for (int idx = gt; idx < 320 * 1408; idx += NGT) {
        const int id = idx / 1408, j = (idx % 1408) * 4;
        const f32x4 g0 = *(const f32x4*)(GF + (size_t)id * DFF + j), v0 = *(const f32x4*)(VF + (size_t)id * DFF + j);
        f32x4 p1, p2; int R;
        if (id < 256) {
            const int pm = id >> 3, blk = (id & 7) >> 1, rr = id & 1; R = 256 * pm + 64 * blk + rr;
            const bool start = blk == 0 && (pm == 0 || pm == 16);
            const float* S0; const float* S1;
            if (start) { const int b = pm >> 4; S0 = GM + (size_t)(b * 2 + 0) * DFF; S1 = GM + (size_t)(b * 2 + 1) * DFF; }
            else { const int sb = blk > 0 ? pm * 8 + (blk - 1) * 2 : (pm - 1) * 8 + 6; S0 = GS + (size_t)sb * DFF; S1 = GS + (size_t)(sb + 1) * DFF; }
            if (rr == 0) { p1 = *(const f32x4*)(S1 + j); p2 = *(const f32x4*)(S0 + j); }
            else { p1 = *(const f32x4*)(GF + (size_t)(id - 1) * DFF + j); p2 = *(const f32x4*)(S1 + j); }
        } else {
            const int q = id - 256, sq = q >> 1, rr = q & 1; R = R_SAMPLE0 + 16 * sq + rr;
            const float* h0 = hist + (size_t)(sq * 2 + 0) * DFF; const float* h1 = hist + (size_t)(sq * 2 + 1) * DFF;
            if (rr == 0) { p1 = *(const f32x4*)(h1 + j); p2 = *(const f32x4*)(h0 + j); }
            else { p1 = *(const f32x4*)(GF + (size_t)(id - 1) * DFF + j); p2 = *(const f32x4*)(h1 + j); }
        }
        const f32x4 w0 = *(const f32x4*)(cw + j), w1 = *(const f32x4*)(cw + DFF + j), w2 = *(const f32x4*)(cw + 2 * DFF + j), bb = *(const f32x4*)(cb + j);
        const f32x4 gc = bb + p2 * w0 + p1 * w1 + g0 * w2;
        v2u o; o.x = pk2(pg8::gelu_tanh(gc.x) * v0.x, pg8::gelu_tanh(gc.y) * v0.y); o.y = pk2(pg8::gelu_tanh(gc.z) * v0.z, pg8::gelu_tanh(gc.w) * v0.w);
        *(v2u*)(H + (size_t)R * DFF + j) = o;
    }
}
__device__ __forceinline__ void final_phase(const Frame& F) {
    const float* gf = inp(F, 26); const float* gn = inp(F, 21); const bf16* XNb = (const bf16*)(F.ws + WS_XN);
    const bf16* FA = (const bf16*)(F.ws + WS_FA); const bf16* FBb = (const bf16*)(F.ws + WS_FB);
    const int gw = F.vcu * NWAVES + F.wave, NGW = F.G * NWAVES; const int lane = ltid() & 63;
    f32x4 rg[8];
#pragma unroll
    for (int j = 0; j < 8; ++j) { const f32x4 g = ((const f32x4*)gn)[64 * j + lane]; rg[j] = (f32x4){1.0f / g.x, 1.0f / g.y, 1.0f / g.z, 1.0f / g.w}; }
    v2u xb[8], xbn[8], xb2[8], fb[8], fbn[8], fb2[8]; int R = gw;
    auto fetch = [&](int Rr, v2u (&x)[8], v2u (&f)[8]) {
        if (Rr < R_REAL) { const v2u* xr = (const v2u*)(XNb + (size_t)Rr * LDP) + lane; const v2u* fr_ = (const v2u*)((Rr < F_SPLIT ? FA + (size_t)Rr * DM : FBb + (size_t)(Rr - F_SPLIT) * DM)) + lane;
#pragma unroll
            for (int j = 0; j < 8; ++j) { x[j] = xr[64 * j]; f[j] = fr_[64 * j]; } } };
    fetch(R, xb, fb); fetch(R + NGW, xbn, fbn);
    while (R < R_REAL) {
        fetch(R + 2 * NGW, xb2, fb2);
        f32x4 v[8]; float s = 0.f;
#pragma unroll
        for (int j = 0; j < 8; ++j) { v[j].x = blo(xb[j].x) * rg[j].x + blo(fb[j].x); v[j].y = bhi(xb[j].x) * rg[j].y + bhi(fb[j].x); v[j].z = blo(xb[j].y) * rg[j].z + blo(fb[j].y); v[j].w = bhi(xb[j].y) * rg[j].w + bhi(fb[j].y);
            s += (v[j].x * v[j].x + v[j].y * v[j].y) + (v[j].z * v[j].z + v[j].w * v[j].w); }
        const float rstd = rsqrtf(wave_sum(s) * (1.0f / DM) + RMS_EPS);
        f32x4* xo = (f32x4*)(F.out + (size_t)R * DM) + lane;
#pragma unroll
        for (int j = 0; j < 8; ++j) { const f32x4 g = ((const f32x4*)gf)[64 * j + lane]; __builtin_nontemporal_store(v[j] * rstd * g, xo + 64 * j); }
#pragma unroll
        for (int j = 0; j < 8; ++j) { xb[j] = xbn[j]; fb[j] = fbn[j]; xbn[j] = xb2[j]; fbn[j] = fb2[j]; }
        R += NGW;
    }
}

struct Args { const float* in[27]; float* out; unsigned char* ws; };
#ifndef PROBE
#define PROBE 0
#endif
__global__ void __launch_bounds__(NTHREADS, 2) hymba_fwd(Args args) {
    extern __shared__ __attribute__((aligned(16))) unsigned char lds[];
    cg::grid_group grid = cg::this_grid();
    Frame F;
    F.lds = (LAS unsigned char*)lds;
    F.wave = __builtin_amdgcn_readfirstlane((int)threadIdx.x >> 6);
    F.G = gridDim.x; { const int bx = blockIdx.x; F.vcu = (F.G % 8 == 0) ? (bx % 8) * (F.G / 8) + bx / 8 : bx; }
    if (threadIdx.x == 0) {
#pragma unroll
        for (int i = 0; i < 27; ++i) ((LAS unsigned long long*)(F.lds + TAB_OFF))[i] = (unsigned long long)args.in[i];
        ((LAS unsigned*)(F.lds + BARST_OFF))[0] = 0u; ((LAS unsigned*)(F.lds + BARST_OFF))[1] = 0u; ((LAS unsigned*)(F.lds + BARST_OFF + 64))[0] = 0u;
    }
    __syncthreads();
    const XcdBarrier bar = xcd_barrier_post((unsigned*)(args.ws + WS_BAR), (volatile LAS unsigned*)(F.lds + BARST_OFF));
#ifndef TPROBE_A
#define TPROBE_A -1
#define TPROBE_B -1
#endif
    int stamp_i_ = 0;
#define STAMP() do { if (TPROBE_A >= 0 && blockIdx.x == 0 && threadIdx.x == 0) ((volatile LAS unsigned long long*)(F.lds + BARST_OFF + 128))[stamp_i_] = __builtin_amdgcn_s_memrealtime(); ++stamp_i_; } while (0)
#define GRID_BAR() do { xcd_barrier(bar); STAMP(); } while (0)
    STAMP();
    F.out = (float*)(GAS float*)args.out; F.ws = (unsigned char*)(GAS unsigned char*)args.ws;
    unsigned char* ws = F.ws;
    bf16* XN = (bf16*)(ws + WS_XN); bf16* U = (bf16*)(ws + WS_U); bf16* YPRE = (bf16*)(ws + WS_YPRE); bf16* MB = (bf16*)(ws + WS_MB); bf16* YCAT = (bf16*)(ws + WS_YCAT); bf16* H = (bf16*)(ws + WS_H);
    float* SS1 = (float*)(ws + WS_SS1); float* SS2 = (float*)(ws + WS_SS2);
    const int gw = F.vcu * NWAVES + F.wave, NGW = F.G * NWAVES;
    LAS unsigned char* wl = F.lds + F.wave * S5_WLDS;

    auto forward_ = [&]() __attribute__((always_inline)) {
    p0_prologue(F);
    if (PROBE == 1) { __syncthreads(); p0_prologue(F); }
    if (args.ws == nullptr) grid.sync();
    GRID_BAR();
    { pg8::Gemm g{XN, (const bf16*)(ws + WS_WIN), LDP, LDP, 2048, 0}; pg8::RemSplit S; S.init(35, 8, 16, 8, F.G, (int)blockIdx.x);
      pg8::EpiBf16 E{U, 2048}; const pg8::SKBuf sk{(float*)(ws + WS_SLOTS), (unsigned*)(ws + WS_FLAGS), (int)blockIdx.x};
      pg8::gemm_phase<pg8::EpiBf16, pg8::RemSplit, true, true, true>(F.lds, g, S, E, sk); GRID_BAR(); pg8::gemm_reduce(S, E, sk);
      if (PROBE == 4) { GRID_BAR(); pg8::gemm_phase<pg8::EpiBf16, pg8::RemSplit, true, true, true>(F.lds, g, S, E, sk); GRID_BAR(); pg8::gemm_reduce(S, E, sk); } }
    GRID_BAR();
    pool_m_phase(F);
    for (int it = gw; it < 2 * 64 * NSEG; it += NGW) s5_prompt_item<false>(F, wl, it, ltid() & 63);
    for (int it = gw; it < DECB * 64; it += NGW) s5_sample_item(F, wl, it, ltid() & 63);
    if (PROBE == 2) { __syncthreads();
        for (int it = gw; it < 2 * 64 * NSEG; it += NGW) s5_prompt_item<false>(F, wl, it, ltid() & 63);
        for (int it = gw; it < DECB * 64; it += NGW) s5_sample_item(F, wl, it, ltid() & 63);
        pool_m_phase(F); }
    GRID_BAR();
    for (int it = gw; it < 2 * 64 * NSEG; it += NGW) s5_prompt_item<true>(F, wl, it, ltid() & 63);
    if (PROBE == 2) { for (int it = gw; it < 2 * 64 * NSEG; it += NGW) s5_prompt_item<true>(F, wl, it, ltid() & 63); }
    GRID_BAR();
    if (F.G > 140 + 35) {
        if ((int)blockIdx.x < 140) { pg8::Gemm g{YPRE, (const bf16*)(ws + WS_WGLU), 1024, 1024, 1024, 0}; pg8::StaticOrder S; S.init(35, 4, 16, 140, (int)blockIdx.x);
            pg8::EpiGlu E{YPRE, YCAT}; pg8::gemm_phase<pg8::EpiGlu, pg8::StaticOrder, true, true>(F.lds, g, S, E); }
        else { pg8::Gemm g{MB, (const bf16*)(ws + WS_WPOOL), 1024, 256, 256, 256}; pg8::StaticOrder S; S.init(35, 4, 4, F.G - 140, (int)blockIdx.x - 140);
            pg8::EpiPool E{YCAT, inp(F, 19)}; pg8::gemm_phase<pg8::EpiPool, pg8::StaticOrder, true, true>(F.lds, g, S, E); }
    } else {
        { pg8::Gemm g{MB, (const bf16*)(ws + WS_WPOOL), 1024, 256, 256, 256}; pg8::StaticOrder S; S.init(35, 4, 4, F.G, (int)blockIdx.x);
          pg8::EpiPool E{YCAT, inp(F, 19)}; pg8::gemm_phase<pg8::EpiPool, pg8::StaticOrder, true, true>(F.lds, g, S, E); }
        __syncthreads();
        { pg8::Gemm g{YPRE, (const bf16*)(ws + WS_WGLU), 1024, 1024, 1024, 0}; pg8::StaticOrder S; S.init(35, 4, 16, F.G, (int)blockIdx.x);
          pg8::EpiGlu E{YPRE, YCAT}; pg8::gemm_phase<pg8::EpiGlu, pg8::StaticOrder, true, true>(F.lds, g, S, E); }
    }
    GRID_BAR();
    if (PROBE == 12) { GRID_BAR();
        if ((int)blockIdx.x < 140) { pg8::Gemm g{YPRE, (const bf16*)(ws + WS_WGLU), 1024, 1024, 1024, 0}; pg8::StaticOrder S; S.init(35, 4, 16, 140, (int)blockIdx.x);
            pg8::EpiGlu E{YPRE, YCAT}; pg8::gemm_phase<pg8::EpiGlu, pg8::StaticOrder, true, true>(F.lds, g, S, E); }
        else { pg8::Gemm g{MB, (const bf16*)(ws + WS_WPOOL), 1024, 256, 256, 256}; pg8::StaticOrder S; S.init(35, 4, 4, F.G - 140, (int)blockIdx.x - 140);
            pg8::EpiPool E{YCAT, inp(F, 19)}; pg8::gemm_phase<pg8::EpiPool, pg8::StaticOrder, true, true>(F.lds, g, S, E); } }
    { pg8::Gemm g{YCAT, (const bf16*)(ws + WS_WOUT), LDP, LDP, 2048, 0}; pg8::RemSplit S; S.init(35, 8, 16, 8, F.G, (int)blockIdx.x);
      pg8::EpiOut E{SS2, inp(F, 7), inp(F, 21), XN, SS1};
      const pg8::SKBuf sk{(float*)(ws + WS_SLOTS), (unsigned*)(ws + WS_FLAGS) + 512, (int)blockIdx.x};
      pg8::gemm_phase<pg8::EpiOut, pg8::RemSplit, true, true, true>(F.lds, g, S, E, sk); GRID_BAR(); pg8::gemm_reduce(S, E, sk);
      if (PROBE == 11) { GRID_BAR(); for (int i = F.vcu * NTHREADS + ltid(); i < 9216; i += F.G * NTHREADS) SS1[i] = 0.f; GRID_BAR();
          pg8::gemm_phase<pg8::EpiOut, pg8::RemSplit, true, true, true>(F.lds, g, S, E, sk); GRID_BAR(); pg8::gemm_reduce(S, E, sk); } }
    GRID_BAR();
    gmeta_phase(F);
    { pg8::Gemm g{XN, (const bf16*)(ws + WS_WUP), LDP, LDP, 2048, 0}; pg8::StaticOrder S; S.init(34, 44, 32, F.G, (int)blockIdx.x);
      pg8::EpiUp E{SS1, inp(F, 23), inp(F, 24), H, (float*)(ws + WS_GFIX), (float*)(ws + WS_VFIX), (float*)(ws + WS_GSRC), F.out + O_CONV_P, F.out + O_CONV_S};
      pg8::gemm_phase<pg8::EpiUp, pg8::StaticOrder, true, true>(F.lds, g, S, E);
      if (PROBE == 3) { __syncthreads(); pg8::gemm_phase<pg8::EpiUp, pg8::StaticOrder, true, true>(F.lds, g, S, E); }
      if (PROBE == 13) { __syncthreads(); pg8::EpiBf16 E2{(bf16*)(ws + WS_FA), 0}; pg8::gemm_phase<pg8::EpiBf16, pg8::StaticOrder, true, true>(F.lds, g, S, E2); } }
    if (F.G == 256 && (int)blockIdx.x >= 216) { __syncthreads(); p0_convert(F, I_EARLY, I_EARLY + I_DOWN, ((int)blockIdx.x - 216) * NWAVES + F.wave, 40 * NWAVES, ltid() & 63); }
    GRID_BAR();
    fixup_phase(F);
    GRID_BAR();
    { pg8::Gemm g{H, (const bf16*)(ws + WS_WDOWN), DFF, DFF, DFF, 0}; pg8::RemSplit S; S.init(34, 8, 44, 16, F.G, (int)blockIdx.x);
      pg8::EpiF E{(bf16*)(ws + WS_FA), (bf16*)(ws + WS_FB), F_SPLIT};
      const pg8::SKBuf sk{(float*)(ws + WS_SLOTS), (unsigned*)(ws + WS_FLAGS) + 768, (int)blockIdx.x};
      pg8::gemm_phase<pg8::EpiF, pg8::RemSplit, true, true, true>(F.lds, g, S, E, sk); GRID_BAR(); pg8::gemm_reduce(S, E, sk); }
    GRID_BAR();
    if (PROBE == 9) { GRID_BAR(); pg8::Gemm g{H, (const bf16*)(ws + WS_WDOWN), DFF, DFF, DFF, 0}; pg8::RemSplit S; S.init(34, 8, 44, 16, F.G, (int)blockIdx.x);
        const pg8::SKBuf sk{(float*)(ws + WS_SLOTS), (unsigned*)(ws + WS_FLAGS) + 768, (int)blockIdx.x}; pg8::EpiBf16 E{XN, 2048};
        pg8::gemm_phase<pg8::EpiBf16, pg8::RemSplit, true, true, true>(F.lds, g, S, E, sk); GRID_BAR(); pg8::gemm_reduce(S, E, sk); }
    if (PROBE == 10) { GRID_BAR(); const int gw2 = F.vcu * NWAVES + F.wave, lane2 = ltid() & 63;
        for (int R = gw2; R < R_REAL; R += F.G * NWAVES) { f32x4* xr = (f32x4*)(F.out + (size_t)R * DM) + lane2;
#pragma unroll
            for (int j = 0; j < 8; ++j) { f32x4 v = xr[64 * j]; asm volatile("" : "+v"(v)); xr[64 * j] = v; } } }
    if (PROBE == 6) { pg8::Gemm g{H, (const bf16*)(ws + WS_WDOWN), DFF, DFF, DFF, 0}; pg8::StaticOrder S; S.init(34, 8, 88, F.G, (int)blockIdx.x);
        pg8::EpiBf16 E{XN, 2048}; pg8::gemm_phase<pg8::EpiBf16, pg8::StaticOrder, true, true>(F.lds, g, S, E); }
    if (PROBE == 7) { GRID_BAR(); GRID_BAR(); GRID_BAR(); GRID_BAR(); GRID_BAR(); GRID_BAR(); GRID_BAR(); GRID_BAR(); }
    final_phase(F);
    if (TPROBE_A >= 0) { asm volatile("s_waitcnt vmcnt(0)" ::: "memory"); __syncthreads(); STAMP();
        if (blockIdx.x == 0 && threadIdx.x == 0) { volatile LAS unsigned long long* ts = (volatile LAS unsigned long long*)(F.lds + BARST_OFF + 128);
            const unsigned long long d = ts[TPROBE_B] - ts[TPROBE_A], t0 = __builtin_amdgcn_s_memrealtime();
            while (__builtin_amdgcn_s_memrealtime() - t0 < d) __builtin_amdgcn_s_sleep(8); } }
    };
    forward_();
    if (PROBE == 8) { GRID_BAR(); forward_(); }
}

extern "C" void kernel_launch(void* const* d_in, const int* in_sizes, int n_in, void* d_out, int out_size, void* d_ws, size_t ws_size, hipStream_t stream) {
    static int grid = 0;
    if (grid == 0) {
        if (n_in != 27 || out_size != 19009536 || ws_size < WS_END) { fprintf(stderr, "kernel_launch: unexpected shapes (n_in %d, out %d, ws %zu)\n", n_in, out_size, ws_size); grid = -1; return; }
        int dev = 0, cus = 0, per_cu = 0;
        if (hipGetDevice(&dev) != hipSuccess || hipDeviceGetAttribute(&cus, hipDeviceAttributeMultiprocessorCount, dev) != hipSuccess) { grid = -1; return; }
        if (hipFuncSetAttribute((const void*)hymba_fwd, hipFuncAttributeMaxDynamicSharedMemorySize, LDS_BYTES) != hipSuccess) { fprintf(stderr, "kernel_launch: hipFuncSetAttribute failed\n"); grid = -1; return; }
        if (hipOccupancyMaxActiveBlocksPerMultiprocessor(&per_cu, (const void*)hymba_fwd, NTHREADS, LDS_BYTES) != hipSuccess || per_cu < 1) { fprintf(stderr, "kernel_launch: occupancy query says %d\n", per_cu); per_cu = 1; }
        (void)hipGetLastError();
        grid = cus;
    }
    if (grid < 0) return;
    if (hipMemsetAsync((char*)d_ws + WS_BAR, 0, XCD_BAR_WORDS * 4, stream) != hipSuccess) { fprintf(stderr, "kernel_launch: memset of barrier words failed\n"); return; }
    Args a{};
    for (int i = 0; i < 27; ++i) a.in[i] = (const float*)d_in[i];
    a.out = (float*)d_out; a.ws = (unsigned char*)d_ws;
    void* kargs[] = {&a};
    hipError_t e = hipLaunchCooperativeKernel((const void*)hymba_fwd, dim3(grid), dim3(NTHREADS), kargs, LDS_BYTES, stream);
    if (e != hipSuccess) fprintf(stderr, "kernel_launch: cooperative launch failed: %s (grid %d)\n", hipGetErrorString(e), grid);
}
```

```cpp
#include <hip/hip_runtime.h>
#include <hip/hip_cooperative_groups.h>
#include <cstdio>
#include <cstdint>
namespace cg = cooperative_groups;

namespace pg8 {
#define PG8_LAS __attribute__((address_space(3)))
typedef unsigned short bf16_t;
typedef short bf16x8 __attribute__((ext_vector_type(8)));
typedef float f32x4 __attribute__((ext_vector_type(4)));
typedef float f32x2 __attribute__((ext_vector_type(2)));
typedef unsigned u32x4 __attribute__((ext_vector_type(4)));
typedef unsigned u32x2 __attribute__((ext_vector_type(2)));
constexpr int BM = 256, BK = 64, HALF = 128, HTB = HALF * BK * 2  , STAGE_BYTES = 8 * HTB, NXCD = 8, WGM = 8;

__host__ __device__ __forceinline__ int lds_byte(int r, int c) { const int st = (r >> 4) * 2 + (c >> 5), rr = r & 15, cc = c & 31, ob = rr * 64 + cc * 2; return st * 1024 + (ob ^ (((ob >> 9) & 1) << 5)); }
__host__ __device__ __forceinline__ void stage_rc(int b, int& R, int& C) { const int st = b / 1024, sb = b % 1024, swz = sb ^ (((sb >> 9) & 1) << 5); R = (st >> 1) * 16 + swz / 64; C = (st & 1) * 32 + (swz % 64) / 2; }
__host__ __device__ __forceinline__ int perm32(int rho) { const int n = rho >> 4, i = rho & 15; return 8 * (i >> 2) + 4 * n + (i & 3); }

struct Unit { int pm, pn, k0, nt, kind, nwait; };
struct Gemm {
    const bf16_t* A; const bf16_t* Bt; int lda, ldb, K, a_pn_off;
    __device__ __forceinline__ const char* abase(const Unit& u) const { return (const char*)(A + ((size_t)u.pm * BM * lda + (size_t)u.pn * a_pn_off + (size_t)u.k0 * BK)); }
    __device__ __forceinline__ const char* bbase(const Unit& u) const { return (const char*)(Bt + ((size_t)u.pn * BM * ldb + (size_t)u.k0 * BK)); }
};

struct StaticOrder {
    int nM, nN, nwg, G, c, ntile;
    __host__ __device__ void init(int nM_, int nN_, int ntile_, int G_, int c_) { nM = nM_; nN = nN_; nwg = nM * nN; ntile = ntile_; G = G_; c = c_; }
    __host__ __device__ bool next(int i, Unit& u) const { const long L = (long)i * G + c; if (L >= nwg) return false; map((int)L, u); return true; }
    __host__ __device__ bool map(int L, Unit& u) const {
        int wgid = L; { const int q = nwg / NXCD, r = nwg % NXCD, xcd = wgid % NXCD, off = wgid / NXCD; wgid = (xcd < r ? xcd * (q + 1) : r * (q + 1) + (xcd - r) * q) + off; }
        const int nig = WGM * nN, gid = wgid / nig, fm = gid * WGM, gsz = (nM - fm) < WGM ? (nM - fm) : WGM;
        u.pm = fm + ((wgid % nig) % gsz); u.pn = (wgid % nig) / gsz; u.k0 = 0; u.nt = ntile; u.kind = 0; u.nwait = 0; return true;
    }
    __device__ __forceinline__ void a_ready(const Unit&) const {}
    __device__ __forceinline__ void done(const Unit&) const {}
};

struct RemSplit {
    StaticOrder so; int q, R, S, P, c;
    __device__ void init(int nM_, int nN_, int P_, int S_, int G_, int c_) { so.init(nM_, nN_, 2 * P_, G_, c_); q = so.nwg / G_; R = so.nwg % G_; S = S_; P = P_; c = c_; }
    __device__ bool next(int i, Unit& u) const {
        if (c < R * S) { if (i == 0) { so.map(q * so.G + c / S, u); const int sl = c % S, lo = sl * P / S, hi = (sl + 1) * P / S; u.k0 = 2 * lo; u.nt = 2 * (hi - lo); u.kind = 1; return true; } i -= 1; }
        if (i >= q) return false; so.map(i * so.G + c, u); return true;
    }
    __device__ bool reducer(Unit& u, unsigned& mask, int& base) const {
        if (c >= R * S) return false; so.map(q * so.G + c / S, u); base = (c / S) * S; const int j = c % S;
        mask = S == 16 ? 1u << ((j >> 3) * 8 + ((j >> 1) & 3) * 2 + (j & 1)) : 3u << ((j >> 2) * 8 + (j & 3) * 2); return true;
    }
    __device__ __forceinline__ void a_ready(const Unit&) const {}
    __device__ __forceinline__ void done(const Unit&) const {}
};
struct SKBuf { float* slots; unsigned* flags; int v; };

__device__ __forceinline__ unsigned cvt_pk_bf16(float lo, float hi) { unsigned r; asm volatile("v_cvt_pk_bf16_f32 %0, %1, %2" : "=v"(r) : "v"(lo), "v"(hi)); return r; }
__device__ __forceinline__ float bflo(unsigned w) { return __uint_as_float(w << 16); }
__device__ __forceinline__ float bfhi(unsigned w) { return __uint_as_float(w & 0xffff0000u); }
__device__ __forceinline__ float gelu_tanh(float x) {
    const float u = x * (1.0f + 0.044715f * x * x);
    const float e = __builtin_amdgcn_exp2f(u * (-2.0f * 0.7978845608028654f * 1.4426950408889634f));
    return x * __builtin_amdgcn_rcpf(1.0f + e);
}
__device__ __forceinline__ float sigmoidf_(float x) { return __builtin_amdgcn_rcpf(1.0f + __builtin_amdgcn_exp2f(x * -1.4426950408889634f)); }

struct EpiBf16 {
    static constexpr bool PERM = true, AFTER_DRAIN = false;
    bf16_t* O; int ldc;
    __device__ __forceinline__ void operator()(const f32x4 (&acc)[2][2][4][2], const Unit& u, int wr, int wc, int fr, int fq, unsigned mask = 0xFFFFu) const {
        const int row0 = u.pm * BM + wr * 64 + fr; const int col0 = u.pn * BM + wc * 32 + 8 * fq;
#pragma unroll
        for (int ai = 0; ai < 2; ++ai)
#pragma unroll
            for (int m = 0; m < 4; ++m) { bf16_t* rowp = O + (size_t)(row0 + ai * HALF + m * 16) * ldc + col0;
#pragma unroll
                for (int bj = 0; bj < 2; ++bj) { if (!((mask >> (ai * 8 + m * 2 + bj)) & 1u)) continue; const f32x4 v0 = acc[ai][bj][m][0], v1 = acc[ai][bj][m][1];
                    u32x4 w; w.x = cvt_pk_bf16(v0[0], v0[1]); w.y = cvt_pk_bf16(v0[2], v0[3]); w.z = cvt_pk_bf16(v1[0], v1[1]); w.w = cvt_pk_bf16(v1[2], v1[3]);
                    *(u32x4*)(rowp + bj * HALF) = w; } }
    }
};
struct EpiF {
    static constexpr bool PERM = true, AFTER_DRAIN = false;
    bf16_t* Oa; bf16_t* Ob; int split;
    __device__ __forceinline__ void operator()(const f32x4 (&acc)[2][2][4][2], const Unit& u, int wr, int wc, int fr, int fq, unsigned mask = 0xFFFFu) const {
        const int rowt = u.pm * BM; bf16_t* base = rowt < split ? Oa + (size_t)rowt * 2048 : Ob + (size_t)(rowt - split) * 2048;
        const int row0 = wr * 64 + fr; const int col0 = u.pn * BM + wc * 32 + 8 * fq;
#pragma unroll
        for (int ai = 0; ai < 2; ++ai)
#pragma unroll
            for (int m = 0; m < 4; ++m) { bf16_t* rowp = base + (size_t)(row0 + ai * HALF + m * 16) * 2048 + col0;
#pragma unroll
                for (int bj = 0; bj < 2; ++bj) { if (!((mask >> (ai * 8 + m * 2 + bj)) & 1u)) continue; const f32x4 v0 = acc[ai][bj][m][0], v1 = acc[ai][bj][m][1];
                    u32x4 w; w.x = cvt_pk_bf16(v0[0], v0[1]); w.y = cvt_pk_bf16(v0[2], v0[3]); w.z = cvt_pk_bf16(v1[0], v1[1]); w.w = cvt_pk_bf16(v1[2], v1[3]);
                    *(u32x4*)(rowp + bj * HALF) = w; } }
    }
};
struct EpiPool {
    static constexpr bool PERM = true, AFTER_DRAIN = false;
    bf16_t* O; const float* scale;
    __device__ __forceinline__ void operator()(const f32x4 (&acc)[2][2][4][2], const Unit& u, int wr, int wc, int fr, int fq) const {
        const int row0 = u.pm * BM + wr * 64 + fr; const int c0 = u.pn * BM + wc * 32 + 8 * fq;
        f32x4 sv[2][2];
#pragma unroll
        for (int bj = 0; bj < 2; ++bj)
#pragma unroll
            for (int n = 0; n < 2; ++n) sv[bj][n] = *(const f32x4*)(scale + c0 + bj * HALF + 4 * n);
#pragma unroll
        for (int ai = 0; ai < 2; ++ai)
#pragma unroll
            for (int m = 0; m < 4; ++m) { bf16_t* rowp = O + (size_t)(row0 + ai * HALF + m * 16) * 2112 + 1024 + c0;
#pragma unroll
                for (int bj = 0; bj < 2; ++bj) { const f32x4 v0 = acc[ai][bj][m][0] * sv[bj][0], v1 = acc[ai][bj][m][1] * sv[bj][1];
                    u32x4 w; w.x = cvt_pk_bf16(v0[0], v0[1]); w.y = cvt_pk_bf16(v0[2], v0[3]); w.z = cvt_pk_bf16(v1[0], v1[1]); w.w = cvt_pk_bf16(v1[2], v1[3]);
                    *(u32x4*)(rowp + bj * HALF) = w; } }
    }
};
struct EpiGlu {
    static constexpr bool PERM = true, AFTER_DRAIN = false;
    const bf16_t* YP; bf16_t* O;
    __device__ __forceinline__ void operator()(const f32x4 (&acc)[2][2][4][2], const Unit& u, int wr, int wc, int fr, int fq) const {
        const int row0 = u.pm * BM + wr * 64 + fr; const int c0 = u.pn * BM + wc * 32 + 8 * fq;
        u32x4 yp[2][4][2];
#pragma unroll
        for (int ai = 0; ai < 2; ++ai)
#pragma unroll
            for (int m = 0; m < 4; ++m)
#pragma unroll
                for (int bj = 0; bj < 2; ++bj) yp[ai][m][bj] = *(const u32x4*)(YP + (size_t)(row0 + ai * HALF + m * 16) * 1024 + c0 + bj * HALF);
#pragma unroll
        for (int ai = 0; ai < 2; ++ai)
#pragma unroll
            for (int m = 0; m < 4; ++m) { const size_t R = (size_t)(row0 + ai * HALF + m * 16);
#pragma unroll
                for (int bj = 0; bj < 2; ++bj) { const u32x4 y = yp[ai][m][bj];
                    const f32x4 a = acc[ai][bj][m][0], b = acc[ai][bj][m][1];
                    u32x4 w;
                    w.x = cvt_pk_bf16(bflo(y.x) * sigmoidf_(a[0]), bfhi(y.x) * sigmoidf_(a[1]));
                    w.y = cvt_pk_bf16(bflo(y.y) * sigmoidf_(a[2]), bfhi(y.y) * sigmoidf_(a[3]));
                    w.z = cvt_pk_bf16(bflo(y.z) * sigmoidf_(b[0]), bfhi(y.z) * sigmoidf_(b[1]));
                    w.w = cvt_pk_bf16(bflo(y.w) * sigmoidf_(b[2]), bfhi(y.w) * sigmoidf_(b[3]));
                    *(u32x4*)(O + R * 2112 + c0 + bj * HALF) = w; } }
    }
};
constexpr int R_SAMPLE0 = 8192, R_REAL = 8704, R_ALL = 8736, R_PAD = 8960;
constexpr int LDP = 2112;
struct EpiOut {
    static constexpr bool PERM = false, AFTER_DRAIN = false;
    const float *irs0, *gmix, *gffn; bf16_t* XN; float* ss;
    __device__ __forceinline__ void operator()(const f32x4 (&acc)[2][2][4][2], const Unit& u, int wr, int wc, int fr, int fq, unsigned mask = 0xFFFFu) const {
        const int col0 = u.pn * BM + wc * 32 + 4 * fq;
        f32x4 gv[2][2], rm[2][2];
#pragma unroll
        for (int bj = 0; bj < 2; ++bj)
#pragma unroll
            for (int n = 0; n < 2; ++n) { gv[bj][n] = *(const f32x4*)(gffn + col0 + bj * HALF + n * 16); const f32x4 g = *(const f32x4*)(gmix + col0 + bj * HALF + n * 16); rm[bj][n] = (f32x4){1.0f / g[0], 1.0f / g[1], 1.0f / g[2], 1.0f / g[3]}; }
#pragma unroll
        for (int ai = 0; ai < 2; ++ai)
#pragma unroll
            for (int m = 0; m < 4; ++m) { if (!((mask >> (ai * 8 + m * 2)) & 3u)) continue; const int R = u.pm * BM + ai * HALF + wr * 64 + m * 16 + fr; float s = 0.f;
                if (R < R_ALL) {
                    const float ir = irs0[R];
                    bf16_t* xn = XN + (size_t)R * LDP;
#pragma unroll
                    for (int bj = 0; bj < 2; ++bj)
#pragma unroll
                        for (int n = 0; n < 2; ++n) { if (!((mask >> (ai * 8 + m * 2 + bj)) & 1u)) continue; const int c = col0 + bj * HALF + n * 16; const u32x2 xq = *(const u32x2*)(xn + c);
                            const f32x4 x1 = (f32x4){bflo(xq.x), bfhi(xq.x), bflo(xq.y), bfhi(xq.y)} * rm[bj][n] * ir + acc[ai][bj][m][n];
                            s += (x1[0] * x1[0] + x1[1] * x1[1]) + (x1[2] * x1[2] + x1[3] * x1[3]);
                            const f32x4 xg = x1 * gv[bj][n]; u32x2 w; w.x = cvt_pk_bf16(xg[0], xg[1]); w.y = cvt_pk_bf16(xg[2], xg[3]); *(u32x2*)(xn + c) = w; }
                }
                s += __shfl_xor(s, 16); s += __shfl_xor(s, 32);
                if (fq == 0 && R < R_ALL) atomicAdd(ss + R, s); }
    }
};
struct EpiDown {
    static constexpr bool PERM = false, AFTER_DRAIN = false;
    float* out; float* ss;
    __device__ __forceinline__ void operator()(const f32x4 (&acc)[2][2][4][2], const Unit& u, int wr, int wc, int fr, int fq, unsigned mask = 0xFFFFu) const {
        const int col0 = u.pn * BM + wc * 32 + 4 * fq;
#pragma unroll
        for (int ai = 0; ai < 2; ++ai)
#pragma unroll
            for (int m = 0; m < 4; ++m) { if (!((mask >> (ai * 8 + m * 2)) & 3u)) continue; const int R = u.pm * BM + ai * HALF + wr * 64 + m * 16 + fr; float s = 0.f; float* dst = out + (size_t)R * 2048;
#pragma unroll
                for (int bj = 0; bj < 2; ++bj)
#pragma unroll
                    for (int n = 0; n < 2; ++n) { if (!((mask >> (ai * 8 + m * 2 + bj)) & 1u)) continue; const int c = col0 + bj * HALF + n * 16; const f32x4 x2 = *(const f32x4*)(dst + c) + acc[ai][bj][m][n];
                        *(f32x4*)(dst + c) = x2; s += (x2[0] * x2[0] + x2[1] * x2[1]) + (x2[2] * x2[2] + x2[3] * x2[3]); }
                s += __shfl_xor(s, 16); s += __shfl_xor(s, 32);
                if (fq == 0) atomicAdd(ss + R, s); }
    }
};
constexpr int DFF = 5632;
struct EpiUp {
    static constexpr bool PERM = true, AFTER_DRAIN = false;
    const float* ss; const float *cw, *cb; bf16_t* H; float *gfix, *vfix, *gsrc; float *conv_p, *conv_s;
    __device__ __forceinline__ void operator()(const f32x4 (&acc)[2][2][4][2], const Unit& u, int wr, int wc, int fr, int fq) const {
        const int j0 = u.pn * HALF + wc * 32 + 8 * fq;
        const bool samp = u.pm >= 32;
        const bool is15 = fr == 15, ge14 = fr >= 14;
        float rs[2][4];
#pragma unroll
        for (int ai = 0; ai < 2; ++ai)
#pragma unroll
            for (int m = 0; m < 4; ++m) rs[ai][m] = ss[u.pm * BM + ai * HALF + wr * 64 + m * 16 + fr];
        f32x4 w0[2], w1[2], w2[2], b0[2];
#pragma unroll
        for (int h = 0; h < 2; ++h) { w0[h] = *(const f32x4*)(cw + j0 + 4 * h); w1[h] = *(const f32x4*)(cw + DFF + j0 + 4 * h); w2[h] = *(const f32x4*)(cw + 2 * DFF + j0 + 4 * h); b0[h] = *(const f32x4*)(cb + j0 + 4 * h); }
#pragma unroll
        for (int ai = 0; ai < 2; ++ai) {
            f32x4 pp[2] = {(f32x4){0.f, 0.f, 0.f, 0.f}, (f32x4){0.f, 0.f, 0.f, 0.f}};
#pragma unroll
            for (int m = 0; m < 4; ++m) {
                const int rt = ai * HALF + wr * 64 + m * 16 + fr; const int R = u.pm * BM + rt;
                const float rstd = rsqrtf(rs[ai][m] * (1.0f / 2048.0f) + 1e-6f);
                f32x4 g4[2], v4[2], h4[2];
#pragma unroll
                for (int h = 0; h < 2; ++h) {
                    g4[h] = acc[ai][0][m][h] * rstd; v4[h] = acc[ai][1][m][h] * rstd;
                    f32x4 t1, t2, p1, p2;
#pragma unroll
                    for (int e = 0; e < 4; ++e) { t1[e] = is15 ? pp[h][e] : g4[h][e]; t2[e] = ge14 ? pp[h][e] : g4[h][e];
                        p1[e] = __int_as_float(__builtin_amdgcn_update_dpp(0, __float_as_int(t1[e]), 0x121, 0xf, 0xf, false));
                        p2[e] = __int_as_float(__builtin_amdgcn_update_dpp(0, __float_as_int(t2[e]), 0x122, 0xf, 0xf, false)); }
                    const f32x4 gc = b0[h] + p2 * w0[h] + p1 * w1[h] + g4[h] * w2[h];
                    const f32x4 uu = gc * (gc * gc * 0.044715f + 1.0f);
                    const f32x4 ee = uu * (-2.0f * 0.7978845608028654f * 1.4426950408889634f);
                    f32x4 dn;
#pragma unroll
                    for (int e = 0; e < 4; ++e) dn[e] = __builtin_amdgcn_rcpf(1.0f + __builtin_amdgcn_exp2f(ee[e]));
                    h4[h] = gc * dn * v4[h];
                }
                u32x4 w; w.x = cvt_pk_bf16(h4[0][0], h4[0][1]); w.y = cvt_pk_bf16(h4[0][2], h4[0][3]); w.z = cvt_pk_bf16(h4[1][0], h4[1][1]); w.w = cvt_pk_bf16(h4[1][2], h4[1][3]);
                *(u32x4*)(H + (size_t)R * DFF + j0) = w;
                const float gg[8] = {g4[0][0], g4[0][1], g4[0][2], g4[0][3], g4[1][0], g4[1][1], g4[1][2], g4[1][3]};
                const float vv[8] = {v4[0][0], v4[0][1], v4[0][2], v4[0][3], v4[1][0], v4[1][1], v4[1][2], v4[1][3]};
                const f32x4 gA = {gg[0], gg[1], gg[2], gg[3]}, gB = {gg[4], gg[5], gg[6], gg[7]};
                if (fr < 2 && (m == 0 || samp)) {
                    const int id = samp ? 256 + (u.pm - 32) * 32 + (rt >> 4) * 2 + fr : u.pm * 8 + (rt >> 6) * 2 + fr;
                    float* gp = gfix + (size_t)id * DFF + j0; float* vp = vfix + (size_t)id * DFF + j0;
                    *(f32x4*)gp = gA; *(f32x4*)(gp + 4) = gB;
                    *(f32x4*)vp = (f32x4){vv[0], vv[1], vv[2], vv[3]}; *(f32x4*)(vp + 4) = (f32x4){vv[4], vv[5], vv[6], vv[7]};
                }
                if (fr >= 14) {
                    if (samp) { float* cp = conv_s + (size_t)(((R - R_SAMPLE0) >> 4) * 2 + (fr - 14)) * DFF + j0; *(f32x4*)cp = gA; *(f32x4*)(cp + 4) = gB; }
                    else if (m == 3) {
                        float* sp = gsrc + (size_t)(u.pm * 8 + (rt >> 6) * 2 + (fr - 14)) * DFF + j0; *(f32x4*)sp = gA; *(f32x4*)(sp + 4) = gB;
                        if ((R & 4095) >= 4094) { float* cp = conv_p + (size_t)((R >> 12) * 2 + ((R & 4095) - 4094)) * DFF + j0; *(f32x4*)cp = gA; *(f32x4*)(cp + 4) = gB; }
                    }
                }
                pp[0] = g4[0]; pp[1] = g4[1];
            }
        }
    }
};

template <class Epi, class Sched, bool ALIGN_EPI = false, bool SP2 = false, bool STREAMK = false>
__device__ __forceinline__ void gemm_phase(PG8_LAS unsigned char* lds, const Gemm g, const Sched& S, const Epi& E, const SKBuf sk = SKBuf{nullptr, nullptr, 0}) {
    int tid_ = threadIdx.x; asm volatile("" : "+v"(tid_));
    const int tid = tid_, wid = __builtin_amdgcn_readfirstlane(tid >> 6), lane = tid & 63, wr = wid >> 2, wc = wid & 3, fr = lane & 15, fq = lane >> 4;
    unsigned voffA[2], voffB[2];
#pragma unroll
    for (int i = 0; i < 2; ++i) { int R, C; stage_rc(tid * 16 + i * 8192, R, C); const int Rb = Epi::PERM ? ((R & ~31) + perm32(R & 31)) : R;
        voffA[i] = (unsigned)(R * g.lda + C) * 2u; voffB[i] = (unsigned)(Rb * g.ldb + C) * 2u; }
    const size_t kstep = (size_t)(BK * 2);
    const size_t hstepA = (size_t)HALF * g.lda * 2, hstepB = (size_t)HALF * g.ldb * 2;
    const unsigned ldsw = (unsigned)wid * 1024u;
    const int aoff = lds_byte(wr * 64 + fr, fq * 8), boff = lds_byte(wc * 32 + fr, fq * 8);
#define PG8_SA(b, h) (((b) * 2 + (h)) * HTB)
#define PG8_SB(b, h) ((4 + (b) * 2 + (h)) * HTB)
#define PG8_STAGE(bufoff, gbase, voff) do { _Pragma("unroll") for (int _i = 0; _i < 2; ++_i) \
        __builtin_amdgcn_global_load_lds((const unsigned*)((const char*)(gbase) + (voff)[_i]), (PG8_LAS unsigned*)(lds + (bufoff) + ldsw + _i * 8192), 16, 0, 0); } while (0)
#define PG8_LDA(dst, b, h) do { _Pragma("unroll") for (int m = 0; m < 4; ++m) _Pragma("unroll") for (int k = 0; k < 2; ++k) dst[m][k] = *(const PG8_LAS bf16x8*)(lds + PG8_SA(b, h) + aoff + m * 2048 + k * 1024); } while (0)
#define PG8_LDB(dst, b, h) do { _Pragma("unroll") for (int n = 0; n < 2; ++n) _Pragma("unroll") for (int k = 0; k < 2; ++k) dst[n][k] = *(const PG8_LAS bf16x8*)(lds + PG8_SB(b, h) + boff + n * 2048 + k * 1024); } while (0)
#define PG8_MMA(ai, bj, At, Bt) do { __builtin_amdgcn_s_setprio(1); _Pragma("unroll") for (int m = 0; m < 4; ++m) _Pragma("unroll") for (int n = 0; n < 2; ++n) _Pragma("unroll") for (int k = 0; k < 2; ++k) \
        acc[ai][bj][m][n] = __builtin_amdgcn_mfma_f32_16x16x32_bf16(Bt[n][k], At[m][k], acc[ai][bj][m][n], 0, 0, 0); __builtin_amdgcn_s_setprio(0); } while (0)
#define PG8_WAIT_V(n) asm volatile("s_waitcnt vmcnt(" #n ")" ::: "memory")
#define PG8_WAIT_L(n) asm volatile("s_waitcnt lgkmcnt(" #n ")" ::: "memory")
#define PG8_BAR __builtin_amdgcn_s_barrier()
#define PG8_SCHED __builtin_amdgcn_sched_barrier(0)
    Unit cur, nxt; int ui = 0;
    if (!S.next(0, cur)) return;
    f32x4 acc[2][2][4][2];
#pragma unroll
    for (int a = 0; a < 2; ++a)
#pragma unroll
        for (int b = 0; b < 2; ++b)
#pragma unroll
            for (int m = 0; m < 4; ++m)
#pragma unroll
                for (int n = 0; n < 2; ++n) acc[a][b][m][n] = (f32x4){0.f, 0.f, 0.f, 0.f};
    bf16x8 At[4][2], B0[2][2], B1[2][2];
    const char* cA = g.abase(cur); const char* cB = g.bbase(cur);
    S.a_ready(cur);
    if constexpr (SP2) {
        PG8_STAGE(PG8_SB(0, 0), cB, voffB); PG8_STAGE(PG8_SB(0, 1), cB + hstepB, voffB); PG8_STAGE(PG8_SA(0, 0), cA, voffA); PG8_STAGE(PG8_SA(0, 1), cA + hstepA, voffA);
        if (wr == 1) PG8_BAR;
        PG8_WAIT_V(2); PG8_BAR;
        PG8_STAGE(PG8_SB(1, 0), cB + kstep, voffB); PG8_STAGE(PG8_SA(1, 0), cA + kstep, voffA); PG8_STAGE(PG8_SB(1, 1), cB + hstepB + kstep, voffB);
        PG8_WAIT_V(6); PG8_BAR;
    } else {
        PG8_STAGE(PG8_SB(0, 0), cB, voffB); PG8_STAGE(PG8_SA(0, 0), cA, voffA); PG8_STAGE(PG8_SB(0, 1), cB + hstepB, voffB); PG8_STAGE(PG8_SA(0, 1), cA + hstepA, voffA);
        if (wr == 1) PG8_BAR;
        PG8_WAIT_V(4); PG8_BAR;
        PG8_STAGE(PG8_SB(1, 0), cB + kstep, voffB); PG8_STAGE(PG8_SA(1, 0), cA + kstep, voffA); PG8_STAGE(PG8_SB(1, 1), cB + hstepB + kstep, voffB);
        PG8_WAIT_V(6); PG8_BAR;
    }
    for (;;) {
        const bool has_next = S.next(ui + 1, nxt);
        const char* nA = has_next ? g.abase(nxt) : cA; const char* nB = has_next ? g.bbase(nxt) : cB;
        const int nt = cur.nt;
        for (int t = 0; t < nt; t += 2) {
            const bool last = (t == nt - 2);
            const char* a1 = cA + (size_t)(t + 1) * kstep;
            const char* a2 = last ? nA : cA + (size_t)(t + 2) * kstep; const char* b2 = last ? nB : cB + (size_t)(t + 2) * kstep;
            const char* a3 = a2 + kstep; const char* b3 = b2 + kstep;
            if (last && has_next) S.a_ready(nxt);
            if constexpr (SP2) {
            PG8_LDB(B0, 0, 0); PG8_LDB(B1, 0, 1); PG8_SCHED; PG8_LDA(At, 0, 0); PG8_STAGE(PG8_SA(1, 1), a1 + hstepA, voffA);
            PG8_WAIT_V(8); PG8_WAIT_L(0); PG8_BAR; PG8_MMA(0, 0, At, B0); PG8_MMA(0, 1, At, B1); PG8_BAR; PG8_SCHED;
            PG8_LDA(At, 0, 1); PG8_STAGE(PG8_SB(0, 0), b2, voffB); PG8_STAGE(PG8_SB(0, 1), b2 + hstepB, voffB); PG8_STAGE(PG8_SA(0, 0), a2, voffA);
            PG8_WAIT_V(8); PG8_WAIT_L(0); PG8_BAR; PG8_MMA(1, 0, At, B0); PG8_MMA(1, 1, At, B1); PG8_BAR; PG8_SCHED;
            PG8_LDB(B0, 1, 0); PG8_LDB(B1, 1, 1); PG8_SCHED; PG8_LDA(At, 1, 0); PG8_STAGE(PG8_SA(0, 1), a2 + hstepA, voffA);
            PG8_WAIT_V(8); PG8_WAIT_L(0); PG8_BAR; PG8_MMA(0, 0, At, B0); PG8_MMA(0, 1, At, B1); PG8_BAR; PG8_SCHED;
            PG8_LDA(At, 1, 1); PG8_STAGE(PG8_SB(1, 0), b3, voffB); PG8_STAGE(PG8_SB(1, 1), b3 + hstepB, voffB); PG8_STAGE(PG8_SA(1, 0), a3, voffA);
            PG8_WAIT_V(8); PG8_WAIT_L(0); PG8_BAR; PG8_MMA(1, 0, At, B0); PG8_MMA(1, 1, At, B1); PG8_BAR; PG8_SCHED;
            } else {
            PG8_LDB(B0, 0, 0); PG8_SCHED; PG8_LDA(At, 0, 0); PG8_STAGE(PG8_SA(1, 1), a1 + hstepA, voffA);
            PG8_WAIT_L(8); PG8_BAR; PG8_WAIT_L(0); PG8_MMA(0, 0, At, B0); PG8_BAR; PG8_SCHED;
            PG8_LDB(B1, 0, 1); PG8_STAGE(PG8_SB(0, 0), b2, voffB);
            PG8_BAR; PG8_WAIT_L(0); PG8_MMA(0, 1, At, B1); PG8_BAR;
            PG8_LDA(At, 0, 1); PG8_STAGE(PG8_SA(0, 0), a2, voffA);
            PG8_BAR; PG8_WAIT_L(0); PG8_MMA(1, 0, At, B0); PG8_BAR; PG8_SCHED;
            PG8_STAGE(PG8_SB(0, 1), b2 + hstepB, voffB);
            PG8_WAIT_V(6); PG8_BAR; PG8_MMA(1, 1, At, B1); PG8_BAR;
            PG8_LDB(B0, 1, 0); PG8_SCHED; PG8_LDA(At, 1, 0); PG8_STAGE(PG8_SA(0, 1), a2 + hstepA, voffA);
            PG8_WAIT_L(8); PG8_BAR; PG8_WAIT_L(0); PG8_MMA(0, 0, At, B0); PG8_BAR; PG8_SCHED;
            PG8_LDB(B1, 1, 1); PG8_STAGE(PG8_SB(1, 0), b3, voffB);
            PG8_BAR; PG8_WAIT_L(0); PG8_MMA(0, 1, At, B1); PG8_BAR;
            PG8_LDA(At, 1, 1); PG8_STAGE(PG8_SA(1, 0), a3, voffA);
            PG8_BAR; PG8_WAIT_L(0); PG8_MMA(1, 0, At, B0); PG8_BAR; PG8_SCHED;
            PG8_STAGE(PG8_SB(1, 1), b3 + hstepB, voffB);
            PG8_WAIT_V(6); PG8_BAR; PG8_MMA(1, 1, At, B1); PG8_BAR;
            }
        }
        if constexpr (ALIGN_EPI) { if (wr == 0) PG8_BAR; }
        if constexpr (STREAMK) {
            if (cur.kind == 1) {
                __attribute__((address_space(1))) unsigned* p = (__attribute__((address_space(1))) unsigned*)sk.slots + (size_t)sk.v * 32768 + (size_t)tid * 4;
#pragma unroll
                for (int a = 0; a < 2; ++a)
#pragma unroll
                    for (int b = 0; b < 2; ++b)
#pragma unroll
                        for (int m = 0; m < 4; ++m) { const f32x4 v0 = acc[a][b][m][0], v1 = acc[a][b][m][1];
                            u32x4 w; w.x = cvt_pk_bf16(v0[0], v0[1]); w.y = cvt_pk_bf16(v0[2], v0[3]); w.z = cvt_pk_bf16(v1[0], v1[1]); w.w = cvt_pk_bf16(v1[2], v1[3]);
                            *(__attribute__((address_space(1))) u32x4*)p = w; p += 2048; asm volatile("" : "+v"(p)); }
            } else {
                E(acc, cur, wr, wc, fr, fq);
            }
        } else
        if constexpr (!Epi::AFTER_DRAIN) { E(acc, cur, wr, wc, fr, fq); S.done(cur); }
        if (!has_next) break;
#pragma unroll
        for (int a = 0; a < 2; ++a)
#pragma unroll
            for (int b = 0; b < 2; ++b)
#pragma unroll
                for (int m = 0; m < 4; ++m)
#pragma unroll
                    for (int n = 0; n < 2; ++n) acc[a][b][m][n] = (f32x4){0.f, 0.f, 0.f, 0.f};
        cur = nxt; cA = nA; cB = nB; ++ui;
        if constexpr (ALIGN_EPI) { if (wr == 1) PG8_BAR; }
    }
    PG8_WAIT_V(0);
    if constexpr (!ALIGN_EPI) { if (wr == 0) PG8_BAR; }
    PG8_BAR;
    if constexpr (Epi::AFTER_DRAIN) { E.fused(acc, cur, wr, wc, fr, fq, lds, wid, lane); S.done(cur); }
#undef PG8_SA
#undef PG8_SB
#undef PG8_STAGE
#undef PG8_LDA
#undef PG8_LDB
#undef PG8_MMA
#undef PG8_WAIT_V
#undef PG8_WAIT_L
#undef PG8_BAR
#undef PG8_SCHED
}

template <class Epi, class Sched>
__device__ __forceinline__ void gemm_reduce(const Sched& S, const Epi& E, const SKBuf sk) {
    int tid_ = threadIdx.x; asm volatile("" : "+v"(tid_));
    const int tid = tid_, wid = __builtin_amdgcn_readfirstlane(tid >> 6), lane = tid & 63, wr = wid >> 2, wc = wid & 3, fr = lane & 15, fq = lane >> 4;
    Unit ru; unsigned mask; int base;
    if (!S.reducer(ru, mask, base)) return;
    const unsigned* sb = (const unsigned*)sk.slots + (size_t)base * 32768 + (size_t)tid * 4;
    f32x4 racc[2][2][4][2];
#pragma unroll
    for (int a = 0; a < 2; ++a)
#pragma unroll
        for (int b = 0; b < 2; ++b)
#pragma unroll
            for (int m = 0; m < 4; ++m)
#pragma unroll
                for (int n = 0; n < 2; ++n) racc[a][b][m][n] = (f32x4){0.f, 0.f, 0.f, 0.f};
#pragma unroll
    for (int a = 0; a < 2; ++a)
#pragma unroll
        for (int m = 0; m < 4; ++m)
#pragma unroll
            for (int b = 0; b < 2; ++b)
                if ((mask >> (a * 8 + m * 2 + b)) & 1u) {
                    f32x4 r0 = (f32x4){0.f, 0.f, 0.f, 0.f}, r1 = r0; const unsigned* p = sb + (size_t)(((a * 2 + b) * 4 + m) * 2048);
                    for (int s8 = 0; s8 < S.S; s8 += 8) {
                        u32x4 t[8];
#pragma unroll
                        for (int k = 0; k < 8; ++k) t[k] = *(const u32x4*)(p + (size_t)k * 32768);
#pragma unroll
                        for (int k = 0; k < 8; ++k) { r0 += (f32x4){bflo(t[k].x), bfhi(t[k].x), bflo(t[k].y), bfhi(t[k].y)}; r1 += (f32x4){bflo(t[k].z), bfhi(t[k].z), bflo(t[k].w), bfhi(t[k].w)}; }
                        p += 8 * 32768; }
                    racc[a][b][m][0] = r0; racc[a][b][m][1] = r1;
                }
    E(racc, ru, wr, wc, fr, fq, mask);
}
}

#define GAS __attribute__((address_space(1)))
#define LAS __attribute__((address_space(3)))
typedef unsigned short bf16;
typedef unsigned v4u __attribute__((ext_vector_type(4)));
typedef unsigned v2u __attribute__((ext_vector_type(2)));
typedef float f32x4 __attribute__((ext_vector_type(4)));
typedef float f32x16 __attribute__((ext_vector_type(16)));
typedef short bf16x8 __attribute__((ext_vector_type(8)));
constexpr int NWAVES = 8, NTHREADS = 512;
constexpr int DM = 2048, SEQ = 4096, NMETA = 16, DECB = 32, DECL = 16;
constexpr int NG = 64, NS = 64, DFF = 5632;
constexpr int R_SAMPLE0 = 8192, R_REAL = 8704, R_ALL = 8736, R_PAD = 8960;
constexpr float RMS_EPS = 1e-6f;
constexpr int NSEG = 16;
constexpr size_t O_Y = 0, O_SRE_P = 17825792, O_SIM_P = 17833984, O_POOL_P = 17842176, O_CONV_P = 17872896,
                 O_SRE_S = 17895424, O_SIM_S = 18026496, O_POOL_S = 18157568, O_CONV_S = 18649088;
constexpr size_t MiB = 1u << 20;
constexpr int LDP = 2112;
constexpr size_t WS_WIN = 0, WS_WGLU = 9 * MiB, WS_WPOOL = 11 * MiB, WS_WOUT = 12 * MiB, WS_WUP = 21 * MiB, WS_WDOWN = 67 * MiB;
constexpr size_t WS_XN = 89 * MiB, WS_U = 126 * MiB, WS_YPRE = 161 * MiB, WS_MB = 179 * MiB, WS_YCAT = 197 * MiB;
constexpr size_t WS_H = 126 * MiB;
constexpr size_t WS_SMALL = 234 * MiB;
constexpr size_t WS_XMETA = WS_SMALL, WS_SS1 = WS_XMETA + 32 * 2048 * 4, WS_SS2 = WS_SS1 + 36864, WS_LBAR = WS_SS2 + 36864, WS_PW = WS_LBAR + 32768,
                 WS_BB = WS_PW + 32768, WS_CC = WS_BB + 262144, WS_EST = WS_CC + 262144, WS_GMETA = WS_EST + 2 * 64 * 16 * 64 * 8;
constexpr size_t WS_GFIX = 238 * MiB, WS_VFIX = 245 * MiB, WS_GSRC = 252 * MiB, WS_SLOTS = 258 * MiB, WS_FLAGS = 322 * MiB, WS_BAR = 322 * MiB + 65536, WS_FA = 323 * MiB, WS_FB = 0, WS_END = 351 * MiB;
static_assert(WS_GMETA + 4 * DFF * 4 <= WS_GFIX && WS_H + (size_t)R_REAL * DFF * 2 <= WS_YCAT + (size_t)R_PAD * LDP * 2 && WS_YCAT + (size_t)R_PAD * LDP * 2 <= WS_SMALL && 320 * (size_t)DFF * 4 <= 7 * MiB
              && WS_XN + (size_t)R_PAD * LDP * 2 <= WS_U && WS_WUP + (size_t)11264 * LDP * 2 <= WS_WDOWN && WS_WIN + (size_t)2048 * LDP * 2 <= WS_WGLU && WS_WOUT + (size_t)2048 * LDP * 2 <= WS_WUP, "ws map");
constexpr int F_SPLIT = 7168;
constexpr int LDS_BYTES = 147456;
constexpr int S5_WLDS = 32 * 528;

__device__ __forceinline__ unsigned f2bf(float f) { unsigned u = __builtin_bit_cast(unsigned, f); return (u + 0x7fffu + ((u >> 16) & 1u)) >> 16; }
__device__ __forceinline__ unsigned pk2(float lo, float hi) { return f2bf(lo) | (f2bf(hi) << 16); }
__device__ __forceinline__ float blo(unsigned w) { return __uint_as_float(w << 16); }
__device__ __forceinline__ float bhi(unsigned w) { return __uint_as_float(w & 0xffff0000u); }
#define LDS_WAIT() asm volatile("s_waitcnt lgkmcnt(0)" ::: "memory")

#define XB_TMO      128
#define XB_XCNT(j)  (256  + 64 * (j))
#define XB_XSUB(j)  (1280 + 64 * (j))
#define XB_XGEN(j)  (2304 + 64 * (j))
#define XB_TOP      3328
#define XB_TOPGEN   3392
#define XCD_BAR_WORDS 3456
#define XB_SPIN_CAP (1u << 18)

__device__ __forceinline__ unsigned xb_ld(unsigned* p)              { return __hip_atomic_load(p, __ATOMIC_RELAXED, __HIP_MEMORY_SCOPE_AGENT); }
__device__ __forceinline__ unsigned xb_add(unsigned* p, unsigned v) { return __hip_atomic_fetch_add(p, v, __ATOMIC_RELAXED, __HIP_MEMORY_SCOPE_AGENT); }
__device__ __forceinline__ unsigned xb_xcc_id() { return (unsigned)__builtin_amdgcn_s_getreg((3 << 11) | 20) & 0xFu; }
#define XB_SPIN(cond, bar) do { unsigned _sp = 0; while (cond) { __builtin_amdgcn_s_sleep(1); \
    if ((++_sp & 255u) == 0u) { if (xb_ld(&(bar)[XB_TMO])) break; if (_sp > XB_SPIN_CAP) { atomicAdd(&(bar)[XB_TMO], 1u); break; } } } } while (0)

struct XcdBarrier {
    unsigned* bar; unsigned x;
    volatile LAS unsigned* st;
};

__device__ __forceinline__ XcdBarrier xcd_barrier_post(unsigned* bar, volatile LAS unsigned* st) {
    XcdBarrier b; b.bar = bar; b.x = xb_xcc_id(); b.st = st;
    if (threadIdx.x == 0) (void)xb_add(&bar[XB_XCNT(b.x)], 1u);
    return b;
}
__device__ __forceinline__ void xcd_barrier_complete(unsigned* bar, unsigned x, unsigned& nloc, unsigned& nx) {
    const unsigned G = gridDim.x * gridDim.y * gridDim.z;
    unsigned sum, cnt, mine, sp = 0u;
    for (;;) {
        sum = 0u; cnt = 0u; mine = 0u;
#pragma unroll
        for (unsigned j = 0; j < 16; ++j) { const unsigned c = xb_ld(&bar[XB_XCNT(j)]); sum += c; cnt += (c > 0u) ? 1u : 0u; mine = (j == x) ? c : mine; }
        if (sum == G) break;
        __builtin_amdgcn_s_sleep(1);
        if ((++sp & 255u) == 0u) { if (xb_ld(&bar[XB_TMO])) break; if (sp > XB_SPIN_CAP) { atomicAdd(&bar[XB_TMO], 1u); break; } }
    }
    nloc = mine > 0u ? mine : 1u; nx = cnt > 0u ? cnt : 1u;
}

__device__ __forceinline__ void xcd_barrier(const XcdBarrier& b) {
    asm volatile("s_waitcnt vmcnt(0)" ::: "memory");
    __syncthreads();
    if (threadIdx.x == 0) {
        unsigned* bar = b.bar;
        __builtin_amdgcn_s_waitcnt(0);
        unsigned nloc = b.st[0], nx = b.st[1];
        if (nloc == 0u) { xcd_barrier_complete(bar, b.x, nloc, nx); b.st[0] = nloc; b.st[1] = nx; }
        const unsigned old = xb_add(&bar[XB_XSUB(b.x)], 1u);
        const unsigned gen = old / nloc;
        if (old + 1u == (gen + 1u) * nloc) {
            __builtin_amdgcn_fence(__ATOMIC_RELEASE, "agent");
            asm volatile("s_waitcnt vmcnt(0)" ::: "memory");
            const unsigned og = xb_add(&bar[XB_TOP], 1u);
            const unsigned tg = og / nx;
            if (og + 1u == (tg + 1u) * nx) xb_add(&bar[XB_TOPGEN], 1u);
            else XB_SPIN(xb_ld(&bar[XB_TOPGEN]) == tg, bar);
            __builtin_amdgcn_fence(__ATOMIC_ACQUIRE, "agent");
            xb_add(&bar[XB_XGEN(b.x)], 1u);
            asm volatile("s_waitcnt vmcnt(0)" ::: "memory");
        } else {
            XB_SPIN(xb_ld(&bar[XB_XGEN(b.x)]) == gen, bar);
            __builtin_amdgcn_fence(__ATOMIC_ACQUIRE, "agent");
            asm volatile("s_waitcnt vmcnt(0)" ::: "memory");
        }
    }
    __syncthreads();
}

struct Frame {
    LAS unsigned char* lds; int wave, vcu, G;
    float* out; unsigned char* ws;
};
constexpr int BARST_OFF = 143360 + 256;
constexpr int TAB_OFF = 143360;
__device__ __forceinline__ const float* inp(const Frame& F, int i) {
    const LAS unsigned* t = (const LAS unsigned*)(F.lds + TAB_OFF) + 2 * i; const unsigned lo = __builtin_amdgcn_readfirstlane(t[0]), hi = __builtin_amdgcn_readfirstlane(t[1]);
    return (const float*)(const GAS float*)(((unsigned long long)hi << 32) | lo);
}
__device__ __forceinline__ int ltid() { int t = threadIdx.x; asm volatile("" : "+v"(t)); return t; }
__device__ __forceinline__ float wave_sum(float v) {
#pragma unroll
    for (int o = 1; o < 64; o <<= 1) v += __shfl_xor(v, o);
    return v;
}
struct TItem { const float* src; bf16* dst; int K, N; };
__device__ __forceinline__ void p0_item_load(const TItem& t, f32x4 (&buf)[16], int lane) {
    const float* p = t.src + (size_t)(lane >> 4) * t.N + 4 * (lane & 15);
#pragma unroll
    for (int i = 0; i < 16; ++i) buf[i] = __builtin_nontemporal_load((const f32x4*)(p + (size_t)(4 * i) * t.N));
}
__device__ __forceinline__ void p0_item_to_lds(const f32x4 (&buf)[16], LAS float* scr, int lane) {
    LAS float* q = scr + (lane >> 4) * 65 + 4 * (lane & 15);
#pragma unroll
    for (int i = 0; i < 16; ++i) { q[(4 * i) * 65 + 0] = buf[i][0]; q[(4 * i) * 65 + 1] = buf[i][1]; q[(4 * i) * 65 + 2] = buf[i][2]; q[(4 * i) * 65 + 3] = buf[i][3]; }
}
__device__ __forceinline__ void p0_item_store(const TItem& t, LAS float* scr, int lane) {
    const int c = lane & 7;
#pragma unroll
    for (int j = 0; j < 8; ++j) { const int n = (lane >> 3) + 8 * j; const LAS float* sp = scr + (8 * c) * 65 + n;
        v4u o; o.x = pk2(sp[0 * 65], sp[1 * 65]); o.y = pk2(sp[2 * 65], sp[3 * 65]); o.z = pk2(sp[4 * 65], sp[5 * 65]); o.w = pk2(sp[6 * 65], sp[7 * 65]);
        *(v4u*)(t.dst + (size_t)n * t.K + 8 * c) = o; }
}
__device__ __forceinline__ const float* xrow(const Frame& F, int R) {
    return R < R_SAMPLE0 ? inp(F, 0) + (size_t)R * DM : (R < R_REAL ? inp(F, 1) + (size_t)(R - R_SAMPLE0) * DM : inp(F, 6) + (size_t)((R - R_REAL) & 15) * DM);
}

constexpr int I_IN = 32 * 32, I_GLU = 16 * 16, I_POOL = 4 * 4 * 4, I_OUT = 32 * 32, I_UP = 32 * 176, I_DOWN = 88 * 32;
constexpr int I_EARLY = I_IN + I_GLU + I_POOL + I_OUT + I_UP;
__device__ __forceinline__ void p0_decode(const Frame& F, int it, TItem& t) {
    unsigned char* ws = F.ws; int r = it;
    if (r < I_IN) { const int kb = r / 32, nb = r % 32; t.K = LDP; t.N = 2048; t.src = inp(F, 8) + (size_t)(64 * kb) * 2048 + 64 * nb; t.dst = (bf16*)(ws + WS_WIN) + (size_t)(64 * nb) * LDP + 64 * kb; return; } r -= I_IN;
    if (r < I_GLU) { const int kb = r / 16, nb = r % 16; t.K = 1024; t.N = 1024; t.src = inp(F, 17) + (size_t)(64 * kb) * 1024 + 64 * nb; t.dst = (bf16*)(ws + WS_WGLU) + (size_t)(64 * nb) * 1024 + 64 * kb; return; } r -= I_GLU;
    if (r < I_POOL) { const int g = r / 16, q = r % 16, kb = q / 4, nb = q % 4; t.K = 256; t.N = 256; t.src = inp(F, 18) + (size_t)g * 65536 + (size_t)(64 * kb) * 256 + 64 * nb; t.dst = (bf16*)(ws + WS_WPOOL) + (size_t)g * 65536 + (size_t)(64 * nb) * 256 + 64 * kb; return; } r -= I_POOL;
    if (r < I_OUT) { const int kb = r / 32, nb = r % 32; t.K = LDP; t.N = 2048; t.src = inp(F, 20) + (size_t)(64 * kb) * 2048 + 64 * nb; t.dst = (bf16*)(ws + WS_WOUT) + (size_t)(64 * nb) * LDP + 64 * kb; return; } r -= I_OUT;
    if (r < I_UP) { const int kb = r / 176, nb = r % 176, n0 = 64 * nb; const int drow = n0 < DFF ? (n0 / 128) * 256 + (n0 % 128) : ((n0 - DFF) / 128) * 256 + 128 + ((n0 - DFF) % 128);
        t.K = LDP; t.N = 2 * DFF; t.src = inp(F, 22) + (size_t)(64 * kb) * (2 * DFF) + n0; t.dst = (bf16*)(ws + WS_WUP) + (size_t)drow * LDP + 64 * kb; return; } r -= I_UP;
    { const int kb = r / 32, nb = r % 32; t.K = DFF; t.N = 2048; t.src = inp(F, 25) + (size_t)(64 * kb) * 2048 + 64 * nb; t.dst = (bf16*)(ws + WS_WDOWN) + (size_t)(64 * nb) * DFF + 64 * kb; }
}
__device__ __forceinline__ void p0_convert(const Frame& F, int lo, int hi, int w, int nw, int lane) {
    LAS float* scr = (LAS float*)(F.lds + F.wave * 16640);
    f32x4 bufA[16], bufB[16]; TItem ta, tb; int it = lo + w;
    if (it < hi) { p0_decode(F, it, ta); p0_item_load(ta, bufA, lane); }
    while (it < hi) {
        p0_item_to_lds(bufA, scr, lane);
        if (it + nw < hi) { p0_decode(F, it + nw, tb); p0_item_load(tb, bufB, lane); }
        LDS_WAIT(); asm volatile("" ::: "memory");
        p0_item_store(ta, scr, lane);
        LDS_WAIT(); asm volatile("" ::: "memory");
        it += nw; if (it >= hi) break;
        p0_item_to_lds(bufB, scr, lane);
        if (it + nw < hi) { p0_decode(F, it + nw, ta); p0_item_load(ta, bufA, lane); }
        LDS_WAIT(); asm volatile("" ::: "memory");
        p0_item_store(tb, scr, lane);
        LDS_WAIT(); asm volatile("" ::: "memory");
        it += nw;
    }
}
__device__ __forceinline__ void p0_prologue(Frame& F) {
    unsigned char* ws = F.ws; const int tid = ltid(), lane = tid & 63;
    const int gw = F.vcu * NWAVES + F.wave, NGW = F.G * NWAVES;
    p0_convert(F, 0, F.G == 256 ? I_EARLY : I_EARLY + I_DOWN, gw, NGW, lane);
    const float* gm = inp(F, 7);
    {
        f32x4 v[8], vn[8]; int R = gw;
        if (R < R_ALL) { const f32x4* xr = (const f32x4*)xrow(F, R) + lane;
#pragma unroll
            for (int j = 0; j < 8; ++j) v[j] = __builtin_nontemporal_load(xr + 64 * j); }
        while (R < R_ALL) {
            const int Rn = R + NGW;
            if (Rn < R_ALL) { const f32x4* xr = (const f32x4*)xrow(F, Rn) + lane;
#pragma unroll
                for (int j = 0; j < 8; ++j) vn[j] = __builtin_nontemporal_load(xr + 64 * j); }
            float s = 0.f;
#pragma unroll
            for (int j = 0; j < 8; ++j) s += (v[j].x * v[j].x + v[j].y * v[j].y) + (v[j].z * v[j].z + v[j].w * v[j].w);
            const float ms = wave_sum(s) * (1.0f / DM) + RMS_EPS; const float rstd = rsqrtf(ms);
            if (lane == 0) ((float*)(ws + WS_SS2))[R] = sqrtf(ms);
            unsigned long long* o8 = (unsigned long long*)((bf16*)(ws + WS_XN) + (size_t)R * LDP) + lane;
#pragma unroll
            for (int j = 0; j < 8; ++j) { const f32x4 g = ((const f32x4*)gm)[64 * j + lane];
                o8[64 * j] = (unsigned long long)pk2(v[j].x * rstd * g.x, v[j].y * rstd * g.y) | ((unsigned long long)pk2(v[j].z * rstd * g.z, v[j].w * rstd * g.w) << 32); }
#pragma unroll
            for (int j = 0; j < 8; ++j) v[j] = vn[j];
            R = Rn;
        }
    }
    const int gt = F.vcu * NTHREADS + tid, NGT = F.G * NTHREADS;
    for (int i = gt; i < 9216; i += NGT) ((float*)(ws + WS_SS1))[i] = 0.f;
    for (int i = gt; i < 4 * 256; i += NGT) __hip_atomic_store((unsigned*)(ws + WS_FLAGS) + i, 0u, __ATOMIC_RELAXED, __HIP_MEMORY_SCOPE_SYSTEM);
    for (int i2 = gt; i2 < NG * NS * 16; i2 += NGT) {
        const int i = i2 >> 4, n = i2 & 15, g = i >> 6, p = i & 63;
        const float lr = inp(F, 9)[i], li = inp(F, 10)[i], dt = expf(inp(F, 11)[g]);
        const float er = expf(lr * dt); const float sn = sinf(li * dt), cs = cosf(li * dt);
        const float br = er * cs, bi = er * sn;
        if (n == 0) {
            ((float2*)(ws + WS_LBAR))[i] = make_float2(br, bi);
            float pr = br, pi = bi;
#pragma unroll
            for (int k = 0; k < 8; ++k) { const float nr = pr * pr - pi * pi, ni = 2.f * pr * pi; pr = nr; pi = ni; }
            ((float2*)(ws + WS_PW))[i] = make_float2(pr, pi);
        }
        const float nr = br - 1.f, ni = bi, den = 1.f / (lr * lr + li * li);
        const float cr = (nr * lr + ni * li) * den, ci = (ni * lr - nr * li) * den;
        bf16* bb = (bf16*)(ws + WS_BB) + (size_t)g * 128 * 16;
        const float b_r = inp(F, 12)[(size_t)i * 16 + n], b_i = inp(F, 13)[(size_t)i * 16 + n];
        bb[p * 16 + n] = (bf16)f2bf(cr * b_r - ci * b_i); bb[(64 + p) * 16 + n] = (bf16)f2bf(cr * b_i + ci * b_r);
    }
    for (int i = gt; i < NG * 16 * 128; i += NGT) {
        const int k = i & 127, gn = i >> 7;
        ((bf16*)(ws + WS_CC))[i] = (bf16)f2bf(k < 64 ? inp(F, 14)[(size_t)gn * 64 + k] : -inp(F, 15)[(size_t)gn * 64 + (k - 64)]);
    }
}

struct S5Ctx { bf16x8 bb[4]; bf16x8 cc[8]; float lbr, lbi; int g; f32x4 dsk[2]; };
struct S5In { bf16x8 a; v2u us[2]; };
__device__ __forceinline__ void s5_load_ctx(S5Ctx& c, const Frame& F, int g, int lane) {
    const unsigned char* ws = F.ws; c.g = g;
    const bf16* bb = (const bf16*)(ws + WS_BB) + (size_t)g * 2048; const bf16* cc = (const bf16*)(ws + WS_CC) + (size_t)g * 2048;
#pragma unroll
    for (int cb = 0; cb < 4; ++cb) c.bb[cb] = *(const bf16x8*)(bb + (32 * cb + (lane & 31)) * 16 + 8 * (lane >> 5));
#pragma unroll
    for (int kb = 0; kb < 8; ++kb) { bf16x8 z = {0, 0, 0, 0, 0, 0, 0, 0}; if ((lane & 31) < 16) z = *(const bf16x8*)(cc + (lane & 31) * 128 + 16 * kb + 8 * (lane >> 5)); c.cc[kb] = z; }
    const float2 lb = ((const float2*)(ws + WS_LBAR))[g * 64 + lane]; c.lbr = lb.x; c.lbi = lb.y;
    c.dsk[0] = *(const f32x4*)(inp(F, 16) + g * 16 + 4 * (lane >> 5)); c.dsk[1] = *(const f32x4*)(inp(F, 16) + g * 16 + 8 + 4 * (lane >> 5));
}
template <int NV, bool FULL>
__device__ __forceinline__ void s5_fetch(S5In& in, const Frame& F, int g, int row0, int lane) {
    const bf16* U = (const bf16*)(F.ws + WS_U); const int ti = lane & 31, kh = lane >> 5;
    in.a = (bf16x8){0, 0, 0, 0, 0, 0, 0, 0}; in.us[0] = (v2u){0u, 0u}; in.us[1] = (v2u){0u, 0u};
    if (ti < NV) { const bf16* ur = U + (size_t)(row0 + ti) * 2048 + g * 16; in.a = *(const bf16x8*)(ur + 8 * kh);
        if (FULL) { in.us[0] = *(const v2u*)(ur + 4 * kh); in.us[1] = *(const v2u*)(ur + 8 + 4 * kh); } }
}
template <int NV, bool FULL>
__device__ __forceinline__ void s5_block(const S5Ctx& c, const Frame& F, LAS unsigned char* wl, int row0, const S5In& in, float& hr, float& hi, int lane) {
    const int ti = lane & 31, kh = lane >> 5;
    const bf16x8 a = in.a;
    LAS float* L = (LAS float*)wl;
#pragma unroll
    for (int cb = 0; cb < 4; ++cb) {
        f32x16 d = {0.f, 0.f, 0.f, 0.f, 0.f, 0.f, 0.f, 0.f, 0.f, 0.f, 0.f, 0.f, 0.f, 0.f, 0.f, 0.f};
        d = __builtin_amdgcn_mfma_f32_32x32x16_bf16(a, c.bb[cb], d, 0, 0, 0);
#pragma unroll
        for (int r = 0; r < 16; ++r) { const int i = (r & 3) + 8 * (r >> 2) + 4 * kh; if (i < NV) L[i * 132 + 32 * cb + ti] = d[r]; }
    }
    LDS_WAIT(); asm volatile("" ::: "memory");
    float bre[NV], bim[NV];
#pragma unroll
    for (int t = 0; t < NV; ++t) { bre[t] = L[t * 132 + lane]; bim[t] = L[t * 132 + 64 + lane]; }
    LDS_WAIT(); asm volatile("" ::: "memory");
    LAS bf16* Hh = (LAS bf16*)wl;
#pragma unroll
    for (int t = 0; t < NV; ++t) {
        const float nr = c.lbr * hr - c.lbi * hi + bre[t], ni = c.lbr * hi + c.lbi * hr + bim[t]; hr = nr; hi = ni;
        if (FULL) { Hh[t * 264 + lane] = (bf16)f2bf(hr); Hh[t * 264 + 64 + lane] = (bf16)f2bf(hi); }
    }
    if (FULL) {
        LDS_WAIT(); asm volatile("" ::: "memory");
        f32x16 y = {0.f, 0.f, 0.f, 0.f, 0.f, 0.f, 0.f, 0.f, 0.f, 0.f, 0.f, 0.f, 0.f, 0.f, 0.f, 0.f};
#pragma unroll
        for (int kb = 0; kb < 8; ++kb) { const bf16x8 hb = *(const LAS bf16x8*)(wl + ti * 528 + (16 * kb + 8 * kh) * 2); y = __builtin_amdgcn_mfma_f32_32x32x16_bf16(c.cc[kb], hb, y, 0, 0, 0); }
        LDS_WAIT(); asm volatile("" ::: "memory");
        if (ti < NV) {
            bf16* YP = (bf16*)(F.ws + WS_YPRE) + (size_t)(row0 + ti) * 1024 + c.g * 16;
#pragma unroll
            for (int rr = 0; rr < 2; ++rr) { const int n0 = 8 * rr + 4 * kh; const v2u uu = in.us[rr]; const f32x4 dd = c.dsk[rr];
                const float y0 = pg8::gelu_tanh(y[4 * rr + 0] + dd.x * blo(uu.x)), y1 = pg8::gelu_tanh(y[4 * rr + 1] + dd.y * bhi(uu.x)),
                            y2 = pg8::gelu_tanh(y[4 * rr + 2] + dd.z * blo(uu.y)), y3 = pg8::gelu_tanh(y[4 * rr + 3] + dd.w * bhi(uu.y));
                v2u o; o.x = pk2(y0, y1); o.y = pk2(y2, y3); *(v2u*)(YP + n0) = o; }
        }
    }
}
template <bool FULL>
__device__ __forceinline__ void s5_prompt_item(const Frame& F, LAS unsigned char* wl, int item, int lane) {
    const int seg = item & (NSEG - 1), g = (item >> 4) & 63, b = item >> 10;
    float2* est = (float2*)(F.ws + WS_EST) + ((size_t)(b * 64 + g) * NSEG) * 64;
    if (!FULL && seg == NSEG - 1) return;
    S5Ctx c; s5_load_ctx(c, F, g, lane);
    float hr = 0.f, hi = 0.f;
    if (FULL) { const float2 pw = ((const float2*)(F.ws + WS_PW))[g * 64 + lane];
        float2 ev[NSEG - 1];
#pragma unroll
        for (int s = 0; s < NSEG - 1; ++s) { ev[s] = make_float2(0.f, 0.f); if (s < seg) ev[s] = est[s * 64 + lane]; }
#pragma unroll
        for (int s = 0; s < NSEG - 1; ++s) if (s < seg) { const float nr = pw.x * hr - pw.y * hi + ev[s].x, ni = pw.x * hi + pw.y * hr + ev[s].y; hr = nr; hi = ni; } }
    S5In cur, nxt, nx2;
    const int rbase = SEQ * b + 32 * (8 * seg);
    if (seg == 0) { s5_fetch<16, FULL>(cur, F, g, R_REAL + 16 * b, lane); s5_fetch<32, FULL>(nxt, F, g, rbase, lane); s5_fetch<32, FULL>(nx2, F, g, rbase + 32, lane);
        s5_block<16, FULL>(c, F, wl, R_REAL + 16 * b, cur, hr, hi, lane); cur = nxt; nxt = nx2; }
    else { s5_fetch<32, FULL>(cur, F, g, rbase, lane); s5_fetch<32, FULL>(nxt, F, g, rbase + 32, lane); }
    for (int j = 0; j < 8; ++j) {
        const int row0 = rbase + 32 * j;
        if (j < 6) s5_fetch<32, FULL>(nx2, F, g, row0 + 64, lane);
        s5_block<32, FULL>(c, F, wl, row0, cur, hr, hi, lane); cur = nxt; nxt = nx2; }
    if (!FULL) est[seg * 64 + lane] = make_float2(hr, hi);
    else if (seg == NSEG - 1) { F.out[O_SRE_P + (size_t)(b * 64 + g) * 64 + lane] = hr; F.out[O_SIM_P + (size_t)(b * 64 + g) * 64 + lane] = hi; }
}
__device__ __forceinline__ void s5_sample_item(const Frame& F, LAS unsigned char* wl, int item, int lane) {
    const int g = item & 63, s = item >> 6;
    S5Ctx c; s5_load_ctx(c, F, g, lane);
    float hr = inp(F, 2)[(size_t)(s * 64 + g) * 64 + lane], hi = inp(F, 3)[(size_t)(s * 64 + g) * 64 + lane];
    S5In cur; s5_fetch<16, true>(cur, F, g, R_SAMPLE0 + 16 * s, lane);
    s5_block<16, true>(c, F, wl, R_SAMPLE0 + 16 * s, cur, hr, hi, lane);
    F.out[O_SRE_S + (size_t)(s * 64 + g) * 64 + lane] = hr; F.out[O_SIM_S + (size_t)(s * 64 + g) * 64 + lane] = hi;
}

__device__ __forceinline__ void pool_m_phase(const Frame& F) {
    const bf16* U = (const bf16*)(F.ws + WS_U); bf16* MB = (bf16*)(F.ws + WS_MB); const int tid = ltid();
    const int sub = tid >> 7, t128 = tid & 127, c0 = 8 * t128, w = 2 << (c0 >> 8);
    for (int run = F.vcu * 4 + sub; run < 546; run += F.G * 4) {
        const bool samp = run >= 514; int rowbase, pos0; const float* hist = nullptr; int b = 0;
        if (samp) { const int sq = run - 514; rowbase = R_SAMPLE0 + 16 * sq; pos0 = 0; hist = inp(F, 4) + (size_t)sq * 15 * 1024 + c0; }
        else { b = run / 257; const int j = run % 257; pos0 = 16 * j; rowbase = j == 0 ? R_REAL + 16 * b : SEQ * b + 16 * (j - 1); }
        v4u zr[31];
#pragma unroll
        for (int i = 0; i < 31; ++i) {
            const int rel = i - 15; v4u q = {0u, 0u, 0u, 0u};
            if (rel >= 0) q = *(const v4u*)(U + (size_t)(rowbase + rel) * 2048 + 1024 + c0);
            else if (samp) { const f32x4 a = *(const f32x4*)(hist + (size_t)(15 + rel) * 1024), b2 = *(const f32x4*)(hist + (size_t)(15 + rel) * 1024 + 4); q.x = pk2(a.x, a.y); q.y = pk2(a.z, a.w); q.z = pk2(b2.x, b2.y); q.w = pk2(b2.z, b2.w); }
            else { const int pos = pos0 + rel; if (pos >= 0) { const int row = pos < 16 ? R_REAL + 16 * b + pos : SEQ * b + (pos - 16); q = *(const v4u*)(U + (size_t)row * 2048 + 1024 + c0); } }
            zr[i] = q;
        }
        float s[8];
#pragma unroll
        for (int e = 0; e < 8; ++e) s[e] = 0.f;
#pragma unroll
        for (int jj = 1; jj < 16; ++jj) { const v4u q = zr[15 - jj]; const float f = jj < w ? 1.f : 0.f;
            s[0] += f * blo(q.x); s[1] += f * bhi(q.x); s[2] += f * blo(q.y); s[3] += f * bhi(q.y); s[4] += f * blo(q.z); s[5] += f * bhi(q.z); s[6] += f * blo(q.w); s[7] += f * bhi(q.w); }
#pragma unroll
        for (int t = 0; t < 16; ++t) {
            const v4u q = zr[15 + t]; const float z[8] = {blo(q.x), bhi(q.x), blo(q.y), bhi(q.y), blo(q.z), bhi(q.z), blo(q.w), bhi(q.w)};
            const int pos = pos0 + t; const float inv = 1.0f / (float)((samp || pos + 1 >= w) ? w : pos + 1);
            float mo[8];
#pragma unroll
            for (int e = 0; e < 8; ++e) { s[e] += z[e]; mo[e] = s[e] * inv - z[e]; }
            v4u o; o.x = pk2(mo[0], mo[1]); o.y = pk2(mo[2], mo[3]); o.z = pk2(mo[4], mo[5]); o.w = pk2(mo[6], mo[7]);
            *(v4u*)(MB + (size_t)(rowbase + t) * 1024 + c0) = o;
            const v4u q2 = zr[15 + t - 1], q4 = zr[15 + t - 3], q8 = zr[15 + t - 7], q16 = zr[15 + t - 15];
            v4u ql; ql.x = w == 2 ? q2.x : (w == 4 ? q4.x : (w == 8 ? q8.x : q16.x)); ql.y = w == 2 ? q2.y : (w == 4 ? q4.y : (w == 8 ? q8.y : q16.y));
            ql.z = w == 2 ? q2.z : (w == 4 ? q4.z : (w == 8 ? q8.z : q16.z)); ql.w = w == 2 ? q2.w : (w == 4 ? q4.w : (w == 8 ? q8.w : q16.w));
            s[0] -= blo(ql.x); s[1] -= bhi(ql.x); s[2] -= blo(ql.y); s[3] -= bhi(ql.y); s[4] -= blo(ql.z); s[5] -= bhi(ql.z); s[6] -= blo(ql.w); s[7] -= bhi(ql.w);
        }
    }
    const int gt = F.vcu * NTHREADS + tid, NGT = F.G * NTHREADS;
    for (int i = gt; i < (2 + 32) * 15 * 256; i += NGT) {
        const int c4 = (i & 255) * 4, q = i >> 8, r = q % 15, sq = q / 15;
        const int row = sq < 2 ? SEQ * sq + 4081 + r : R_SAMPLE0 + 16 * (sq - 2) + 1 + r;
        const v2u uu = *(const v2u*)(U + (size_t)row * 2048 + 1024 + c4);
        float* dst = sq < 2 ? F.out + O_POOL_P + (size_t)(sq * 15 + r) * 1024 + c4 : F.out + O_POOL_S + (size_t)((sq - 2) * 15 + r) * 1024 + c4;
        *(f32x4*)dst = (f32x4){blo(uu.x), bhi(uu.x), blo(uu.y), bhi(uu.y)};
    }
}

__device__ __forceinline__ void gmeta_phase(const Frame& F) {
    const bf16* XN = (const bf16*)(F.ws + WS_XN); const bf16* WU = (const bf16*)(F.ws + WS_WUP); const float* ss = (const float*)(F.ws + WS_SS1); float* GM = (float*)(F.ws + WS_GMETA);
    const int gw = F.vcu * NWAVES + F.wave, NGW = F.G * NWAVES; const int lane = ltid() & 63;
    for (int jb = gw; jb < DFF; jb += 3 * NGW) {
        v4u xv[4][4], wv[3][4];
#pragma unroll
        for (int i = 0; i < 4; ++i) { const int c = 8 * lane + 512 * i;
#pragma unroll
            for (int q = 0; q < 4; ++q) xv[q][i] = *(const v4u*)(XN + (size_t)(R_REAL + 16 * (q >> 1) + 14 + (q & 1)) * LDP + c);
#pragma unroll
            for (int t = 0; t < 3; ++t) { const int j = jb + t * NGW; wv[t][i] = (v4u){0u, 0u, 0u, 0u}; if (j < DFF) wv[t][i] = *(const v4u*)(WU + (size_t)((j >> 7) * 256 + (j & 127)) * LDP + c); } }
#pragma unroll
        for (int t = 0; t < 3; ++t) { const int j = jb + t * NGW;
            float a[4] = {0.f, 0.f, 0.f, 0.f};
#pragma unroll
            for (int i = 0; i < 4; ++i) { const v4u w = wv[t][i]; const float wf[8] = {blo(w.x), bhi(w.x), blo(w.y), bhi(w.y), blo(w.z), bhi(w.z), blo(w.w), bhi(w.w)};
#pragma unroll
                for (int q = 0; q < 4; ++q) { const v4u x = xv[q][i];
                    a[q] += wf[0] * blo(x.x) + wf[1] * bhi(x.x) + wf[2] * blo(x.y) + wf[3] * bhi(x.y) + wf[4] * blo(x.z) + wf[5] * bhi(x.z) + wf[6] * blo(x.w) + wf[7] * bhi(x.w); } }
#pragma unroll
            for (int q = 0; q < 4; ++q) a[q] = wave_sum(a[q]);
            if (lane < 4 && j < DFF) { const int q = lane; const int Rm = R_REAL + 16 * (q >> 1) + 14 + (q & 1); const float v = q == 0 ? a[0] : (q == 1 ? a[1] : (q == 2 ? a[2] : a[3]));
                GM[(size_t)q * DFF + j] = v * rsqrtf(ss[Rm] * (1.0f / DM) + RMS_EPS); }
        }
    }
}

__device__ __forceinline__ void fixup_phase(const Frame& F) {
    const float* GF = (const float*)(F.ws + WS_GFIX); const float* VF = (const float*)(F.ws + WS_VFIX); const float* GS = (const float*)(F.ws + WS_GSRC); const float* GM = (const float*)(F.ws + WS_GMETA);
    const float* cw = inp(F, 23); const float* cb = inp(F, 24); const float* hist = inp(F, 5); bf16* H = (bf16*)(F.ws + WS_H);
    const int tid = ltid(); const int gt = F.vcu * NTHREADS + tid, NGT = F.G * NTHREADS;
    for (int idx = gt; idx < 320 * 1408; idx += NGT) {
        const int id = idx / 1408, j = (idx % 1408) * 4;
        const f32x4 g0 = *(const f32x4*)(GF + (size_t)id * DFF + j), v0 = *(const f32x4*)(VF + (size_t)id * DFF + j);
        f32x4 p1, p2; int R;
        if (id < 256) {
            const int pm = id >> 3, blk = (id & 7) >> 1, rr = id & 1; R = 256 * pm + 64 * blk + rr;
            const bool start = blk == 0 && (pm == 0 || pm == 16);
            const float* S0; const float* S1;
            if (start) { const int b = pm >> 4; S0 = GM + (size_t)(b * 2 + 0) * DFF; S1 = GM + (size_t)(b * 2 + 1) * DFF; }
            else { const int sb = blk > 0 ? pm * 8 + (blk - 1) * 2 : (pm - 1) * 8 + 6; S0 = GS + (size_t)sb * DFF; S1 = GS + (size_t)(sb + 1) * DFF; }
            if (rr == 0) { p1 = *(const f32x4*)(S1 + j); p2 = *(const f32x4*)(S0 + j); }
            else { p1 = *(const f32x4*)(GF + (size_t)(id - 1) * DFF + j); p2 = *(const f32x4*)(S1 + j); }
        } else {
            const int q = id - 256, sq = q >> 1, rr = q & 1; R = R_SAMPLE0 + 16 * sq + rr;
            const float* h0 = hist + (size_t)(sq * 2 + 0) * DFF; const float* h1 = hist + (size_t)(sq * 2 + 1) * DFF;
            if (rr == 0) { p1 = *(const f32x4*)(h1 + j); p2 = *(const f32x4*)(h0 + j); }
            else { p1 = *(const f32x4*)(GF + (size_t)(id - 1) * DFF + j); p2 = *(const f32x4*)(h1 + j); }
        }
        const f32x4 w0 = *(const f32x4*)(cw + j), w1 = *(const f32x4*)(cw + DFF + j), w2 = *(const f32x4*)(cw + 2 * DFF + j), bb = *(const f32x4*)(cb + j);
        const f32x4 gc = bb + p2 * w0 + p1 * w1 + g0 * w2;
        v2u o; o.x = pk2(pg8::gelu_tanh(gc.x) * v0.x, pg8::gelu_tanh(gc.y) * v0.y); o.y = pk2(pg8::gelu_tanh(gc.z) * v0.z, pg8::gelu_tanh(gc.w) * v0.w);
        *(v2u*)(H + (size_t)R * DFF + j) = o;
    }
}
__device__ __forceinline__ void final_phase(const Frame& F) {
    const float* gf = inp(F, 26); const float* gn = inp(F, 21); const bf16* XNb = (const bf16*)(F.ws + WS_XN);
    const bf16* FA = (const bf16*)(F.ws + WS_FA); const bf16* FBb = (const bf16*)(F.ws + WS_FB);
    const int gw = F.vcu * NWAVES + F.wave, NGW = F.G * NWAVES; const int lane = ltid() & 63;
    f32x4 rg[8];
#pragma unroll
    for (int j = 0; j < 8; ++j) { const f32x4 g = ((const f32x4*)gn)[64 * j + lane]; rg[j] = (f32x4){1.0f / g.x, 1.0f / g.y, 1.0f / g.z, 1.0f / g.w}; }
    f32x4 gfin[8];
#pragma unroll
    for (int j = 0; j < 8; ++j) gfin[j] = ((const f32x4*)gf)[64 * j + lane];
    v2u xb[8], xbn[8], xb2[8], fb[8], fbn[8], fb2[8]; int R = gw;
    auto fetch = [&](int Rr, v2u (&x)[8], v2u (&f)[8]) {
        if (Rr < R_REAL) { const v2u* xr = (const v2u*)(XNb + (size_t)Rr * LDP) + lane; const v2u* fr_ = (const v2u*)((Rr < F_SPLIT ? FA + (size_t)Rr * DM : FBb + (size_t)(Rr - F_SPLIT) * DM)) + lane;
#pragma unroll
            for (int j = 0; j < 8; ++j) { x[j] = xr[64 * j]; f[j] = fr_[64 * j]; } } };
    fetch(R, xb, fb); fetch(R + NGW, xbn, fbn);
    while (R < R_REAL) {
        fetch(R + 2 * NGW, xb2, fb2);
        f32x4 v[8]; float s = 0.f;
#pragma unroll
        for (int j = 0; j < 8; ++j) { v[j].x = blo(xb[j].x) * rg[j].x + blo(fb[j].x); v[j].y = bhi(xb[j].x) * rg[j].y + bhi(fb[j].x); v[j].z = blo(xb[j].y) * rg[j].z + blo(fb[j].y); v[j].w = bhi(xb[j].y) * rg[j].w + bhi(fb[j].y);
            s += (v[j].x * v[j].x + v[j].y * v[j].y) + (v[j].z * v[j].z + v[j].w * v[j].w); }
        const float rstd = rsqrtf(wave_sum(s) * (1.0f / DM) + RMS_EPS);
        f32x4* xo = (f32x4*)(F.out + (size_t)R * DM) + lane;
#pragma unroll
        for (int j = 0; j < 8; ++j) __builtin_nontemporal_store(v[j] * rstd * gfin[j], xo + 64 * j);
#pragma unroll
        for (int j = 0; j < 8; ++j) { xb[j] = xbn[j]; fb[j] = fbn[j]; xbn[j] = xb2[j]; fbn[j] = fb2[j]; }
        R += NGW;
    }
}

struct Args { const float* in[27]; float* out; unsigned char* ws; };
#ifndef PROBE
#define PROBE 0
#endif
__global__ void __launch_bounds__(NTHREADS, 2) hymba_fwd(Args args) {
    extern __shared__ __attribute__((aligned(16))) unsigned char lds[];
    cg::grid_group grid = cg::this_grid();
    Frame F;
    F.lds = (LAS unsigned char*)lds;
    F.wave = __builtin_amdgcn_readfirstlane((int)threadIdx.x >> 6);
    F.G = gridDim.x; { const int bx = blockIdx.x; F.vcu = (F.G % 8 == 0) ? (bx % 8) * (F.G / 8) + bx / 8 : bx; }
    if (threadIdx.x == 0) {
#pragma unroll
        for (int i = 0; i < 27; ++i) ((LAS unsigned long long*)(F.lds + TAB_OFF))[i] = (unsigned long long)args.in[i];
        ((LAS unsigned*)(F.lds + BARST_OFF))[0] = 0u; ((LAS unsigned*)(F.lds + BARST_OFF))[1] = 0u; ((LAS unsigned*)(F.lds + BARST_OFF + 64))[0] = 0u;
    }
    __syncthreads();
    const XcdBarrier bar = xcd_barrier_post((unsigned*)(args.ws + WS_BAR), (volatile LAS unsigned*)(F.lds + BARST_OFF));
#ifndef TPROBE_A
#define TPROBE_A -1
#define TPROBE_B -1
#endif
    int stamp_i_ = 0;
#define STAMP() do { if (TPROBE_A >= 0 && blockIdx.x == 0 && threadIdx.x == 0) ((volatile LAS unsigned long long*)(F.lds + BARST_OFF + 128))[stamp_i_] = __builtin_amdgcn_s_memrealtime(); ++stamp_i_; } while (0)
#define GRID_BAR() do { xcd_barrier(bar); STAMP(); } while (0)
    STAMP();
    F.out = (float*)(GAS float*)args.out; F.ws = (unsigned char*)(GAS unsigned char*)args.ws;
    unsigned char* ws = F.ws;
    bf16* XN = (bf16*)(ws + WS_XN); bf16* U = (bf16*)(ws + WS_U); bf16* YPRE = (bf16*)(ws + WS_YPRE); bf16* MB = (bf16*)(ws + WS_MB); bf16* YCAT = (bf16*)(ws + WS_YCAT); bf16* H = (bf16*)(ws + WS_H);
    float* SS1 = (float*)(ws + WS_SS1); float* SS2 = (float*)(ws + WS_SS2);
    const int gw = F.vcu * NWAVES + F.wave, NGW = F.G * NWAVES;
    LAS unsigned char* wl = F.lds + F.wave * S5_WLDS;

    auto forward_ = [&]() __attribute__((always_inline)) {
    p0_prologue(F);
    if (PROBE == 1) { __syncthreads(); p0_prologue(F); }
    if (args.ws == nullptr) grid.sync();
    GRID_BAR();
    { pg8::Gemm g{XN, (const bf16*)(ws + WS_WIN), LDP, LDP, 2048, 0}; pg8::RemSplit S; S.init(35, 8, 16, 8, F.G, (int)blockIdx.x);
      pg8::EpiBf16 E{U, 2048}; const pg8::SKBuf sk{(float*)(ws + WS_SLOTS), (unsigned*)(ws + WS_FLAGS), (int)blockIdx.x};
      pg8::gemm_phase<pg8::EpiBf16, pg8::RemSplit, true, true, true>(F.lds, g, S, E, sk); GRID_BAR(); pg8::gemm_reduce(S, E, sk);
      if (PROBE == 4) { GRID_BAR(); pg8::gemm_phase<pg8::EpiBf16, pg8::RemSplit, true, true, true>(F.lds, g, S, E, sk); GRID_BAR(); pg8::gemm_reduce(S, E, sk); } }
    GRID_BAR();
    for (int it = gw; it < 2 * 64 * NSEG; it += NGW) s5_prompt_item<false>(F, wl, it, ltid() & 63);
    for (int it = gw; it < DECB * 64; it += NGW) s5_sample_item(F, wl, it, ltid() & 63);
    pool_m_phase(F);
    if (PROBE == 2) { __syncthreads();
        for (int it = gw; it < 2 * 64 * NSEG; it += NGW) s5_prompt_item<false>(F, wl, it, ltid() & 63);
        for (int it = gw; it < DECB * 64; it += NGW) s5_sample_item(F, wl, it, ltid() & 63);
        pool_m_phase(F); }
    GRID_BAR();
    for (int it = gw; it < 2 * 64 * NSEG; it += NGW) s5_prompt_item<true>(F, wl, it, ltid() & 63);
    if (PROBE == 2) { for (int it = gw; it < 2 * 64 * NSEG; it += NGW) s5_prompt_item<true>(F, wl, it, ltid() & 63); }
    GRID_BAR();
    if (F.G > 140 + 35) {
        if ((int)blockIdx.x < 140) { pg8::Gemm g{YPRE, (const bf16*)(ws + WS_WGLU), 1024, 1024, 1024, 0}; pg8::StaticOrder S; S.init(35, 4, 16, 140, (int)blockIdx.x);
            pg8::EpiGlu E{YPRE, YCAT}; pg8::gemm_phase<pg8::EpiGlu, pg8::StaticOrder, true, true>(F.lds, g, S, E); }
        else { pg8::Gemm g{MB, (const bf16*)(ws + WS_WPOOL), 1024, 256, 256, 256}; pg8::StaticOrder S; S.init(35, 4, 4, F.G - 140, (int)blockIdx.x - 140);
            pg8::EpiPool E{YCAT, inp(F, 19)}; pg8::gemm_phase<pg8::EpiPool, pg8::StaticOrder, true, true>(F.lds, g, S, E); }
    } else {
        { pg8::Gemm g{MB, (const bf16*)(ws + WS_WPOOL), 1024, 256, 256, 256}; pg8::StaticOrder S; S.init(35, 4, 4, F.G, (int)blockIdx.x);
          pg8::EpiPool E{YCAT, inp(F, 19)}; pg8::gemm_phase<pg8::EpiPool, pg8::StaticOrder, true, true>(F.lds, g, S, E); }
        __syncthreads();
        { pg8::Gemm g{YPRE, (const bf16*)(ws + WS_WGLU), 1024, 1024, 1024, 0}; pg8::StaticOrder S; S.init(35, 4, 16, F.G, (int)blockIdx.x);
          pg8::EpiGlu E{YPRE, YCAT}; pg8::gemm_phase<pg8::EpiGlu, pg8::StaticOrder, true, true>(F.lds, g, S, E); }
    }
    GRID_BAR();
    if (PROBE == 12) { GRID_BAR();
        if ((int)blockIdx.x < 140) { pg8::Gemm g{YPRE, (const bf16*)(ws + WS_WGLU), 1024, 1024, 1024, 0}; pg8::StaticOrder S; S.init(35, 4, 16, 140, (int)blockIdx.x);
            pg8::EpiGlu E{YPRE, YCAT}; pg8::gemm_phase<pg8::EpiGlu, pg8::StaticOrder, true, true>(F.lds, g, S, E); }
        else { pg8::Gemm g{MB, (const bf16*)(ws + WS_WPOOL), 1024, 256, 256, 256}; pg8::StaticOrder S; S.init(35, 4, 4, F.G - 140, (int)blockIdx.x - 140);
            pg8::EpiPool E{YCAT, inp(F, 19)}; pg8::gemm_phase<pg8::EpiPool, pg8::StaticOrder, true, true>(F.lds, g, S, E); } }
    { pg8::Gemm g{YCAT, (const bf16*)(ws + WS_WOUT), LDP, LDP, 2048, 0}; pg8::RemSplit S; S.init(35, 8, 16, 8, F.G, (int)blockIdx.x);
      pg8::EpiOut E{SS2, inp(F, 7), inp(F, 21), XN, SS1};
      const pg8::SKBuf sk{(float*)(ws + WS_SLOTS), (unsigned*)(ws + WS_FLAGS) + 512, (int)blockIdx.x};
      pg8::gemm_phase<pg8::EpiOut, pg8::RemSplit, true, true, true>(F.lds, g, S, E, sk); GRID_BAR(); pg8::gemm_reduce(S, E, sk);
      if (PROBE == 11) { GRID_BAR(); for (int i = F.vcu * NTHREADS + ltid(); i < 9216; i += F.G * NTHREADS) SS1[i] = 0.f; GRID_BAR();
          pg8::gemm_phase<pg8::EpiOut, pg8::RemSplit, true, true, true>(F.lds, g, S, E, sk); GRID_BAR(); pg8::gemm_reduce(S, E, sk); } }
    GRID_BAR();
    gmeta_phase(F);
    { pg8::Gemm g{XN, (const bf16*)(ws + WS_WUP), LDP, LDP, 2048, 0}; pg8::StaticOrder S; S.init(34, 44, 32, F.G, (int)blockIdx.x);
      pg8::EpiUp E{SS1, inp(F, 23), inp(F, 24), H, (float*)(ws + WS_GFIX), (float*)(ws + WS_VFIX), (float*)(ws + WS_GSRC), F.out + O_CONV_P, F.out + O_CONV_S};
      pg8::gemm_phase<pg8::EpiUp, pg8::StaticOrder, true, true>(F.lds, g, S, E);
      if (PROBE == 3) { __syncthreads(); pg8::gemm_phase<pg8::EpiUp, pg8::StaticOrder, true, true>(F.lds, g, S, E); }
      if (PROBE == 13) { __syncthreads(); pg8::EpiBf16 E2{(bf16*)(ws + WS_FA), 0}; pg8::gemm_phase<pg8::EpiBf16, pg8::StaticOrder, true, true>(F.lds, g, S, E2); } }
    if (F.G == 256 && (int)blockIdx.x >= 216) { __syncthreads(); p0_convert(F, I_EARLY, I_EARLY + I_DOWN, ((int)blockIdx.x - 216) * NWAVES + F.wave, 40 * NWAVES, ltid() & 63); }
    GRID_BAR();
    fixup_phase(F);
    GRID_BAR();
    { pg8::Gemm g{H, (const bf16*)(ws + WS_WDOWN), DFF, DFF, DFF, 0}; pg8::RemSplit S; S.init(34, 8, 44, 16, F.G, (int)blockIdx.x);
      pg8::EpiF E{(bf16*)(ws + WS_FA), (bf16*)(ws + WS_FB), F_SPLIT};
      const pg8::SKBuf sk{(float*)(ws + WS_SLOTS), (unsigned*)(ws + WS_FLAGS) + 768, (int)blockIdx.x};
      pg8::gemm_phase<pg8::EpiF, pg8::RemSplit, true, true, true>(F.lds, g, S, E, sk); GRID_BAR(); pg8::gemm_reduce(S, E, sk); }
    GRID_BAR();
    if (PROBE == 9) { GRID_BAR(); pg8::Gemm g{H, (const bf16*)(ws + WS_WDOWN), DFF, DFF, DFF, 0}; pg8::RemSplit S; S.init(34, 8, 44, 16, F.G, (int)blockIdx.x);
        const pg8::SKBuf sk{(float*)(ws + WS_SLOTS), (unsigned*)(ws + WS_FLAGS) + 768, (int)blockIdx.x}; pg8::EpiBf16 E{XN, 2048};
        pg8::gemm_phase<pg8::EpiBf16, pg8::RemSplit, true, true, true>(F.lds, g, S, E, sk); GRID_BAR(); pg8::gemm_reduce(S, E, sk); }
    if (PROBE == 10) { GRID_BAR(); const int gw2 = F.vcu * NWAVES + F.wave, lane2 = ltid() & 63;
        for (int R = gw2; R < R_REAL; R += F.G * NWAVES) { f32x4* xr = (f32x4*)(F.out + (size_t)R * DM) + lane2;
#pragma unroll
            for (int j = 0; j < 8; ++j) { f32x4 v = xr[64 * j]; asm volatile("" : "+v"(v)); xr[64 * j] = v; } } }
    if (PROBE == 6) { pg8::Gemm g{H, (const bf16*)(ws + WS_WDOWN), DFF, DFF, DFF, 0}; pg8::StaticOrder S; S.init(34, 8, 88, F.G, (int)blockIdx.x);
        pg8::EpiBf16 E{XN, 2048}; pg8::gemm_phase<pg8::EpiBf16, pg8::StaticOrder, true, true>(F.lds, g, S, E); }
    if (PROBE == 7) { GRID_BAR(); GRID_BAR(); GRID_BAR(); GRID_BAR(); GRID_BAR(); GRID_BAR(); GRID_BAR(); GRID_BAR(); }
    final_phase(F);
    if (TPROBE_A >= 0) { asm volatile("s_waitcnt vmcnt(0)" ::: "memory"); __syncthreads(); STAMP();
        if (blockIdx.x == 0 && threadIdx.x == 0) { volatile LAS unsigned long long* ts = (volatile LAS unsigned long long*)(F.lds + BARST_OFF + 128);
            const unsigned long long d = ts[TPROBE_B] - ts[TPROBE_A], t0 = __builtin_amdgcn_s_memrealtime();
            while (__builtin_amdgcn_s_memrealtime() - t0 < d) __builtin_amdgcn_s_sleep(8); } }
    };
    forward_();
    if (PROBE == 8) { GRID_BAR(); forward_(); }
}

extern "C" void kernel_launch(void* const* d_in, const int* in_sizes, int n_in, void* d_out, int out_size, void* d_ws, size_t ws_size, hipStream_t stream) {
    static int grid = 0;
    if (grid == 0) {
        if (n_in != 27 || out_size != 19009536 || ws_size < WS_END) { fprintf(stderr, "kernel_launch: unexpected shapes (n_in %d, out %d, ws %zu)\n", n_in, out_size, ws_size); grid = -1; return; }
        int dev = 0, cus = 0, per_cu = 0;
        if (hipGetDevice(&dev) != hipSuccess || hipDeviceGetAttribute(&cus, hipDeviceAttributeMultiprocessorCount, dev) != hipSuccess) { grid = -1; return; }
        if (hipFuncSetAttribute((const void*)hymba_fwd, hipFuncAttributeMaxDynamicSharedMemorySize, LDS_BYTES) != hipSuccess) { fprintf(stderr, "kernel_launch: hipFuncSetAttribute failed\n"); grid = -1; return; }
        if (hipOccupancyMaxActiveBlocksPerMultiprocessor(&per_cu, (const void*)hymba_fwd, NTHREADS, LDS_BYTES) != hipSuccess || per_cu < 1) { fprintf(stderr, "kernel_launch: occupancy query says %d\n", per_cu); per_cu = 1; }
        (void)hipGetLastError();
        grid = cus;
    }
    if (grid < 0) return;
    if (hipMemsetAsync((char*)d_ws + WS_BAR, 0, XCD_BAR_WORDS * 4, stream) != hipSuccess) { fprintf(stderr, "kernel_launch: memset of barrier words failed\n"); return; }
    Args a{};
    for (int i = 0; i < 27; ++i) a.in[i] = (const float*)d_in[i];
    a.out = (float*)d_out; a.ws = (unsigned char*)d_ws;
    void* kargs[] = {&a};
    hipError_t e = hipLaunchCooperativeKernel((const void*)hymba_fwd, dim3(grid), dim3(NTHREADS), kargs, LDS_BYTES, stream);
    if (e != hipSuccess) fprintf(stderr, "kernel_launch: cooperative launch failed: %s (grid %d)\n", hipGetErrorString(e), grid);
}
```

```cpp
#include <hip/hip_runtime.h>
#include <hip/hip_cooperative_groups.h>
#include <cstdio>
#include <cstdint>
namespace cg = cooperative_groups;

namespace pg8 {
#define PG8_LAS __attribute__((address_space(3)))
typedef unsigned short bf16_t;
typedef short bf16x8 __attribute__((ext_vector_type(8)));
typedef float f32x4 __attribute__((ext_vector_type(4)));
typedef float f32x2 __attribute__((ext_vector_type(2)));
typedef unsigned u32x4 __attribute__((ext_vector_type(4)));
typedef unsigned u32x2 __attribute__((ext_vector_type(2)));
constexpr int BM = 256, BK = 64, HALF = 128, HTB = HALF * BK * 2  , STAGE_BYTES = 8 * HTB, NXCD = 8, WGM = 8;

__host__ __device__ __forceinline__ int lds_byte(int r, int c) { const int st = (r >> 4) * 2 + (c >> 5), rr = r & 15, cc = c & 31, ob = rr * 64 + cc * 2; return st * 1024 + (ob ^ (((ob >> 9) & 1) << 5)); }
__host__ __device__ __forceinline__ void stage_rc(int b, int& R, int& C) { const int st = b / 1024, sb = b % 1024, swz = sb ^ (((sb >> 9) & 1) << 5); R = (st >> 1) * 16 + swz / 64; C = (st & 1) * 32 + (swz % 64) / 2; }
__host__ __device__ __forceinline__ int perm32(int rho) { const int n = rho >> 4, i = rho & 15; return 8 * (i >> 2) + 4 * n + (i & 3); }

struct Unit { int pm, pn, k0, nt, kind, nwait; };
struct Gemm {
    const bf16_t* A; const bf16_t* Bt; int lda, ldb, K, a_pn_off;
    __device__ __forceinline__ const char* abase(const Unit& u) const { return (const char*)(A + ((size_t)u.pm * BM * lda + (size_t)u.pn * a_pn_off + (size_t)u.k0 * BK)); }
    __device__ __forceinline__ const char* bbase(const Unit& u) const { return (const char*)(Bt + ((size_t)u.pn * BM * ldb + (size_t)u.k0 * BK)); }
};

struct StaticOrder {
    int nM, nN, nwg, G, c, ntile;
    __host__ __device__ void init(int nM_, int nN_, int ntile_, int G_, int c_) { nM = nM_; nN = nN_; nwg = nM * nN; ntile = ntile_; G = G_; c = c_; }
    __host__ __device__ bool next(int i, Unit& u) const { const long L = (long)i * G + c; if (L >= nwg) return false; map((int)L, u); return true; }
    __host__ __device__ bool map(int L, Unit& u) const {
        int wgid = L; { const int q = nwg / NXCD, r = nwg % NXCD, xcd = wgid % NXCD, off = wgid / NXCD; wgid = (xcd < r ? xcd * (q + 1) : r * (q + 1) + (xcd - r) * q) + off; }
        const int nig = WGM * nN, gid = wgid / nig, fm = gid * WGM, gsz = (nM - fm) < WGM ? (nM - fm) : WGM;
        u.pm = fm + ((wgid % nig) % gsz); u.pn = (wgid % nig) / gsz; u.k0 = 0; u.nt = ntile; u.kind = 0; u.nwait = 0; return true;
    }
    __device__ __forceinline__ void a_ready(const Unit&) const {}
    __device__ __forceinline__ void done(const Unit&) const {}
};

struct RemSplit {
    StaticOrder so; int q, R, S, P, c;
    __device__ void init(int nM_, int nN_, int P_, int S_, int G_, int c_) { so.init(nM_, nN_, 2 * P_, G_, c_); q = so.nwg / G_; R = so.nwg % G_; S = S_; P = P_; c = c_; }
    __device__ bool next(int i, Unit& u) const {
        if (c < R * S) { if (i == 0) { so.map(q * so.G + c / S, u); const int sl = c % S, lo = sl * P / S, hi = (sl + 1) * P / S; u.k0 = 2 * lo; u.nt = 2 * (hi - lo); u.kind = 1; return true; } i -= 1; }
        if (i >= q) return false; so.map(i * so.G + c, u); return true;
    }
    __device__ bool reducer(Unit& u, unsigned& mask, int& base) const {
        if (c >= R * S) return false; so.map(q * so.G + c / S, u); base = (c / S) * S; const int j = c % S;
        mask = S == 16 ? 1u << ((j >> 3) * 8 + ((j >> 1) & 3) * 2 + (j & 1)) : 3u << ((j >> 2) * 8 + (j & 3) * 2); return true;
    }
    __device__ __forceinline__ void a_ready(const Unit&) const {}
    __device__ __forceinline__ void done(const Unit&) const {}
};
struct SKBuf { float* slots; unsigned* flags; int v; };

__device__ __forceinline__ unsigned cvt_pk_bf16(float lo, float hi) { unsigned r; asm volatile("v_cvt_pk_bf16_f32 %0, %1, %2" : "=v"(r) : "v"(lo), "v"(hi)); return r; }
__device__ __forceinline__ float bflo(unsigned w) { return __uint_as_float(w << 16); }
__device__ __forceinline__ float bfhi(unsigned w) { return __uint_as_float(w & 0xffff0000u); }
__device__ __forceinline__ float gelu_tanh(float x) {
    const float u = x * (1.0f + 0.044715f * x * x);
    const float e = __builtin_amdgcn_exp2f(u * (-2.0f * 0.7978845608028654f * 1.4426950408889634f));
    return x * __builtin_amdgcn_rcpf(1.0f + e);
}
__device__ __forceinline__ float sigmoidf_(float x) { return __builtin_amdgcn_rcpf(1.0f + __builtin_amdgcn_exp2f(x * -1.4426950408889634f)); }

struct EpiBf16 {
    static constexpr bool PERM = true, AFTER_DRAIN = false;
    bf16_t* O; int ldc;
    __device__ __forceinline__ void operator()(const f32x4 (&acc)[2][2][4][2], const Unit& u, int wr, int wc, int fr, int fq, unsigned mask = 0xFFFFu) const {
        const int row0 = u.pm * BM + wr * 64 + fr; const int col0 = u.pn * BM + wc * 32 + 8 * fq;
#pragma unroll
        for (int ai = 0; ai < 2; ++ai)
#pragma unroll
            for (int m = 0; m < 4; ++m) { bf16_t* rowp = O + (size_t)(row0 + ai * HALF + m * 16) * ldc + col0;
#pragma unroll
                for (int bj = 0; bj < 2; ++bj) { if (!((mask >> (ai * 8 + m * 2 + bj)) & 1u)) continue; const f32x4 v0 = acc[ai][bj][m][0], v1 = acc[ai][bj][m][1];
                    u32x4 w; w.x = cvt_pk_bf16(v0[0], v0[1]); w.y = cvt_pk_bf16(v0[2], v0[3]); w.z = cvt_pk_bf16(v1[0], v1[1]); w.w = cvt_pk_bf16(v1[2], v1[3]);
                    *(u32x4*)(rowp + bj * HALF) = w; } }
    }
};
struct EpiF {
    static constexpr bool PERM = true, AFTER_DRAIN = false;
    bf16_t* Oa; bf16_t* Ob; int split;
    __device__ __forceinline__ void operator()(const f32x4 (&acc)[2][2][4][2], const Unit& u, int wr, int wc, int fr, int fq, unsigned mask = 0xFFFFu) const {
        const int rowt = u.pm * BM; bf16_t* base = rowt < split ? Oa + (size_t)rowt * 2048 : Ob + (size_t)(rowt - split) * 2048;
        const int row0 = wr * 64 + fr; const int col0 = u.pn * BM + wc * 32 + 8 * fq;
#pragma unroll
        for (int ai = 0; ai < 2; ++ai)
#pragma unroll
            for (int m = 0; m < 4; ++m) { bf16_t* rowp = base + (size_t)(row0 + ai * HALF + m * 16) * 2048 + col0;
#pragma unroll
                for (int bj = 0; bj < 2; ++bj) { if (!((mask >> (ai * 8 + m * 2 + bj)) & 1u)) continue; const f32x4 v0 = acc[ai][bj][m][0], v1 = acc[ai][bj][m][1];
                    u32x4 w; w.x = cvt_pk_bf16(v0[0], v0[1]); w.y = cvt_pk_bf16(v0[2], v0[3]); w.z = cvt_pk_bf16(v1[0], v1[1]); w.w = cvt_pk_bf16(v1[2], v1[3]);
                    *(u32x4*)(rowp + bj * HALF) = w; } }
    }
};
struct EpiPool {
    static constexpr bool PERM = true, AFTER_DRAIN = false;
    bf16_t* O; const float* scale;
    __device__ __forceinline__ void operator()(const f32x4 (&acc)[2][2][4][2], const Unit& u, int wr, int wc, int fr, int fq) const {
        const int row0 = u.pm * BM + wr * 64 + fr; const int c0 = u.pn * BM + wc * 32 + 8 * fq;
        f32x4 sv[2][2];
#pragma unroll
        for (int bj = 0; bj < 2; ++bj)
#pragma unroll
            for (int n = 0; n < 2; ++n) sv[bj][n] = *(const f32x4*)(scale + c0 + bj * HALF + 4 * n);
#pragma unroll
        for (int ai = 0; ai < 2; ++ai)
#pragma unroll
            for (int m = 0; m < 4; ++m) { bf16_t* rowp = O + (size_t)(row0 + ai * HALF + m * 16) * 2112 + 1024 + c0;
#pragma unroll
                for (int bj = 0; bj < 2; ++bj) { const f32x4 v0 = acc[ai][bj][m][0] * sv[bj][0], v1 = acc[ai][bj][m][1] * sv[bj][1];
                    u32x4 w; w.x = cvt_pk_bf16(v0[0], v0[1]); w.y = cvt_pk_bf16(v0[2], v0[3]); w.z = cvt_pk_bf16(v1[0], v1[1]); w.w = cvt_pk_bf16(v1[2], v1[3]);
                    *(u32x4*)(rowp + bj * HALF) = w; } }
    }
};
struct EpiGlu {
    static constexpr bool PERM = true, AFTER_DRAIN = false;
    const bf16_t* YP; bf16_t* O;
    __device__ __forceinline__ void operator()(const f32x4 (&acc)[2][2][4][2], const Unit& u, int wr, int wc, int fr, int fq) const {
        const int row0 = u.pm * BM + wr * 64 + fr; const int c0 = u.pn * BM + wc * 32 + 8 * fq;
        u32x4 yp[2][4][2];
#pragma unroll
        for (int ai = 0; ai < 2; ++ai)
#pragma unroll
            for (int m = 0; m < 4; ++m)
#pragma unroll
                for (int bj = 0; bj < 2; ++bj) yp[ai][m][bj] = *(const u32x4*)(YP + (size_t)(row0 + ai * HALF + m * 16) * 1024 + c0 + bj * HALF);
#pragma unroll
        for (int ai = 0; ai < 2; ++ai)
#pragma unroll
            for (int m = 0; m < 4; ++m) { const size_t R = (size_t)(row0 + ai * HALF + m * 16);
#pragma unroll
                for (int bj = 0; bj < 2; ++bj) { const u32x4 y = yp[ai][m][bj];
                    const f32x4 a = acc[ai][bj][m][0], b = acc[ai][bj][m][1];
                    u32x4 w;
                    w.x = cvt_pk_bf16(bflo(y.x) * sigmoidf_(a[0]), bfhi(y.x) * sigmoidf_(a[1]));
                    w.y = cvt_pk_bf16(bflo(y.y) * sigmoidf_(a[2]), bfhi(y.y) * sigmoidf_(a[3]));
                    w.z = cvt_pk_bf16(bflo(y.z) * sigmoidf_(b[0]), bfhi(y.z) * sigmoidf_(b[1]));
                    w.w = cvt_pk_bf16(bflo(y.w) * sigmoidf_(b[2]), bfhi(y.w) * sigmoidf_(b[3]));
                    *(u32x4*)(O + R * 2112 + c0 + bj * HALF) = w; } }
    }
};
constexpr int R_SAMPLE0 = 8192, R_REAL = 8704, R_ALL = 8736, R_PAD = 8960;
constexpr int LDP = 2112;
struct EpiOut {
    static constexpr bool PERM = false, AFTER_DRAIN = false;
    const float *irs0, *gmix, *gffn; bf16_t* XN; float* ss;
    __device__ __forceinline__ void operator()(const f32x4 (&acc)[2][2][4][2], const Unit& u, int wr, int wc, int fr, int fq, unsigned mask = 0xFFFFu) const {
        const int col0 = u.pn * BM + wc * 32 + 4 * fq;
        f32x4 gv[2][2], rm[2][2];
#pragma unroll
        for (int bj = 0; bj < 2; ++bj)
#pragma unroll
            for (int n = 0; n < 2; ++n) { gv[bj][n] = *(const f32x4*)(gffn + col0 + bj * HALF + n * 16); const f32x4 g = *(const f32x4*)(gmix + col0 + bj * HALF + n * 16); rm[bj][n] = (f32x4){1.0f / g[0], 1.0f / g[1], 1.0f / g[2], 1.0f / g[3]}; }
#pragma unroll
        for (int ai = 0; ai < 2; ++ai)
#pragma unroll
            for (int m = 0; m < 4; ++m) { if (!((mask >> (ai * 8 + m * 2)) & 3u)) continue; const int R = u.pm * BM + ai * HALF + wr * 64 + m * 16 + fr; float s = 0.f;
                if (R < R_ALL) {
                    const float ir = irs0[R];
                    bf16_t* xn = XN + (size_t)R * LDP;
#pragma unroll
                    for (int bj = 0; bj < 2; ++bj)
#pragma unroll
                        for (int n = 0; n < 2; ++n) { if (!((mask >> (ai * 8 + m * 2 + bj)) & 1u)) continue; const int c = col0 + bj * HALF + n * 16; const u32x2 xq = *(const u32x2*)(xn + c);
                            const f32x4 x1 = (f32x4){bflo(xq.x), bfhi(xq.x), bflo(xq.y), bfhi(xq.y)} * rm[bj][n] * ir + acc[ai][bj][m][n];
                            s += (x1[0] * x1[0] + x1[1] * x1[1]) + (x1[2] * x1[2] + x1[3] * x1[3]);
                            const f32x4 xg = x1 * gv[bj][n]; u32x2 w; w.x = cvt_pk_bf16(xg[0], xg[1]); w.y = cvt_pk_bf16(xg[2], xg[3]); *(u32x2*)(xn + c) = w; }
                }
                s += __shfl_xor(s, 16); s += __shfl_xor(s, 32);
                if (fq == 0 && R < R_ALL) atomicAdd(ss + R, s); }
    }
};
struct EpiDown {
    static constexpr bool PERM = false, AFTER_DRAIN = false;
    float* out; float* ss;
    __device__ __forceinline__ void operator()(const f32x4 (&acc)[2][2][4][2], const Unit& u, int wr, int wc, int fr, int fq, unsigned mask = 0xFFFFu) const {
        const int col0 = u.pn * BM + wc * 32 + 4 * fq;
#pragma unroll
        for (int ai = 0; ai < 2; ++ai)
#pragma unroll
            for (int m = 0; m < 4; ++m) { if (!((mask >> (ai * 8 + m * 2)) & 3u)) continue; const int R = u.pm * BM + ai * HALF + wr * 64 + m * 16 + fr; float s = 0.f; float* dst = out + (size_t)R * 2048;
#pragma unroll
                for (int bj = 0; bj < 2; ++bj)
#pragma unroll
                    for (int n = 0; n < 2; ++n) { if (!((mask >> (ai * 8 + m * 2 + bj)) & 1u)) continue; const int c = col0 + bj * HALF + n * 16; const f32x4 x2 = *(const f32x4*)(dst + c) + acc[ai][bj][m][n];
                        *(f32x4*)(dst + c) = x2; s += (x2[0] * x2[0] + x2[1] * x2[1]) + (x2[2] * x2[2] + x2[3] * x2[3]); }
                s += __shfl_xor(s, 16); s += __shfl_xor(s, 32);
                if (fq == 0) atomicAdd(ss + R, s); }
    }
};
constexpr int DFF = 5632;
struct EpiUp {
    static constexpr bool PERM = true, AFTER_DRAIN = false;
    const float* ss; const float *cw, *cb; bf16_t* H; float *gfix, *vfix, *gsrc; float *conv_p, *conv_s;
    __device__ __forceinline__ void operator()(const f32x4 (&acc)[2][2][4][2], const Unit& u, int wr, int wc, int fr, int fq) const {
        const int j0 = u.pn * HALF + wc * 32 + 8 * fq;
        const bool samp = u.pm >= 32;
        const bool is15 = fr == 15, ge14 = fr >= 14;
        float rs[2][4];
#pragma unroll
        for (int ai = 0; ai < 2; ++ai)
#pragma unroll
            for (int m = 0; m < 4; ++m) rs[ai][m] = ss[u.pm * BM + ai * HALF + wr * 64 + m * 16 + fr];
        f32x4 w0[2], w1[2], w2[2], b0[2];
#pragma unroll
        for (int h = 0; h < 2; ++h) { w0[h] = *(const f32x4*)(cw + j0 + 4 * h); w1[h] = *(const f32x4*)(cw + DFF + j0 + 4 * h); w2[h] = *(const f32x4*)(cw + 2 * DFF + j0 + 4 * h); b0[h] = *(const f32x4*)(cb + j0 + 4 * h); }
#pragma unroll
        for (int ai = 0; ai < 2; ++ai) {
            f32x4 pp[2] = {(f32x4){0.f, 0.f, 0.f, 0.f}, (f32x4){0.f, 0.f, 0.f, 0.f}};
#pragma unroll
            for (int m = 0; m < 4; ++m) {
                const int rt = ai * HALF + wr * 64 + m * 16 + fr; const int R = u.pm * BM + rt;
                const float rstd = rsqrtf(rs[ai][m] * (1.0f / 2048.0f) + 1e-6f);
                f32x4 g4[2], v4[2], h4[2];
#pragma unroll
                for (int h = 0; h < 2; ++h) {
                    g4[h] = acc[ai][0][m][h] * rstd; v4[h] = acc[ai][1][m][h] * rstd;
                    f32x4 t1, t2, p1, p2;
#pragma unroll
                    for (int e = 0; e < 4; ++e) { t1[e] = is15 ? pp[h][e] : g4[h][e]; t2[e] = ge14 ? pp[h][e] : g4[h][e];
                        p1[e] = __int_as_float(__builtin_amdgcn_update_dpp(0, __float_as_int(t1[e]), 0x121, 0xf, 0xf, false));
                        p2[e] = __int_as_float(__builtin_amdgcn_update_dpp(0, __float_as_int(t2[e]), 0x122, 0xf, 0xf, false)); }
                    const f32x4 gc = b0[h] + p2 * w0[h] + p1 * w1[h] + g4[h] * w2[h];
                    const f32x4 uu = gc * (gc * gc * 0.044715f + 1.0f);
                    const f32x4 ee = uu * (-2.0f * 0.7978845608028654f * 1.4426950408889634f);
                    f32x4 dn;
#pragma unroll
                    for (int e = 0; e < 4; ++e) dn[e] = __builtin_amdgcn_rcpf(1.0f + __builtin_amdgcn_exp2f(ee[e]));
                    h4[h] = gc * dn * v4[h];
                }
                u32x4 w; w.x = cvt_pk_bf16(h4[0][0], h4[0][1]); w.y = cvt_pk_bf16(h4[0][2], h4[0][3]); w.z = cvt_pk_bf16(h4[1][0], h4[1][1]); w.w = cvt_pk_bf16(h4[1][2], h4[1][3]);
                *(u32x4*)(H + (size_t)R * DFF + j0) = w;
                const float gg[8] = {g4[0][0], g4[0][1], g4[0][2], g4[0][3], g4[1][0], g4[1][1], g4[1][2], g4[1][3]};
                const float vv[8] = {v4[0][0], v4[0][1], v4[0][2], v4[0][3], v4[1][0], v4[1][1], v4[1][2], v4[1][3]};
                const f32x4 gA = {gg[0], gg[1], gg[2], gg[3]}, gB = {gg[4], gg[5], gg[6], gg[7]};
                if (fr < 2 && (m == 0 || samp)) {
                    const int id = samp ? 256 + (u.pm - 32) * 32 + (rt >> 4) * 2 + fr : u.pm * 8 + (rt >> 6) * 2 + fr;
                    float* gp = gfix + (size_t)id * DFF + j0; float* vp = vfix + (size_t)id * DFF + j0;
                    *(f32x4*)gp = gA; *(f32x4*)(gp + 4) = gB;
                    *(f32x4*)vp = (f32x4){vv[0], vv[1], vv[2], vv[3]}; *(f32x4*)(vp + 4) = (f32x4){vv[4], vv[5], vv[6], vv[7]};
                }
                if (fr >= 14) {
                    if (samp) { float* cp = conv_s + (size_t)(((R - R_SAMPLE0) >> 4) * 2 + (fr - 14)) * DFF + j0; *(f32x4*)cp = gA; *(f32x4*)(cp + 4) = gB; }
                    else if (m == 3) {
                        float* sp = gsrc + (size_t)(u.pm * 8 + (rt >> 6) * 2 + (fr - 14)) * DFF + j0; *(f32x4*)sp = gA; *(f32x4*)(sp + 4) = gB;
                        if ((R & 4095) >= 4094) { float* cp = conv_p + (size_t)((R >> 12) * 2 + ((R & 4095) - 4094)) * DFF + j0; *(f32x4*)cp = gA; *(f32x4*)(cp + 4) = gB; }
                    }
                }
                pp[0] = g4[0]; pp[1] = g4[1];
            }
        }
    }
};

template <class Epi, class Sched, bool ALIGN_EPI = false, bool SP2 = false, bool STREAMK = false>
__device__ __forceinline__ void gemm_phase(PG8_LAS unsigned char* lds, const Gemm g, const Sched& S, const Epi& E, const SKBuf sk = SKBuf{nullptr, nullptr, 0}) {
    int tid_ = threadIdx.x; asm volatile("" : "+v"(tid_));
    const int tid = tid_, wid = __builtin_amdgcn_readfirstlane(tid >> 6), lane = tid & 63, wr = wid >> 2, wc = wid & 3, fr = lane & 15, fq = lane >> 4;
    unsigned voffA[2], voffB[2];
#pragma unroll
    for (int i = 0; i < 2; ++i) { int R, C; stage_rc(tid * 16 + i * 8192, R, C); const int Rb = Epi::PERM ? ((R & ~31) + perm32(R & 31)) : R;
        voffA[i] = (unsigned)(R * g.lda + C) * 2u; voffB[i] = (unsigned)(Rb * g.ldb + C) * 2u; }
    const size_t kstep = (size_t)(BK * 2);
    const size_t hstepA = (size_t)HALF * g.lda * 2, hstepB = (size_t)HALF * g.ldb * 2;
    const unsigned ldsw = (unsigned)wid * 1024u;
    const int aoff = lds_byte(wr * 64 + fr, fq * 8), boff = lds_byte(wc * 32 + fr, fq * 8);
#define PG8_SA(b, h) (((b) * 2 + (h)) * HTB)
#define PG8_SB(b, h) ((4 + (b) * 2 + (h)) * HTB)
#define PG8_STAGE(bufoff, gbase, voff) do { _Pragma("unroll") for (int _i = 0; _i < 2; ++_i) \
        __builtin_amdgcn_global_load_lds((const unsigned*)((const char*)(gbase) + (voff)[_i]), (PG8_LAS unsigned*)(lds + (bufoff) + ldsw + _i * 8192), 16, 0, 0); } while (0)
#define PG8_LDA(dst, b, h) do { _Pragma("unroll") for (int m = 0; m < 4; ++m) _Pragma("unroll") for (int k = 0; k < 2; ++k) dst[m][k] = *(const PG8_LAS bf16x8*)(lds + PG8_SA(b, h) + aoff + m * 2048 + k * 1024); } while (0)
#define PG8_LDB(dst, b, h) do { _Pragma("unroll") for (int n = 0; n < 2; ++n) _Pragma("unroll") for (int k = 0; k < 2; ++k) dst[n][k] = *(const PG8_LAS bf16x8*)(lds + PG8_SB(b, h) + boff + n * 2048 + k * 1024); } while (0)
#define PG8_MMA(ai, bj, At, Bt) do { __builtin_amdgcn_s_setprio(1); _Pragma("unroll") for (int m = 0; m < 4; ++m) _Pragma("unroll") for (int n = 0; n < 2; ++n) _Pragma("unroll") for (int k = 0; k < 2; ++k) \
        acc[ai][bj][m][n] = __builtin_amdgcn_mfma_f32_16x16x32_bf16(Bt[n][k], At[m][k], acc[ai][bj][m][n], 0, 0, 0); __builtin_amdgcn_s_setprio(0); } while (0)
#define PG8_WAIT_V(n) asm volatile("s_waitcnt vmcnt(" #n ")" ::: "memory")
#define PG8_WAIT_L(n) asm volatile("s_waitcnt lgkmcnt(" #n ")" ::: "memory")
#define PG8_BAR __builtin_amdgcn_s_barrier()
#define PG8_SCHED __builtin_amdgcn_sched_barrier(0)
    Unit cur, nxt; int ui = 0;
    if (!S.next(0, cur)) return;
    f32x4 acc[2][2][4][2];
#pragma unroll
    for (int a = 0; a < 2; ++a)
#pragma unroll
        for (int b = 0; b < 2; ++b)
#pragma unroll
            for (int m = 0; m < 4; ++m)
#pragma unroll
                for (int n = 0; n < 2; ++n) acc[a][b][m][n] = (f32x4){0.f, 0.f, 0.f, 0.f};
    bf16x8 At[4][2], B0[2][2], B1[2][2];
    const char* cA = g.abase(cur); const char* cB = g.bbase(cur);
    S.a_ready(cur);
    if constexpr (SP2) {
        PG8_STAGE(PG8_SB(0, 0), cB, voffB); PG8_STAGE(PG8_SB(0, 1), cB + hstepB, voffB); PG8_STAGE(PG8_SA(0, 0), cA, voffA); PG8_STAGE(PG8_SA(0, 1), cA + hstepA, voffA);
        if (wr == 1) PG8_BAR;
        PG8_WAIT_V(2); PG8_BAR;
        PG8_STAGE(PG8_SB(1, 0), cB + kstep, voffB); PG8_STAGE(PG8_SA(1, 0), cA + kstep, voffA); PG8_STAGE(PG8_SB(1, 1), cB + hstepB + kstep, voffB);
        PG8_WAIT_V(6); PG8_BAR;
    } else {
        PG8_STAGE(PG8_SB(0, 0), cB, voffB); PG8_STAGE(PG8_SA(0, 0), cA, voffA); PG8_STAGE(PG8_SB(0, 1), cB + hstepB, voffB); PG8_STAGE(PG8_SA(0, 1), cA + hstepA, voffA);
        if (wr == 1) PG8_BAR;
        PG8_WAIT_V(4); PG8_BAR;
        PG8_STAGE(PG8_SB(1, 0), cB + kstep, voffB); PG8_STAGE(PG8_SA(1, 0), cA + kstep, voffA); PG8_STAGE(PG8_SB(1, 1), cB + hstepB + kstep, voffB);
        PG8_WAIT_V(6); PG8_BAR;
    }
    for (;;) {
        const bool has_next = S.next(ui + 1, nxt);
        const char* nA = has_next ? g.abase(nxt) : cA; const char* nB = has_next ? g.bbase(nxt) : cB;
        const int nt = cur.nt;
        for (int t = 0; t < nt; t += 2) {
            const bool last = (t == nt - 2);
            const char* a1 = cA + (size_t)(t + 1) * kstep;
            const char* a2 = last ? nA : cA + (size_t)(t + 2) * kstep; const char* b2 = last ? nB : cB + (size_t)(t + 2) * kstep;
            const char* a3 = a2 + kstep; const char* b3 = b2 + kstep;
            if (last && has_next) S.a_ready(nxt);
            if constexpr (SP2) {
            PG8_LDB(B0, 0, 0); PG8_LDB(B1, 0, 1); PG8_SCHED; PG8_LDA(At, 0, 0); PG8_STAGE(PG8_SA(1, 1), a1 + hstepA, voffA);
            PG8_WAIT_V(8); PG8_WAIT_L(0); PG8_BAR; PG8_MMA(0, 0, At, B0); PG8_MMA(0, 1, At, B1); PG8_BAR; PG8_SCHED;
            PG8_LDA(At, 0, 1); PG8_STAGE(PG8_SB(0, 0), b2, voffB); PG8_STAGE(PG8_SB(0, 1), b2 + hstepB, voffB); PG8_STAGE(PG8_SA(0, 0), a2, voffA);
            PG8_WAIT_V(8); PG8_WAIT_L(0); PG8_BAR; PG8_MMA(1, 0, At, B0); PG8_MMA(1, 1, At, B1); PG8_BAR; PG8_SCHED;
            PG8_LDB(B0, 1, 0); PG8_LDB(B1, 1, 1); PG8_SCHED; PG8_LDA(At, 1, 0); PG8_STAGE(PG8_SA(0, 1), a2 + hstepA, voffA);
            PG8_WAIT_V(8); PG8_WAIT_L(0); PG8_BAR; PG8_MMA(0, 0, At, B0); PG8_MMA(0, 1, At, B1); PG8_BAR; PG8_SCHED;
            PG8_LDA(At, 1, 1); PG8_STAGE(PG8_SB(1, 0), b3, voffB); PG8_STAGE(PG8_SB(1, 1), b3 + hstepB, voffB); PG8_STAGE(PG8_SA(1, 0), a3, voffA);
            PG8_WAIT_V(8); PG8_WAIT_L(0); PG8_BAR; PG8_MMA(1, 0, At, B0); PG8_MMA(1, 1, At, B1); PG8_BAR; PG8_SCHED;
            } else {
            PG8_LDB(B0, 0, 0); PG8_SCHED; PG8_LDA(At, 0, 0); PG8_STAGE(PG8_SA(1, 1), a1 + hstepA, voffA);
            PG8_WAIT_L(8); PG8_BAR; PG8_WAIT_L(0); PG8_MMA(0, 0, At, B0); PG8_BAR; PG8_SCHED;
            PG8_LDB(B1, 0, 1); PG8_STAGE(PG8_SB(0, 0), b2, voffB);
            PG8_BAR; PG8_WAIT_L(0); PG8_MMA(0, 1, At, B1); PG8_BAR;
            PG8_LDA(At, 0, 1); PG8_STAGE(PG8_SA(0, 0), a2, voffA);
            PG8_BAR; PG8_WAIT_L(0); PG8_MMA(1, 0, At, B0); PG8_BAR; PG8_SCHED;
            PG8_STAGE(PG8_SB(0, 1), b2 + hstepB, voffB);
            PG8_WAIT_V(6); PG8_BAR; PG8_MMA(1, 1, At, B1); PG8_BAR;
            PG8_LDB(B0, 1, 0); PG8_SCHED; PG8_LDA(At, 1, 0); PG8_STAGE(PG8_SA(0, 1), a2 + hstepA, voffA);
            PG8_WAIT_L(8); PG8_BAR; PG8_WAIT_L(0); PG8_MMA(0, 0, At, B0); PG8_BAR; PG8_SCHED;
            PG8_LDB(B1, 1, 1); PG8_STAGE(PG8_SB(1, 0), b3, voffB);
            PG8_BAR; PG8_WAIT_L(0); PG8_MMA(0, 1, At, B1); PG8_BAR;
            PG8_LDA(At, 1, 1); PG8_STAGE(PG8_SA(1, 0), a3, voffA);
            PG8_BAR; PG8_WAIT_L(0); PG8_MMA(1, 0, At, B0); PG8_BAR; PG8_SCHED;
            PG8_STAGE(PG8_SB(1, 1), b3 + hstepB, voffB);
            PG8_WAIT_V(6); PG8_BAR; PG8_MMA(1, 1, At, B1); PG8_BAR;
            }
        }
        if constexpr (ALIGN_EPI) { if (wr == 0) PG8_BAR; }
        if constexpr (STREAMK) {
            if (cur.kind == 1) {
                __attribute__((address_space(1))) unsigned* p = (__attribute__((address_space(1))) unsigned*)sk.slots + (size_t)sk.v * 32768 + (size_t)tid * 4;
#pragma unroll
                for (int a = 0; a < 2; ++a)
#pragma unroll
                    for (int b = 0; b < 2; ++b)
#pragma unroll
                        for (int m = 0; m < 4; ++m) { const f32x4 v0 = acc[a][b][m][0], v1 = acc[a][b][m][1];
                            u32x4 w; w.x = cvt_pk_bf16(v0[0], v0[1]); w.y = cvt_pk_bf16(v0[2], v0[3]); w.z = cvt_pk_bf16(v1[0], v1[1]); w.w = cvt_pk_bf16(v1[2], v1[3]);
                            *(__attribute__((address_space(1))) u32x4*)p = w; p += 2048; asm volatile("" : "+v"(p)); }
            } else {
                E(acc, cur, wr, wc, fr, fq);
            }
        } else
        if constexpr (!Epi::AFTER_DRAIN) { E(acc, cur, wr, wc, fr, fq); S.done(cur); }
        if (!has_next) break;
#pragma unroll
        for (int a = 0; a < 2; ++a)
#pragma unroll
            for (int b = 0; b < 2; ++b)
#pragma unroll
                for (int m = 0; m < 4; ++m)
#pragma unroll
                    for (int n = 0; n < 2; ++n) acc[a][b][m][n] = (f32x4){0.f, 0.f, 0.f, 0.f};
        cur = nxt; cA = nA; cB = nB; ++ui;
        if constexpr (ALIGN_EPI) { if (wr == 1) PG8_BAR; }
    }
    PG8_WAIT_V(0);
    if constexpr (!ALIGN_EPI) { if (wr == 0) PG8_BAR; }
    PG8_BAR;
    if constexpr (Epi::AFTER_DRAIN) { E.fused(acc, cur, wr, wc, fr, fq, lds, wid, lane); S.done(cur); }
#undef PG8_SA
#undef PG8_SB
#undef PG8_STAGE
#undef PG8_LDA
#undef PG8_LDB
#undef PG8_MMA
#undef PG8_WAIT_V
#undef PG8_WAIT_L
#undef PG8_BAR
#undef PG8_SCHED
}

template <class Epi, class Sched>
__device__ __forceinline__ void gemm_reduce(const Sched& S, const Epi& E, const SKBuf sk) {
    int tid_ = threadIdx.x; asm volatile("" : "+v"(tid_));
    const int tid = tid_, wid = __builtin_amdgcn_readfirstlane(tid >> 6), lane = tid & 63, wr = wid >> 2, wc = wid & 3, fr = lane & 15, fq = lane >> 4;
    Unit ru; unsigned mask; int base;
    if (!S.reducer(ru, mask, base)) return;
    const unsigned* sb = (const unsigned*)sk.slots + (size_t)base * 32768 + (size_t)tid * 4;
    f32x4 racc[2][2][4][2];
#pragma unroll
    for (int a = 0; a < 2; ++a)
#pragma unroll
        for (int b = 0; b < 2; ++b)
#pragma unroll
            for (int m = 0; m < 4; ++m)
#pragma unroll
                for (int n = 0; n < 2; ++n) racc[a][b][m][n] = (f32x4){0.f, 0.f, 0.f, 0.f};
#pragma unroll
    for (int a = 0; a < 2; ++a)
#pragma unroll
        for (int m = 0; m < 4; ++m)
#pragma unroll
            for (int b = 0; b < 2; ++b)
                if ((mask >> (a * 8 + m * 2 + b)) & 1u) {
                    f32x4 r0 = (f32x4){0.f, 0.f, 0.f, 0.f}, r1 = r0; const unsigned* p = sb + (size_t)(((a * 2 + b) * 4 + m) * 2048);
                    for (int s8 = 0; s8 < S.S; s8 += 8) {
                        u32x4 t[8];
#pragma unroll
                        for (int k = 0; k < 8; ++k) t[k] = *(const u32x4*)(p + (size_t)k * 32768);
#pragma unroll
                        for (int k = 0; k < 8; ++k) { r0 += (f32x4){bflo(t[k].x), bfhi(t[k].x), bflo(t[k].y), bfhi(t[k].y)}; r1 += (f32x4){bflo(t[k].z), bfhi(t[k].z), bflo(t[k].w), bfhi(t[k].w)}; }
                        p += 8 * 32768; }
                    racc[a][b][m][0] = r0; racc[a][b][m][1] = r1;
                }
    E(racc, ru, wr, wc, fr, fq, mask);
}
}

#define GAS __attribute__((address_space(1)))
#define LAS __attribute__((address_space(3)))
typedef unsigned short bf16;
typedef unsigned v4u __attribute__((ext_vector_type(4)));
typedef unsigned v2u __attribute__((ext_vector_type(2)));
typedef float f32x4 __attribute__((ext_vector_type(4)));
typedef float f32x16 __attribute__((ext_vector_type(16)));
typedef short bf16x8 __attribute__((ext_vector_type(8)));
constexpr int NWAVES = 8, NTHREADS = 512;
constexpr int DM = 2048, SEQ = 4096, NMETA = 16, DECB = 32, DECL = 16;
constexpr int NG = 64, NS = 64, DFF = 5632;
constexpr int R_SAMPLE0 = 8192, R_REAL = 8704, R_ALL = 8736, R_PAD = 8960;
constexpr float RMS_EPS = 1e-6f;
constexpr int NSEG = 16;
constexpr size_t O_Y = 0, O_SRE_P = 17825792, O_SIM_P = 17833984, O_POOL_P = 17842176, O_CONV_P = 17872896,
                 O_SRE_S = 17895424, O_SIM_S = 18026496, O_POOL_S = 18157568, O_CONV_S = 18649088;
constexpr size_t MiB = 1u << 20;
constexpr int LDP = 2112;
constexpr size_t WS_WIN = 0, WS_WGLU = 9 * MiB, WS_WPOOL = 11 * MiB, WS_WOUT = 12 * MiB, WS_WUP = 21 * MiB, WS_WDOWN = 67 * MiB;
constexpr size_t WS_XN = 89 * MiB, WS_U = 126 * MiB, WS_YPRE = 161 * MiB, WS_MB = 179 * MiB, WS_YCAT = 197 * MiB;
constexpr size_t WS_H = 126 * MiB;
constexpr size_t WS_SMALL = 234 * MiB;
constexpr size_t WS_XMETA = WS_SMALL, WS_SS1 = WS_XMETA + 32 * 2048 * 4, WS_SS2 = WS_SS1 + 36864, WS_LBAR = WS_SS2 + 36864, WS_PW = WS_LBAR + 32768,
                 WS_BB = WS_PW + 32768, WS_CC = WS_BB + 262144, WS_EST = WS_CC + 262144, WS_GMETA = WS_EST + 2 * 64 * 16 * 64 * 8;
constexpr size_t WS_GFIX = 238 * MiB, WS_VFIX = 245 * MiB, WS_GSRC = 252 * MiB, WS_SLOTS = 258 * MiB, WS_FLAGS = 322 * MiB, WS_BAR = 322 * MiB + 65536, WS_FA = 323 * MiB, WS_FB = 0, WS_END = 351 * MiB;
static_assert(WS_GMETA + 4 * DFF * 4 <= WS_GFIX && WS_H + (size_t)R_REAL * DFF * 2 <= WS_YCAT + (size_t)R_PAD * LDP * 2 && WS_YCAT + (size_t)R_PAD * LDP * 2 <= WS_SMALL && 320 * (size_t)DFF * 4 <= 7 * MiB
              && WS_XN + (size_t)R_PAD * LDP * 2 <= WS_U && WS_WUP + (size_t)11264 * LDP * 2 <= WS_WDOWN && WS_WIN + (size_t)2048 * LDP * 2 <= WS_WGLU && WS_WOUT + (size_t)2048 * LDP * 2 <= WS_WUP, "ws map");
constexpr int F_SPLIT = 7168;
constexpr int LDS_BYTES = 147456;
constexpr int S5_WLDS = 32 * 528;

__device__ __forceinline__ unsigned f2bf(float f) { unsigned u = __builtin_bit_cast(unsigned, f); return (u + 0x7fffu + ((u >> 16) & 1u)) >> 16; }
__device__ __forceinline__ unsigned pk2(float lo, float hi) { return f2bf(lo) | (f2bf(hi) << 16); }
__device__ __forceinline__ float blo(unsigned w) { return __uint_as_float(w << 16); }
__device__ __forceinline__ float bhi(unsigned w) { return __uint_as_float(w & 0xffff0000u); }
#define LDS_WAIT() asm volatile("s_waitcnt lgkmcnt(0)" ::: "memory")

#define XB_TMO      128
#define XB_XCNT(j)  (256  + 64 * (j))
#define XB_XSUB(j)  (1280 + 64 * (j))
#define XB_XGEN(j)  (2304 + 64 * (j))
#define XB_TOP      3328
#define XB_TOPGEN   3392
#define XCD_BAR_WORDS 3456
#define XB_SPIN_CAP (1u << 18)

__device__ __forceinline__ unsigned xb_ld(unsigned* p)              { return __hip_atomic_load(p, __ATOMIC_RELAXED, __HIP_MEMORY_SCOPE_AGENT); }
__device__ __forceinline__ unsigned xb_add(unsigned* p, unsigned v) { return __hip_atomic_fetch_add(p, v, __ATOMIC_RELAXED, __HIP_MEMORY_SCOPE_AGENT); }
__device__ __forceinline__ unsigned xb_xcc_id() { return (unsigned)__builtin_amdgcn_s_getreg((3 << 11) | 20) & 0xFu; }
#define XB_SPIN(cond, bar) do { unsigned _sp = 0; while (cond) { __builtin_amdgcn_s_sleep(1); \
    if ((++_sp & 255u) == 0u) { if (xb_ld(&(bar)[XB_TMO])) break; if (_sp > XB_SPIN_CAP) { atomicAdd(&(bar)[XB_TMO], 1u); break; } } } } while (0)

struct XcdBarrier {
    unsigned* bar; unsigned x;
    volatile LAS unsigned* st;
};

__device__ __forceinline__ XcdBarrier xcd_barrier_post(unsigned* bar, volatile LAS unsigned* st) {
    XcdBarrier b; b.bar = bar; b.x = xb_xcc_id(); b.st = st;
    if (threadIdx.x == 0) (void)xb_add(&bar[XB_XCNT(b.x)], 1u);
    return b;
}
__device__ __forceinline__ void xcd_barrier_complete(unsigned* bar, unsigned x, unsigned& nloc, unsigned& nx) {
    const unsigned G = gridDim.x * gridDim.y * gridDim.z;
    unsigned sum, cnt, mine, sp = 0u;
    for (;;) {
        sum = 0u; cnt = 0u; mine = 0u;
#pragma unroll
        for (unsigned j = 0; j < 16; ++j) { const unsigned c = xb_ld(&bar[XB_XCNT(j)]); sum += c; cnt += (c > 0u) ? 1u : 0u; mine = (j == x) ? c : mine; }
        if (sum == G) break;
        __builtin_amdgcn_s_sleep(1);
        if ((++sp & 255u) == 0u) { if (xb_ld(&bar[XB_TMO])) break; if (sp > XB_SPIN_CAP) { atomicAdd(&bar[XB_TMO], 1u); break; } }
    }
    nloc = mine > 0u ? mine : 1u; nx = cnt > 0u ? cnt : 1u;
}

__device__ __forceinline__ void xcd_barrier(const XcdBarrier& b) {
    asm volatile("s_waitcnt vmcnt(0)" ::: "memory");
    __syncthreads();
    if (threadIdx.x == 0) {
        unsigned* bar = b.bar;
        __builtin_amdgcn_s_waitcnt(0);
        unsigned nloc = b.st[0], nx = b.st[1];
        if (nloc == 0u) { xcd_barrier_complete(bar, b.x, nloc, nx); b.st[0] = nloc; b.st[1] = nx; }
        const unsigned old = xb_add(&bar[XB_XSUB(b.x)], 1u);
        const unsigned gen = old / nloc;
        if (old + 1u == (gen + 1u) * nloc) {
            __builtin_amdgcn_fence(__ATOMIC_RELEASE, "agent");
            asm volatile("s_waitcnt vmcnt(0)" ::: "memory");
            const unsigned og = xb_add(&bar[XB_TOP], 1u);
            const unsigned tg = og / nx;
            if (og + 1u == (tg + 1u) * nx) xb_add(&bar[XB_TOPGEN], 1u);
            else XB_SPIN(xb_ld(&bar[XB_TOPGEN]) == tg, bar);
            __builtin_amdgcn_fence(__ATOMIC_ACQUIRE, "agent");
            xb_add(&bar[XB_XGEN(b.x)], 1u);
            asm volatile("s_waitcnt vmcnt(0)" ::: "memory");
        } else {
            XB_SPIN(xb_ld(&bar[XB_XGEN(b.x)]) == gen, bar);
            __builtin_amdgcn_fence(__ATOMIC_ACQUIRE, "agent");
            asm volatile("s_waitcnt vmcnt(0)" ::: "memory");
        }
    }
    __syncthreads();
}

struct Frame {
    LAS unsigned char* lds; int wave, vcu, G;
    float* out; unsigned char* ws;
};
constexpr int BARST_OFF = 143360 + 256;
constexpr int TAB_OFF = 143360;
__device__ __forceinline__ const float* inp(const Frame& F, int i) {
    const LAS unsigned* t = (const LAS unsigned*)(F.lds + TAB_OFF) + 2 * i; const unsigned lo = __builtin_amdgcn_readfirstlane(t[0]), hi = __builtin_amdgcn_readfirstlane(t[1]);
    return (const float*)(const GAS float*)(((unsigned long long)hi << 32) | lo);
}
__device__ __forceinline__ int ltid() { int t = threadIdx.x; asm volatile("" : "+v"(t)); return t; }
__device__ __forceinline__ float wave_sum(float v) {
#pragma unroll
    for (int o = 1; o < 64; o <<= 1) v += __shfl_xor(v, o);
    return v;
}
struct TItem { const float* src; bf16* dst; int K, N; };
__device__ __forceinline__ void p0_item_load(const TItem& t, f32x4 (&buf)[16], int lane) {
    const float* p = t.src + (size_t)(lane >> 4) * t.N + 4 * (lane & 15);
#pragma unroll
    for (int i = 0; i < 16; ++i) buf[i] = __builtin_nontemporal_load((const f32x4*)(p + (size_t)(4 * i) * t.N));
}
__device__ __forceinline__ void p0_item_to_lds(const f32x4 (&buf)[16], LAS float* scr, int lane) {
    LAS float* q = scr + (lane >> 4) * 65 + 4 * (lane & 15);
#pragma unroll
    for (int i = 0; i < 16; ++i) { q[(4 * i) * 65 + 0] = buf[i][0]; q[(4 * i) * 65 + 1] = buf[i][1]; q[(4 * i) * 65 + 2] = buf[i][2]; q[(4 * i) * 65 + 3] = buf[i][3]; }
}
__device__ __forceinline__ void p0_item_store(const TItem& t, LAS float* scr, int lane) {
    const int c = lane & 7;
#pragma unroll
    for (int j = 0; j < 8; ++j) { const int n = (lane >> 3) + 8 * j; const LAS float* sp = scr + (8 * c) * 65 + n;
        v4u o; o.x = pk2(sp[0 * 65], sp[1 * 65]); o.y = pk2(sp[2 * 65], sp[3 * 65]); o.z = pk2(sp[4 * 65], sp[5 * 65]); o.w = pk2(sp[6 * 65], sp[7 * 65]);
        *(v4u*)(t.dst + (size_t)n * t.K + 8 * c) = o; }
}
__device__ __forceinline__ const float* xrow(const Frame& F, int R) {
    return R < R_SAMPLE0 ? inp(F, 0) + (size_t)R * DM : (R < R_REAL ? inp(F, 1) + (size_t)(R - R_SAMPLE0) * DM : inp(F, 6) + (size_t)((R - R_REAL) & 15) * DM);
}

constexpr int I_IN = 32 * 32, I_GLU = 16 * 16, I_POOL = 4 * 4 * 4, I_OUT = 32 * 32, I_UP = 32 * 176, I_DOWN = 88 * 32;
constexpr int I_EARLY = I_IN + I_GLU + I_POOL + I_OUT + I_UP;
__device__ __forceinline__ void p0_decode(const Frame& F, int it, TItem& t) {
    unsigned char* ws = F.ws; int r = it;
    if (r < I_IN) { const int kb = r / 32, nb = r % 32; t.K = LDP; t.N = 2048; t.src = inp(F, 8) + (size_t)(64 * kb) * 2048 + 64 * nb; t.dst = (bf16*)(ws + WS_WIN) + (size_t)(64 * nb) * LDP + 64 * kb; return; } r -= I_IN;
    if (r < I_GLU) { const int kb = r / 16, nb = r % 16; t.K = 1024; t.N = 1024; t.src = inp(F, 17) + (size_t)(64 * kb) * 1024 + 64 * nb; t.dst = (bf16*)(ws + WS_WGLU) + (size_t)(64 * nb) * 1024 + 64 * kb; return; } r -= I_GLU;
    if (r < I_POOL) { const int g = r / 16, q = r % 16, kb = q / 4, nb = q % 4; t.K = 256; t.N = 256; t.src = inp(F, 18) + (size_t)g * 65536 + (size_t)(64 * kb) * 256 + 64 * nb; t.dst = (bf16*)(ws + WS_WPOOL) + (size_t)g * 65536 + (size_t)(64 * nb) * 256 + 64 * kb; return; } r -= I_POOL;
    if (r < I_OUT) { const int kb = r / 32, nb = r % 32; t.K = LDP; t.N = 2048; t.src = inp(F, 20) + (size_t)(64 * kb) * 2048 + 64 * nb; t.dst = (bf16*)(ws + WS_WOUT) + (size_t)(64 * nb) * LDP + 64 * kb; return; } r -= I_OUT;
    if (r < I_UP) { const int kb = r / 176, nb = r % 176, n0 = 64 * nb; const int drow = n0 < DFF ? (n0 / 128) * 256 + (n0 % 128) : ((n0 - DFF) / 128) * 256 + 128 + ((n0 - DFF) % 128);
        t.K = LDP; t.N = 2 * DFF; t.src = inp(F, 22) + (size_t)(64 * kb) * (2 * DFF) + n0; t.dst = (bf16*)(ws + WS_WUP) + (size_t)drow * LDP + 64 * kb; return; } r -= I_UP;
    { const int kb = r / 32, nb = r % 32; t.K = DFF; t.N = 2048; t.src = inp(F, 25) + (size_t)(64 * kb) * 2048 + 64 * nb; t.dst = (bf16*)(ws + WS_WDOWN) + (size_t)(64 * nb) * DFF + 64 * kb; }
}
__device__ __forceinline__ void p0_convert(const Frame& F, int lo, int hi, int w, int nw, int lane) {
    LAS float* scr = (LAS float*)(F.lds + F.wave * 16640);
    f32x4 bufA[16], bufB[16]; TItem ta, tb; int it = lo + w;
    if (it < hi) { p0_decode(F, it, ta); p0_item_load(ta, bufA, lane); }
    while (it < hi) {
        p0_item_to_lds(bufA, scr, lane);
        if (it + nw < hi) { p0_decode(F, it + nw, tb); p0_item_load(tb, bufB, lane); }
        LDS_WAIT(); asm volatile("" ::: "memory");
        p0_item_store(ta, scr, lane);
        LDS_WAIT(); asm volatile("" ::: "memory");
        it += nw; if (it >= hi) break;
        p0_item_to_lds(bufB, scr, lane);
        if (it + nw < hi) { p0_decode(F, it + nw, ta); p0_item_load(ta, bufA, lane); }
        LDS_WAIT(); asm volatile("" ::: "memory");
        p0_item_store(tb, scr, lane);
        LDS_WAIT(); asm volatile("" ::: "memory");
        it += nw;
    }
}
__device__ __forceinline__ void p0_prologue(Frame& F) {
    unsigned char* ws = F.ws; const int tid = ltid(), lane = tid & 63;
    const int gw = F.vcu * NWAVES + F.wave, NGW = F.G * NWAVES;
    p0_convert(F, 0, F.G == 256 ? I_EARLY : I_EARLY + I_DOWN, gw, NGW, lane);
    const float* gm = inp(F, 7);
    {
        f32x4 v[8], vn[8]; int R = gw;
        f32x4 gmix[8];
#pragma unroll
        for (int j = 0; j < 8; ++j) gmix[j] = ((const f32x4*)gm)[64 * j + lane];
        if (R < R_ALL) { const f32x4* xr = (const f32x4*)xrow(F, R) + lane;
#pragma unroll
            for (int j = 0; j < 8; ++j) v[j] = __builtin_nontemporal_load(xr + 64 * j); }
        while (R < R_ALL) {
            const int Rn = R + NGW;
            if (Rn < R_ALL) { const f32x4* xr = (const f32x4*)xrow(F, Rn) + lane;
#pragma unroll
                for (int j = 0; j < 8; ++j) vn[j] = __builtin_nontemporal_load(xr + 64 * j); }
            float s = 0.f;
#pragma unroll
            for (int j = 0; j < 8; ++j) s += (v[j].x * v[j].x + v[j].y * v[j].y) + (v[j].z * v[j].z + v[j].w * v[j].w);
            const float ms = wave_sum(s) * (1.0f / DM) + RMS_EPS; const float rstd = rsqrtf(ms);
            if (lane == 0) ((float*)(ws + WS_SS2))[R] = sqrtf(ms);
            unsigned long long* o8 = (unsigned long long*)((bf16*)(ws + WS_XN) + (size_t)R * LDP) + lane;
#pragma unroll
            for (int j = 0; j < 8; ++j) { const f32x4 g = gmix[j];
                o8[64 * j] = (unsigned long long)pk2(v[j].x * rstd * g.x, v[j].y * rstd * g.y) | ((unsigned long long)pk2(v[j].z * rstd * g.z, v[j].w * rstd * g.w) << 32); }
#pragma unroll
            for (int j = 0; j < 8; ++j) v[j] = vn[j];
            R = Rn;
        }
    }
    const int gt = F.vcu * NTHREADS + tid, NGT = F.G * NTHREADS;
    for (int i = gt; i < 9216; i += NGT) ((float*)(ws + WS_SS1))[i] = 0.f;
    for (int i = gt; i < 4 * 256; i += NGT) __hip_atomic_store((unsigned*)(ws + WS_FLAGS) + i, 0u, __ATOMIC_RELAXED, __HIP_MEMORY_SCOPE_SYSTEM);
    for (int i2 = gt; i2 < NG * NS * 16; i2 += NGT) {
        const int i = i2 >> 4, n = i2 & 15, g = i >> 6, p = i & 63;
        const float lr = inp(F, 9)[i], li = inp(F, 10)[i], dt = expf(inp(F, 11)[g]);
        const float er = expf(lr * dt); const float sn = sinf(li * dt), cs = cosf(li * dt);
        const float br = er * cs, bi = er * sn;
        if (n == 0) {
            ((float2*)(ws + WS_LBAR))[i] = make_float2(br, bi);
            float pr = br, pi = bi;
#pragma unroll
            for (int k = 0; k < 8; ++k) { const float nr = pr * pr - pi * pi, ni = 2.f * pr * pi; pr = nr; pi = ni; }
            ((float2*)(ws + WS_PW))[i] = make_float2(pr, pi);
        }
        const float nr = br - 1.f, ni = bi, den = 1.f / (lr * lr + li * li);
        const float cr = (nr * lr + ni * li) * den, ci = (ni * lr - nr * li) * den;
        bf16* bb = (bf16*)(ws + WS_BB) + (size_t)g * 128 * 16;
        const float b_r = inp(F, 12)[(size_t)i * 16 + n], b_i = inp(F, 13)[(size_t)i * 16 + n];
        bb[p * 16 + n] = (bf16)f2bf(cr * b_r - ci * b_i); bb[(64 + p) * 16 + n] = (bf16)f2bf(cr * b_i + ci * b_r);
    }
    for (int i = gt; i < NG * 16 * 128; i += NGT) {
        const int k = i & 127, gn = i >> 7;
        ((bf16*)(ws + WS_CC))[i] = (bf16)f2bf(k < 64 ? inp(F, 14)[(size_t)gn * 64 + k] : -inp(F, 15)[(size_t)gn * 64 + (k - 64)]);
    }
}

struct S5Ctx { bf16x8 bb[4]; bf16x8 cc[8]; float lbr, lbi; int g; f32x4 dsk[2]; };
struct S5In { bf16x8 a; v2u us[2]; };
__device__ __forceinline__ void s5_load_ctx(S5Ctx& c, const Frame& F, int g, int lane) {
    const unsigned char* ws = F.ws; c.g = g;
    const bf16* bb = (const bf16*)(ws + WS_BB) + (size_t)g * 2048; const bf16* cc = (const bf16*)(ws + WS_CC) + (size_t)g * 2048;
#pragma unroll
    for (int cb = 0; cb < 4; ++cb) c.bb[cb] = *(const bf16x8*)(bb + (32 * cb + (lane & 31)) * 16 + 8 * (lane >> 5));
#pragma unroll
    for (int kb = 0; kb < 8; ++kb) { bf16x8 z = {0, 0, 0, 0, 0, 0, 0, 0}; if ((lane & 31) < 16) z = *(const bf16x8*)(cc + (lane & 31) * 128 + 16 * kb + 8 * (lane >> 5)); c.cc[kb] = z; }
    const float2 lb = ((const float2*)(ws + WS_LBAR))[g * 64 + lane]; c.lbr = lb.x; c.lbi = lb.y;
    c.dsk[0] = *(const f32x4*)(inp(F, 16) + g * 16 + 4 * (lane >> 5)); c.dsk[1] = *(const f32x4*)(inp(F, 16) + g * 16 + 8 + 4 * (lane >> 5));
}
template <int NV, bool FULL>
__device__ __forceinline__ void s5_fetch(S5In& in, const Frame& F, int g, int row0, int lane) {
    const bf16* U = (const bf16*)(F.ws + WS_U); const int ti = lane & 31, kh = lane >> 5;
    in.a = (bf16x8){0, 0, 0, 0, 0, 0, 0, 0}; in.us[0] = (v2u){0u, 0u}; in.us[1] = (v2u){0u, 0u};
    if (ti < NV) { const bf16* ur = U + (size_t)(row0 + ti) * 2048 + g * 16; in.a = *(const bf16x8*)(ur + 8 * kh);
        if (FULL) { in.us[0] = *(const v2u*)(ur + 4 * kh); in.us[1] = *(const v2u*)(ur + 8 + 4 * kh); } }
}
template <int NV, bool FULL>
__device__ __forceinline__ void s5_block(const S5Ctx& c, const Frame& F, LAS unsigned char* wl, int row0, const S5In& in, float& hr, float& hi, int lane) {
    const int ti = lane & 31, kh = lane >> 5;
    const bf16x8 a = in.a;
    LAS float* L = (LAS float*)wl;
#pragma unroll
    for (int cb = 0; cb < 4; ++cb) {
        f32x16 d = {0.f, 0.f, 0.f, 0.f, 0.f, 0.f, 0.f, 0.f, 0.f, 0.f, 0.f, 0.f, 0.f, 0.f, 0.f, 0.f};
        d = __builtin_amdgcn_mfma_f32_32x32x16_bf16(a, c.bb[cb], d, 0, 0, 0);
#pragma unroll
        for (int r = 0; r < 16; ++r) { const int i = (r & 3) + 8 * (r >> 2) + 4 * kh; if (i < NV) L[i * 132 + 32 * cb + ti] = d[r]; }
    }
    LDS_WAIT(); asm volatile("" ::: "memory");
    float bre[NV], bim[NV];
#pragma unroll
    for (int t = 0; t < NV; ++t) { bre[t] = L[t * 132 + lane]; bim[t] = L[t * 132 + 64 + lane]; }
    LDS_WAIT(); asm volatile("" ::: "memory");
    LAS bf16* Hh = (LAS bf16*)wl;
#pragma unroll
    for (int t = 0; t < NV; ++t) {
        const float nr = c.lbr * hr - c.lbi * hi + bre[t], ni = c.lbr * hi + c.lbi * hr + bim[t]; hr = nr; hi = ni;
        if (FULL) { Hh[t * 264 + lane] = (bf16)f2bf(hr); Hh[t * 264 + 64 + lane] = (bf16)f2bf(hi); }
    }
    if (FULL) {
        LDS_WAIT(); asm volatile("" ::: "memory");
        f32x16 y = {0.f, 0.f, 0.f, 0.f, 0.f, 0.f, 0.f, 0.f, 0.f, 0.f, 0.f, 0.f, 0.f, 0.f, 0.f, 0.f};
#pragma unroll
        for (int kb = 0; kb < 8; ++kb) { const bf16x8 hb = *(const LAS bf16x8*)(wl + ti * 528 + (16 * kb + 8 * kh) * 2); y = __builtin_amdgcn_mfma_f32_32x32x16_bf16(c.cc[kb], hb, y, 0, 0, 0); }
        LDS_WAIT(); asm volatile("" ::: "memory");
        if (ti < NV) {
            bf16* YP = (bf16*)(F.ws + WS_YPRE) + (size_t)(row0 + ti) * 1024 + c.g * 16;
#pragma unroll
            for (int rr = 0; rr < 2; ++rr) { const int n0 = 8 * rr + 4 * kh; const v2u uu = in.us[rr]; const f32x4 dd = c.dsk[rr];
                const float y0 = pg8::gelu_tanh(y[4 * rr + 0] + dd.x * blo(uu.x)), y1 = pg8::gelu_tanh(y[4 * rr + 1] + dd.y * bhi(uu.x)),
                            y2 = pg8::gelu_tanh(y[4 * rr + 2] + dd.z * blo(uu.y)), y3 = pg8::gelu_tanh(y[4 * rr + 3] + dd.w * bhi(uu.y));
                v2u o; o.x = pk2(y0, y1); o.y = pk2(y2, y3); *(v2u*)(YP + n0) = o; }
        }
    }
}
template <bool FULL>
__device__ __forceinline__ void s5_prompt_item(const Frame& F, LAS unsigned char* wl, int item, int lane) {
    const int seg = item & (NSEG - 1), g = (item >> 4) & 63, b = item >> 10;
    float2* est = (float2*)(F.ws + WS_EST) + ((size_t)(b * 64 + g) * NSEG) * 64;
    if (!FULL && seg == NSEG - 1) return;
    S5Ctx c; s5_load_ctx(c, F, g, lane);
    float hr = 0.f, hi = 0.f;
    if (FULL) { const float2 pw = ((const float2*)(F.ws + WS_PW))[g * 64 + lane];
        float2 ev[NSEG - 1];
#pragma unroll
        for (int s = 0; s < NSEG - 1; ++s) { ev[s] = make_float2(0.f, 0.f); if (s < seg) ev[s] = est[s * 64 + lane]; }
#pragma unroll
        for (int s = 0; s < NSEG - 1; ++s) if (s < seg) { const float nr = pw.x * hr - pw.y * hi + ev[s].x, ni = pw.x * hi + pw.y * hr + ev[s].y; hr = nr; hi = ni; } }
    S5In cur, nxt, nx2;
    const int rbase = SEQ * b + 32 * (8 * seg);
    if (seg == 0) { s5_fetch<16, FULL>(cur, F, g, R_REAL + 16 * b, lane); s5_fetch<32, FULL>(nxt, F, g, rbase, lane); s5_fetch<32, FULL>(nx2, F, g, rbase + 32, lane);
        s5_block<16, FULL>(c, F, wl, R_REAL + 16 * b, cur, hr, hi, lane); cur = nxt; nxt = nx2; }
    else { s5_fetch<32, FULL>(cur, F, g, rbase, lane); s5_fetch<32, FULL>(nxt, F, g, rbase + 32, lane); }
    for (int j = 0; j < 8; ++j) {
        const int row0 = rbase + 32 * j;
        if (j < 6) s5_fetch<32, FULL>(nx2, F, g, row0 + 64, lane);
        s5_block<32, FULL>(c, F, wl, row0, cur, hr, hi, lane); cur = nxt; nxt = nx2; }
    if (!FULL) est[seg * 64 + lane] = make_float2(hr, hi);
    else if (seg == NSEG - 1) { F.out[O_SRE_P + (size_t)(b * 64 + g) * 64 + lane] = hr; F.out[O_SIM_P + (size_t)(b * 64 + g) * 64 + lane] = hi; }
}
__device__ __forceinline__ void s5_sample_item(const Frame& F, LAS unsigned char* wl, int item, int lane) {
    const int g = item & 63, s = item >> 6;
    S5Ctx c; s5_load_ctx(c, F, g, lane);
    float hr = inp(F, 2)[(size_t)(s * 64 + g) * 64 + lane], hi = inp(F, 3)[(size_t)(s * 64 + g) * 64 + lane];
    S5In cur; s5_fetch<16, true>(cur, F, g, R_SAMPLE0 + 16 * s, lane);
    s5_block<16, true>(c, F, wl, R_SAMPLE0 + 16 * s, cur, hr, hi, lane);
    F.out[O_SRE_S + (size_t)(s * 64 + g) * 64 + lane] = hr; F.out[O_SIM_S + (size_t)(s * 64 + g) * 64 + lane] = hi;
}

__device__ __forceinline__ void pool_m_phase(const Frame& F) {
    const bf16* U = (const bf16*)(F.ws + WS_U); bf16* MB = (bf16*)(F.ws + WS_MB); const int tid = ltid();
    const int sub = tid >> 7, t128 = tid & 127, c0 = 8 * t128, w = 2 << (c0 >> 8);
    for (int run = F.vcu * 4 + sub; run < 546; run += F.G * 4) {
        const bool samp = run >= 514; int rowbase, pos0; const float* hist = nullptr; int b = 0;
        if (samp) { const int sq = run - 514; rowbase = R_SAMPLE0 + 16 * sq; pos0 = 0; hist = inp(F, 4) + (size_t)sq * 15 * 1024 + c0; }
        else { b = run / 257; const int j = run % 257; pos0 = 16 * j; rowbase = j == 0 ? R_REAL + 16 * b : SEQ * b + 16 * (j - 1); }
        v4u zr[31];
#pragma unroll
        for (int i = 0; i < 31; ++i) {
            const int rel = i - 15; v4u q = {0u, 0u, 0u, 0u};
            if (rel >= 0) q = *(const v4u*)(U + (size_t)(rowbase + rel) * 2048 + 1024 + c0);
            else if (samp) { const f32x4 a = *(const f32x4*)(hist + (size_t)(15 + rel) * 1024), b2 = *(const f32x4*)(hist + (size_t)(15 + rel) * 1024 + 4); q.x = pk2(a.x, a.y); q.y = pk2(a.z, a.w); q.z = pk2(b2.x, b2.y); q.w = pk2(b2.z, b2.w); }
            else { const int pos = pos0 + rel; if (pos >= 0) { const int row = pos < 16 ? R_REAL + 16 * b + pos : SEQ * b + (pos - 16); q = *(const v4u*)(U + (size_t)row * 2048 + 1024 + c0); } }
            zr[i] = q;
        }
        float s[8];
#pragma unroll
        for (int e = 0; e < 8; ++e) s[e] = 0.f;
#pragma unroll
        for (int jj = 1; jj < 16; ++jj) { const v4u q = zr[15 - jj]; const float f = jj < w ? 1.f : 0.f;
            s[0] += f * blo(q.x); s[1] += f * bhi(q.x); s[2] += f * blo(q.y); s[3] += f * bhi(q.y); s[4] += f * blo(q.z); s[5] += f * bhi(q.z); s[6] += f * blo(q.w); s[7] += f * bhi(q.w); }
#pragma unroll
        for (int t = 0; t < 16; ++t) {
            const v4u q = zr[15 + t]; const float z[8] = {blo(q.x), bhi(q.x), blo(q.y), bhi(q.y), blo(q.z), bhi(q.z), blo(q.w), bhi(q.w)};
            const int pos = pos0 + t; const float inv = 1.0f / (float)((samp || pos + 1 >= w) ? w : pos + 1);
            float mo[8];
#pragma unroll
            for (int e = 0; e < 8; ++e) { s[e] += z[e]; mo[e] = s[e] * inv - z[e]; }
            v4u o; o.x = pk2(mo[0], mo[1]); o.y = pk2(mo[2], mo[3]); o.z = pk2(mo[4], mo[5]); o.w = pk2(mo[6], mo[7]);
            *(v4u*)(MB + (size_t)(rowbase + t) * 1024 + c0) = o;
            const v4u q2 = zr[15 + t - 1], q4 = zr[15 + t - 3], q8 = zr[15 + t - 7], q16 = zr[15 + t - 15];
            v4u ql; ql.x = w == 2 ? q2.x : (w == 4 ? q4.x : (w == 8 ? q8.x : q16.x)); ql.y = w == 2 ? q2.y : (w == 4 ? q4.y : (w == 8 ? q8.y : q16.y));
            ql.z = w == 2 ? q2.z : (w == 4 ? q4.z : (w == 8 ? q8.z : q16.z)); ql.w = w == 2 ? q2.w : (w == 4 ? q4.w : (w == 8 ? q8.w : q16.w));
            s[0] -= blo(ql.x); s[1] -= bhi(ql.x); s[2] -= blo(ql.y); s[3] -= bhi(ql.y); s[4] -= blo(ql.z); s[5] -= bhi(ql.z); s[6] -= blo(ql.w); s[7] -= bhi(ql.w);
        }
    }
    const int gt = F.vcu * NTHREADS + tid, NGT = F.G * NTHREADS;
    for (int i = gt; i < (2 + 32) * 15 * 256; i += NGT) {
        const int c4 = (i & 255) * 4, q = i >> 8, r = q % 15, sq = q / 15;
        const int row = sq < 2 ? SEQ * sq + 4081 + r : R_SAMPLE0 + 16 * (sq - 2) + 1 + r;
        const v2u uu = *(const v2u*)(U + (size_t)row * 2048 + 1024 + c4);
        float* dst = sq < 2 ? F.out + O_POOL_P + (size_t)(sq * 15 + r) * 1024 + c4 : F.out + O_POOL_S + (size_t)((sq - 2) * 15 + r) * 1024 + c4;
        *(f32x4*)dst = (f32x4){blo(uu.x), bhi(uu.x), blo(uu.y), bhi(uu.y)};
    }
}

__device__ __forceinline__ void gmeta_phase(const Frame& F) {
    const bf16* XN = (const bf16*)(F.ws + WS_XN); const bf16* WU = (const bf16*)(F.ws + WS_WUP); const float* ss = (const float*)(F.ws + WS_SS1); float* GM = (float*)(F.ws + WS_GMETA);
    const int gw = F.vcu * NWAVES + F.wave, NGW = F.G * NWAVES; const int lane = ltid() & 63;
    for (int jb = gw; jb < DFF; jb += 3 * NGW) {
        v4u xv[4][4], wv[3][4];
#pragma unroll
        for (int i = 0; i < 4; ++i) { const int c = 8 * lane + 512 * i;
#pragma unroll
            for (int q = 0; q < 4; ++q) xv[q][i] = *(const v4u*)(XN + (size_t)(R_REAL + 16 * (q >> 1) + 14 + (q & 1)) * LDP + c);
#pragma unroll
            for (int t = 0; t < 3; ++t) { const int j = jb + t * NGW; wv[t][i] = (v4u){0u, 0u, 0u, 0u}; if (j < DFF) wv[t][i] = *(const v4u*)(WU + (size_t)((j >> 7) * 256 + (j & 127)) * LDP + c); } }
#pragma unroll
        for (int t = 0; t < 3; ++t) { const int j = jb + t * NGW;
            float a[4] = {0.f, 0.f, 0.f, 0.f};
#pragma unroll
            for (int i = 0; i < 4; ++i) { const v4u w = wv[t][i]; const float wf[8] = {blo(w.x), bhi(w.x), blo(w.y), bhi(w.y), blo(w.z), bhi(w.z), blo(w.w), bhi(w.w)};
#pragma unroll
                for (int q = 0; q < 4; ++q) { const v4u x = xv[q][i];
                    a[q] += wf[0] * blo(x.x) + wf[1] * bhi(x.x) + wf[2] * blo(x.y) + wf[3] * bhi(x.y) + wf[4] * blo(x.z) + wf[5] * bhi(x.z) + wf[6] * blo(x.w) + wf[7] * bhi(x.w); } }
#pragma unroll
            for (int q = 0; q < 4; ++q) a[q] = wave_sum(a[q]);
            if (lane < 4 && j < DFF) { const int q = lane; const int Rm = R_REAL + 16 * (q >> 1) + 14 + (q & 1); const float v = q == 0 ? a[0] : (q == 1 ? a[1] : (q == 2 ? a[2] : a[3]));
                GM[(size_t)q * DFF + j] = v * rsqrtf(ss[Rm] * (1.0f / DM) + RMS_EPS); }
        }
    }
}

__device__ __forceinline__ void fixup_phase(const Frame& F) {
    const float* GF = (const float*)(F.ws + WS_GFIX); const float* VF = (const float*)(F.ws + WS_VFIX); const float* GS = (const float*)(F.ws + WS_GSRC); const float* GM = (const float*)(F.ws + WS_GMETA);
    const float* cw = inp(F, 23); const float* cb = inp(F, 24); const float* hist = inp(F, 5); bf16* H = (bf16*)(F.ws + WS_H);
    const int tid = ltid(); const int gt = F.vcu * NTHREADS + tid, NGT = F.G * NTHREADS;
    for (int idx = gt; idx < 320 * 1408; idx += NGT) {
        const int id = idx / 1408, j = (idx % 1408) * 4;
        const f32x4 g0 = *(const f32x4*)(GF + (size_t)id * DFF + j), v0 = *(const f32x4*)(VF + (size_t)id * DFF + j);
        f32x4 p1, p2; int R;
        if (id < 256) {
            const int pm = id >> 3, blk = (id & 7) >> 1, rr = id & 1; R = 256 * pm + 64 * blk + rr;
            const bool start = blk == 0 && (pm == 0 || pm == 16);
            const float* S0; const float* S1;
            if (start) { const int b = pm >> 4; S0 = GM + (size_t)(b * 2 + 0) * DFF; S1 = GM + (size_t)(b * 2 + 1) * DFF; }
            else { const int sb = blk > 0 ? pm * 8 + (blk - 1) * 2 : (pm - 1) * 8 + 6; S0 = GS + (size_t)sb * DFF; S1 = GS + (size_t)(sb + 1) * DFF; }
            if (rr == 0) { p1 = *(const f32x4*)(S1 + j); p2 = *(const f32x4*)(S0 + j); }
            else { p1 = *(const f32x4*)(GF + (size_t)(id - 1) * DFF + j); p2 = *(const f32x4*)(S1 + j); }
        } else {
            const int q = id - 256, sq = q >> 1, rr = q & 1; R = R_SAMPLE0 + 16 * sq + rr;
            const float* h0 = hist + (size_t)(sq * 2 + 0) * DFF; const float* h1 = hist + (size_t)(sq * 2 + 1) * DFF;
            if (rr == 0) { p1 = *(const f32x4*)(h1 + j); p2 = *(const f32x4*)(h0 + j); }
            else { p1 = *(const f32x4*)(GF + (size_t)(id - 1) * DFF + j); p2 = *(const f32x4*)(h1 + j); }
        }
        const f32x4 w0 = *(const f32x4*)(cw + j), w1 = *(const f32x4*)(cw + DFF + j), w2 = *(const f32x4*)(cw + 2 * DFF + j), bb = *(const f32x4*)(cb + j);
        const f32x4 gc = bb + p2 * w0 + p1 * w1 + g0 * w2;
        v2u o; o.x = pk2(pg8::gelu_tanh(gc.x) * v0.x, pg8::gelu_tanh(gc.y) * v0.y); o.y = pk2(pg8::gelu_tanh(gc.z) * v0.z, pg8::gelu_tanh(gc.w) * v0.w);
        *(v2u*)(H + (size_t)R * DFF + j) = o;
    }
}
__device__ __forceinline__ void final_phase(const Frame& F) {
    const float* gf = inp(F, 26); const float* gn = inp(F, 21); const bf16* XNb = (const bf16*)(F.ws + WS_XN);
    const bf16* FA = (const bf16*)(F.ws + WS_FA); const bf16* FBb = (const bf16*)(F.ws + WS_FB);
    const int gw = F.vcu * NWAVES + F.wave, NGW = F.G * NWAVES; const int lane = ltid() & 63;
    f32x4 rg[8];
#pragma unroll
    for (int j = 0; j < 8; ++j) { const f32x4 g = ((const f32x4*)gn)[64 * j + lane]; rg[j] = (f32x4){1.0f / g.x, 1.0f / g.y, 1.0f / g.z, 1.0f / g.w}; }
    f32x4 gfin[8];
#pragma unroll
    for (int j = 0; j < 8; ++j) gfin[j] = ((const f32x4*)gf)[64 * j + lane];
    v2u xb[8], xbn[8], xb2[8], fb[8], fbn[8], fb2[8]; int R = gw;
    auto fetch = [&](int Rr, v2u (&x)[8], v2u (&f)[8]) {
        if (Rr < R_REAL) { const v2u* xr = (const v2u*)(XNb + (size_t)Rr * LDP) + lane; const v2u* fr_ = (const v2u*)((Rr < F_SPLIT ? FA + (size_t)Rr * DM : FBb + (size_t)(Rr - F_SPLIT) * DM)) + lane;
#pragma unroll
            for (int j = 0; j < 8; ++j) { x[j] = xr[64 * j]; f[j] = fr_[64 * j]; } } };
    fetch(R, xb, fb); fetch(R + NGW, xbn, fbn);
    while (R < R_REAL) {
        fetch(R + 2 * NGW, xb2, fb2);
        f32x4 v[8]; float s = 0.f;
#pragma unroll
        for (int j = 0; j < 8; ++j) { v[j].x = blo(xb[j].x) * rg[j].x + blo(fb[j].x); v[j].y = bhi(xb[j].x) * rg[j].y + bhi(fb[j].x); v[j].z = blo(xb[j].y) * rg[j].z + blo(fb[j].y); v[j].w = bhi(xb[j].y) * rg[j].w + bhi(fb[j].y);
            s += (v[j].x * v[j].x + v[j].y * v[j].y) + (v[j].z * v[j].z + v[j].w * v[j].w); }
        const float rstd = rsqrtf(wave_sum(s) * (1.0f / DM) + RMS_EPS);
        f32x4* xo = (f32x4*)(F.out + (size_t)R * DM) + lane;
#pragma unroll
        for (int j = 0; j < 8; ++j) __builtin_nontemporal_store(v[j] * rstd * gfin[j], xo + 64 * j);
#pragma unroll
        for (int j = 0; j < 8; ++j) { xb[j] = xbn[j]; fb[j] = fbn[j]; xbn[j] = xb2[j]; fbn[j] = fb2[j]; }
        R += NGW;
    }
}

struct Args { const float* in[27]; float* out; unsigned char* ws; };
#ifndef PROBE
#define PROBE 0
#endif
__global__ void __launch_bounds__(NTHREADS, 2) hymba_fwd(Args args) {
    extern __shared__ __attribute__((aligned(16))) unsigned char lds[];
    cg::grid_group grid = cg::this_grid();
    Frame F;
    F.lds = (LAS unsigned char*)lds;
    F.wave = __builtin_amdgcn_readfirstlane((int)threadIdx.x >> 6);
    F.G = gridDim.x; { const int bx = blockIdx.x; F.vcu = (F.G % 8 == 0) ? (bx % 8) * (F.G / 8) + bx / 8 : bx; }
    if (threadIdx.x == 0) {
#pragma unroll
        for (int i = 0; i < 27; ++i) ((LAS unsigned long long*)(F.lds + TAB_OFF))[i] = (unsigned long long)args.in[i];
        ((LAS unsigned*)(F.lds + BARST_OFF))[0] = 0u; ((LAS unsigned*)(F.lds + BARST_OFF))[1] = 0u; ((LAS unsigned*)(F.lds + BARST_OFF + 64))[0] = 0u;
    }
    __syncthreads();
    const XcdBarrier bar = xcd_barrier_post((unsigned*)(args.ws + WS_BAR), (volatile LAS unsigned*)(F.lds + BARST_OFF));
#ifndef TPROBE_A
#define TPROBE_A -1
#define TPROBE_B -1
#endif
    int stamp_i_ = 0;
#define STAMP() do { if (TPROBE_A >= 0 && blockIdx.x == 0 && threadIdx.x == 0) ((volatile LAS unsigned long long*)(F.lds + BARST_OFF + 128))[stamp_i_] = __builtin_amdgcn_s_memrealtime(); ++stamp_i_; } while (0)
#define GRID_BAR() do { xcd_barrier(bar); STAMP(); } while (0)
    STAMP();
    F.out = (float*)(GAS float*)args.out; F.ws = (unsigned char*)(GAS unsigned char*)args.ws;
    unsigned char* ws = F.ws;
    bf16* XN = (bf16*)(ws + WS_XN); bf16* U = (bf16*)(ws + WS_U); bf16* YPRE = (bf16*)(ws + WS_YPRE); bf16* MB = (bf16*)(ws + WS_MB); bf16* YCAT = (bf16*)(ws + WS_YCAT); bf16* H = (bf16*)(ws + WS_H);
    float* SS1 = (float*)(ws + WS_SS1); float* SS2 = (float*)(ws + WS_SS2);
    const int gw = F.vcu * NWAVES + F.wave, NGW = F.G * NWAVES;
    LAS unsigned char* wl = F.lds + F.wave * S5_WLDS;

    auto forward_ = [&]() __attribute__((always_inline)) {
    p0_prologue(F);
    if (PROBE == 1) { __syncthreads(); p0_prologue(F); }
    if (args.ws == nullptr) grid.sync();
    GRID_BAR();
    { pg8::Gemm g{XN, (const bf16*)(ws + WS_WIN), LDP, LDP, 2048, 0}; pg8::RemSplit S; S.init(35, 8, 16, 8, F.G, (int)blockIdx.x);
      pg8::EpiBf16 E{U, 2048}; const pg8::SKBuf sk{(float*)(ws + WS_SLOTS), (unsigned*)(ws + WS_FLAGS), (int)blockIdx.x};
      pg8::gemm_phase<pg8::EpiBf16, pg8::RemSplit, true, true, true>(F.lds, g, S, E, sk); GRID_BAR(); pg8::gemm_reduce(S, E, sk);
      if (PROBE == 4) { GRID_BAR(); pg8::gemm_phase<pg8::EpiBf16, pg8::RemSplit, true, true, true>(F.lds, g, S, E, sk); GRID_BAR(); pg8::gemm_reduce(S, E, sk); } }
    GRID_BAR();
    for (int it = gw; it < 2 * 64 * NSEG; it += NGW) s5_prompt_item<false>(F, wl, it, ltid() & 63);
    for (int it = gw; it < DECB * 64; it += NGW) s5_sample_item(F, wl, it, ltid() & 63);
    pool_m_phase(F);
    if (PROBE == 2) { __syncthreads();
        for (int it = gw; it < 2 * 64 * NSEG; it += NGW) s5_prompt_item<false>(F, wl, it, ltid() & 63);
        for (int it = gw; it < DECB * 64; it += NGW) s5_sample_item(F, wl, it, ltid() & 63);
        pool_m_phase(F); }
    GRID_BAR();
    for (int it = gw; it < 2 * 64 * NSEG; it += NGW) s5_prompt_item<true>(F, wl, it, ltid() & 63);
    if (PROBE == 2) { for (int it = gw; it < 2 * 64 * NSEG; it += NGW) s5_prompt_item<true>(F, wl, it, ltid() & 63); }
    GRID_BAR();
    if (F.G > 140 + 35) {
        if ((int)blockIdx.x < 140) { pg8::Gemm g{YPRE, (const bf16*)(ws + WS_WGLU), 1024, 1024, 1024, 0}; pg8::StaticOrder S; S.init(35, 4, 16, 140, (int)blockIdx.x);
            pg8::EpiGlu E{YPRE, YCAT}; pg8::gemm_phase<pg8::EpiGlu, pg8::StaticOrder, true, true>(F.lds, g, S, E); }
        else { pg8::Gemm g{MB, (const bf16*)(ws + WS_WPOOL), 1024, 256, 256, 256}; pg8::StaticOrder S; S.init(35, 4, 4, F.G - 140, (int)blockIdx.x - 140);
            pg8::EpiPool E{YCAT, inp(F, 19)}; pg8::gemm_phase<pg8::EpiPool, pg8::StaticOrder, true, true>(F.lds, g, S, E); }
    } else {
        { pg8::Gemm g{MB, (const bf16*)(ws + WS_WPOOL), 1024, 256, 256, 256}; pg8::StaticOrder S; S.init(35, 4, 4, F.G, (int)blockIdx.x);
          pg8::EpiPool E{YCAT, inp(F, 19)}; pg8::gemm_phase<pg8::EpiPool, pg8::StaticOrder, true, true>(F.lds, g, S, E); }
        __syncthreads();
        { pg8::Gemm g{YPRE, (const bf16*)(ws + WS_WGLU), 1024, 1024, 1024, 0}; pg8::StaticOrder S; S.init(35, 4, 16, F.G, (int)blockIdx.x);
          pg8::EpiGlu E{YPRE, YCAT}; pg8::gemm_phase<pg8::EpiGlu, pg8::StaticOrder, true, true>(F.lds, g, S, E); }
    }
    GRID_BAR();
    if (PROBE == 12) { GRID_BAR();
        if ((int)blockIdx.x < 140) { pg8::Gemm g{YPRE, (const bf16*)(ws + WS_WGLU), 1024, 1024, 1024, 0}; pg8::StaticOrder S; S.init(35, 4, 16, 140, (int)blockIdx.x);
            pg8::EpiGlu E{YPRE, YCAT}; pg8::gemm_phase<pg8::EpiGlu, pg8::StaticOrder, true, true>(F.lds, g, S, E); }
        else { pg8::Gemm g{MB, (const bf16*)(ws + WS_WPOOL), 1024, 256, 256, 256}; pg8::StaticOrder S; S.init(35, 4, 4, F.G - 140, (int)blockIdx.x - 140);
            pg8::EpiPool E{YCAT, inp(F, 19)}; pg8::gemm_phase<pg8::EpiPool, pg8::StaticOrder, true, true>(F.lds, g, S, E); } }
    { pg8::Gemm g{YCAT, (const bf16*)(ws + WS_WOUT), LDP, LDP, 2048, 0}; pg8::RemSplit S; S.init(35, 8, 16, 8, F.G, (int)blockIdx.x);
      pg8::EpiOut E{SS2, inp(F, 7), inp(F, 21), XN, SS1};
      const pg8::SKBuf sk{(float*)(ws + WS_SLOTS), (unsigned*)(ws + WS_FLAGS) + 512, (int)blockIdx.x};
      pg8::gemm_phase<pg8::EpiOut, pg8::RemSplit, true, true, true>(F.lds, g, S, E, sk); GRID_BAR(); pg8::gemm_reduce(S, E, sk);
      if (PROBE == 11) { GRID_BAR(); for (int i = F.vcu * NTHREADS + ltid(); i < 9216; i += F.G * NTHREADS) SS1[i] = 0.f; GRID_BAR();
          pg8::gemm_phase<pg8::EpiOut, pg8::RemSplit, true, true, true>(F.lds, g, S, E, sk); GRID_BAR(); pg8::gemm_reduce(S, E, sk); } }
    GRID_BAR();
    gmeta_phase(F);
    { pg8::Gemm g{XN, (const bf16*)(ws + WS_WUP), LDP, LDP, 2048, 0}; pg8::StaticOrder S; S.init(34, 44, 32, F.G, (int)blockIdx.x);
      pg8::EpiUp E{SS1, inp(F, 23), inp(F, 24), H, (float*)(ws + WS_GFIX), (float*)(ws + WS_VFIX), (float*)(ws + WS_GSRC), F.out + O_CONV_P, F.out + O_CONV_S};
      pg8::gemm_phase<pg8::EpiUp, pg8::StaticOrder, true, true>(F.lds, g, S, E);
      if (PROBE == 3) { __syncthreads(); pg8::gemm_phase<pg8::EpiUp, pg8::StaticOrder, true, true>(F.lds, g, S, E); }
      if (PROBE == 13) { __syncthreads(); pg8::EpiBf16 E2{(bf16*)(ws + WS_FA), 0}; pg8::gemm_phase<pg8::EpiBf16, pg8::StaticOrder, true, true>(F.lds, g, S, E2); } }
    if (F.G == 256 && (int)blockIdx.x >= 216) { __syncthreads(); p0_convert(F, I_EARLY, I_EARLY + I_DOWN, ((int)blockIdx.x - 216) * NWAVES + F.wave, 40 * NWAVES, ltid() & 63); }
    GRID_BAR();
    fixup_phase(F);
    GRID_BAR();
    { pg8::Gemm g{H, (const bf16*)(ws + WS_WDOWN), DFF, DFF, DFF, 0}; pg8::RemSplit S; S.init(34, 8, 44, 16, F.G, (int)blockIdx.x);
      pg8::EpiF E{(bf16*)(ws + WS_FA), (bf16*)(ws + WS_FB), F_SPLIT};
      const pg8::SKBuf sk{(float*)(ws + WS_SLOTS), (unsigned*)(ws + WS_FLAGS) + 768, (int)blockIdx.x};
      pg8::gemm_phase<pg8::EpiF, pg8::RemSplit, true, true, true>(F.lds, g, S, E, sk); GRID_BAR(); pg8::gemm_reduce(S, E, sk); }
    GRID_BAR();
    if (PROBE == 9) { GRID_BAR(); pg8::Gemm g{H, (const bf16*)(ws + WS_WDOWN), DFF, DFF, DFF, 0}; pg8::RemSplit S; S.init(34, 8, 44, 16, F.G, (int)blockIdx.x);
        const pg8::SKBuf sk{(float*)(ws + WS_SLOTS), (unsigned*)(ws + WS_FLAGS) + 768, (int)blockIdx.x}; pg8::EpiBf16 E{XN, 2048};
        pg8::gemm_phase<pg8::EpiBf16, pg8::RemSplit, true, true, true>(F.lds, g, S, E, sk); GRID_BAR(); pg8::gemm_reduce(S, E, sk); }
    if (PROBE == 10) { GRID_BAR(); const int gw2 = F.vcu * NWAVES + F.wave, lane2 = ltid() & 63;
        for (int R = gw2; R < R_REAL; R += F.G * NWAVES) { f32x4* xr = (f32x4*)(F.out + (size_t)R * DM) + lane2;
#pragma unroll
            for (int j = 0; j < 8; ++j) { f32x4 v = xr[64 * j]; asm volatile("" : "+v"(v)); xr[64 * j] = v; } } }
    if (PROBE == 6) { pg8::Gemm g{H, (const bf16*)(ws + WS_WDOWN), DFF, DFF, DFF, 0}; pg8::StaticOrder S; S.init(34, 8, 88, F.G, (int)blockIdx.x);
        pg8::EpiBf16 E{XN, 2048}; pg8::gemm_phase<pg8::EpiBf16, pg8::StaticOrder, true, true>(F.lds, g, S, E); }
    if (PROBE == 7) { GRID_BAR(); GRID_BAR(); GRID_BAR(); GRID_BAR(); GRID_BAR(); GRID_BAR(); GRID_BAR(); GRID_BAR(); }
    final_phase(F);
    if (TPROBE_A >= 0) { asm volatile("s_waitcnt vmcnt(0)" ::: "memory"); __syncthreads(); STAMP();
        if (blockIdx.x == 0 && threadIdx.x == 0) { volatile LAS unsigned long long* ts = (volatile LAS unsigned long long*)(F.lds + BARST_OFF + 128);
            const unsigned long long d = ts[TPROBE_B] - ts[TPROBE_A], t0 = __builtin_amdgcn_s_memrealtime();
            while (__builtin_amdgcn_s_memrealtime() - t0 < d) __builtin_amdgcn_s_sleep(8); } }
    };
    forward_();
    if (PROBE == 8) { GRID_BAR(); forward_(); }
}

extern "C" void kernel_launch(void* const* d_in, const int* in_sizes, int n_in, void* d_out, int out_size, void* d_ws, size_t ws_size, hipStream_t stream) {
    static int grid = 0;
    if (grid == 0) {
        if (n_in != 27 || out_size != 19009536 || ws_size < WS_END) { fprintf(stderr, "kernel_launch: unexpected shapes (n_in %d, out %d, ws %zu)\n", n_in, out_size, ws_size); grid = -1; return; }
        int dev = 0, cus = 0, per_cu = 0;
        if (hipGetDevice(&dev) != hipSuccess || hipDeviceGetAttribute(&cus, hipDeviceAttributeMultiprocessorCount, dev) != hipSuccess) { grid = -1; return; }
        if (hipFuncSetAttribute((const void*)hymba_fwd, hipFuncAttributeMaxDynamicSharedMemorySize, LDS_BYTES) != hipSuccess) { fprintf(stderr, "kernel_launch: hipFuncSetAttribute failed\n"); grid = -1; return; }
        if (hipOccupancyMaxActiveBlocksPerMultiprocessor(&per_cu, (const void*)hymba_fwd, NTHREADS, LDS_BYTES) != hipSuccess || per_cu < 1) { fprintf(stderr, "kernel_launch: occupancy query says %d\n", per_cu); per_cu = 1; }
        (void)hipGetLastError();
        grid = cus;
    }
    if (grid < 0) return;
    if (hipMemsetAsync((char*)d_ws + WS_BAR, 0, XCD_BAR_WORDS * 4, stream) != hipSuccess) { fprintf(stderr, "kernel_launch: memset of barrier words failed\n"); return; }
    Args a{};
    for (int i = 0; i < 27; ++i) a.in[i] = (const float*)d_in[i];
    a.out = (float*)d_out; a.ws = (unsigned char*)d_ws;
    void* kargs[] = {&a};
    hipError_t e = hipLaunchCooperativeKernel((const void*)hymba_fwd, dim3(grid), dim3(NTHREADS), kargs, LDS_BYTES, stream);
    if (e != hipSuccess) fprintf(stderr, "kernel_launch: cooperative launch failed: %s (grid %d)\n", hipGetErrorString(e), grid);
}
```
